# Optimizing an MI355X kernel written in HIP

```python
import jax, jax.numpy as jnp
from jax import lax
import numpy as np

D_MODEL = 1024
BATCH = 16
SEQ = 2048
DEPTH = 1

HEAD_DIM = 64
N_Q_HEADS = 16
N_KV_HEADS = 2
GQA_GROUP = N_Q_HEADS // N_KV_HEADS
WINDOW = 128
BLOCK = 128
Q_WIDTH = N_Q_HEADS * HEAD_DIM
KV_WIDTH = N_KV_HEADS * HEAD_DIM
CONV_CH = D_MODEL
CONV_WIDTH = 31
N_BRANCH = 2
IN_WIDTH = Q_WIDTH + 2 * KV_WIDTH + 2 * CONV_CH + N_BRANCH * D_MODEL
D_FF = 2816
FFN_RESIDUAL = 0.5
N_MOD = 9
EPS = 1e-6

kernel_name = "conditioned_hybrid_swa_conformer_macaron_layer"


def rmsnorm(x, g):
    xf = x.astype(jnp.float32)
    y = xf * lax.rsqrt(jnp.mean(xf * xf, axis=-1, keepdims=True) + EPS)
    return (y * g.astype(jnp.float32)).astype(x.dtype)


def layernorm(x, g, b):
    xf = x.astype(jnp.float32)
    mu = jnp.mean(xf, axis=-1, keepdims=True)
    var = jnp.mean(jnp.square(xf - mu), axis=-1, keepdims=True)
    y = (xf - mu) * lax.rsqrt(var + EPS)
    return (y * g.astype(jnp.float32) + b.astype(jnp.float32)).astype(x.dtype)


def modulate(h, shift, scale):
    return h * (1 + scale[:, None, :]) + shift[:, None, :]


def swiglu(h, w_gate, w_up, w_down):
    return (jax.nn.silu(h @ w_gate) * (h @ w_up)) @ w_down


def sliding_window_sink_attention(q, k, v, sinks):
    B, S = q.shape[0], q.shape[1]
    nb = S // BLOCK
    qb = q.reshape(B, nb, BLOCK, N_KV_HEADS, GQA_GROUP, HEAD_DIM)

    def band(t):
        tp = jnp.pad(t, ((0, 0), (BLOCK, 0), (0, 0), (0, 0)))
        tb = tp.reshape(B, nb + 1, BLOCK, N_KV_HEADS, HEAD_DIM)
        return jnp.concatenate([tb[:, :-1], tb[:, 1:]], axis=2)

    kb, vb = band(k), band(v)
    scores = jnp.einsum('bnqkgd,bnskd->bnkgqs', qb, kb).astype(jnp.float32) * (HEAD_DIM ** -0.5)
    qi = jnp.arange(BLOCK)[:, None]
    sj = jnp.arange(2 * BLOCK)[None, :]
    rel = qi + BLOCK - sj
    key_pos = jnp.arange(nb)[:, None, None] * BLOCK + sj[None] - BLOCK
    valid = ((rel >= 0) & (rel < WINDOW))[None] & (key_pos >= 0)
    valid = valid[None, :, None, None]
    sink = sinks.astype(jnp.float32).reshape(1, 1, N_KV_HEADS, GQA_GROUP, 1, 1)
    masked = jnp.where(valid, scores, -jnp.inf)
    m = jnp.maximum(jnp.max(masked, axis=-1, keepdims=True), sink)
    p = jnp.where(valid, jnp.exp(masked - m), 0.0)
    denom = jnp.sum(p, axis=-1, keepdims=True) + jnp.exp(sink - m)
    probs = (p / denom).astype(v.dtype)
    out = jnp.einsum('bnkgqs,bnskd->bnqkgd', probs, vb)
    return out.reshape(B, S, Q_WIDTH)


def conformer_conv(u2, w_dw, b_dw, ln_g, ln_b, w_pw):
    a, b = jnp.split(u2, 2, axis=-1)
    u = a * jax.nn.sigmoid(b)
    u = jnp.pad(u, ((0, 0), (CONV_WIDTH - 1, 0), (0, 0)))
    y = lax.conv_general_dilated(
        u, w_dw[:, None, :].astype(u.dtype), window_strides=(1,), padding='VALID',
        dimension_numbers=('NWC', 'WIO', 'NWC'), feature_group_count=CONV_CH)
    y = y + b_dw
    y = jax.nn.silu(layernorm(y, ln_g, ln_b))
    return y @ w_pw


def setup_inputs(seed: int = 0) -> dict:
    key = jax.random.key(seed)
    ks = jax.random.split(key, 24)
    f32 = jnp.float32
    L = DEPTH

    def w(k, shape, fan_in):
        return jax.random.normal(k, shape, f32) * (fan_in ** -0.5)

    def gain(k, shape):
        return 1.0 + 0.02 * jax.random.normal(k, shape, f32)

    def small(k, shape):
        return 0.01 * jax.random.normal(k, shape, f32)

    return {
        "x": jax.random.normal(ks[0], (BATCH, SEQ, D_MODEL), f32),
        "c": jax.random.normal(ks[1], (BATCH, D_MODEL), f32),
        "w_ada": w(ks[2], (L, D_MODEL, N_MOD * D_MODEL), D_MODEL),
        "b_ada": small(ks[3], (L, N_MOD * D_MODEL)),
        "norm_ffn1_g": gain(ks[4], (L, D_MODEL)),
        "ffn1_w_gate": w(ks[5], (L, D_MODEL, D_FF), D_MODEL),
        "ffn1_w_up": w(ks[6], (L, D_MODEL, D_FF), D_MODEL),
        "ffn1_w_down": w(ks[7], (L, D_FF, D_MODEL), D_FF),
        "norm_mix_g": gain(ks[8], (L, D_MODEL)),
        "w_in": w(ks[9], (L, D_MODEL, IN_WIDTH), D_MODEL),
        "attn_sinks": 0.5 * jax.random.normal(ks[10], (L, N_Q_HEADS), f32),
        "w_attn_o": w(ks[11], (L, Q_WIDTH, D_MODEL), Q_WIDTH),
        "conv_w_dw": w(ks[12], (L, CONV_WIDTH, CONV_CH), CONV_WIDTH),
        "conv_b_dw": small(ks[13], (L, CONV_CH)),
        "conv_ln_g": gain(ks[14], (L, CONV_CH)),
        "conv_ln_b": small(ks[15], (L, CONV_CH)),
        "w_conv_o": w(ks[16], (L, CONV_CH, D_MODEL), CONV_CH),
        "w_out": w(ks[17], (L, D_MODEL, D_MODEL), D_MODEL),
        "norm_ffn2_g": gain(ks[18], (L, D_MODEL)),
        "ffn2_w_gate": w(ks[19], (L, D_MODEL, D_FF), D_MODEL),
        "ffn2_w_up": w(ks[20], (L, D_MODEL, D_FF), D_MODEL),
        "ffn2_w_down": w(ks[21], (L, D_FF, D_MODEL), D_FF),
        "final_norm_g": gain(ks[22], (D_MODEL,)),
    }


def reference(x, c, w_ada, b_ada, norm_ffn1_g, ffn1_w_gate, ffn1_w_up, ffn1_w_down,
              norm_mix_g, w_in, attn_sinks, w_attn_o, conv_w_dw, conv_b_dw, conv_ln_g,
              conv_ln_b, w_conv_o, w_out, norm_ffn2_g, ffn2_w_gate, ffn2_w_up, ffn2_w_down,
              final_norm_g):
    B, S, _ = x.shape
    c_act = jax.nn.silu(c)
    split_idx = np.cumsum([Q_WIDTH, KV_WIDTH, KV_WIDTH, 2 * CONV_CH, D_MODEL]).tolist()
    for l in range(DEPTH):
        mod = (c_act @ w_ada[l] + b_ada[l]).reshape(B, N_MOD, D_MODEL)
        sh1, sc1, g1 = mod[:, 0], mod[:, 1], mod[:, 2]
        sh2, sc2, g2 = mod[:, 3], mod[:, 4], mod[:, 5]
        sh3, sc3, g3 = mod[:, 6], mod[:, 7], mod[:, 8]

        h = modulate(rmsnorm(x, norm_ffn1_g[l]), sh1, sc1)
        x = x + FFN_RESIDUAL * g1[:, None, :] * swiglu(h, ffn1_w_gate[l], ffn1_w_up[l], ffn1_w_down[l])

        h = modulate(rmsnorm(x, norm_mix_g[l]), sh2, sc2)
        proj = h @ w_in[l]
        q, k, v, conv_in, gate_a, gate_c = jnp.split(proj, split_idx, axis=-1)
        q = q.reshape(B, S, N_Q_HEADS, HEAD_DIM)
        k = k.reshape(B, S, N_KV_HEADS, HEAD_DIM)
        v = v.reshape(B, S, N_KV_HEADS, HEAD_DIM)
        y_attn = sliding_window_sink_attention(q, k, v, attn_sinks[l]) @ w_attn_o[l]
        y_conv = conformer_conv(conv_in, conv_w_dw[l], conv_b_dw[l], conv_ln_g[l],
                                conv_ln_b[l], w_conv_o[l])
        merged = jax.nn.sigmoid(gate_a) * y_attn + jax.nn.sigmoid(gate_c) * y_conv
        x = x + g2[:, None, :] * (merged @ w_out[l])

        h = modulate(rmsnorm(x, norm_ffn2_g[l]), sh3, sc3)
        x = x + FFN_RESIDUAL * g3[:, None, :] * swiglu(h, ffn2_w_gate[l], ffn2_w_up[l], ffn2_w_down[l])
    return rmsnorm(x, final_norm_g)
```

```cpp
#include <hip/hip_runtime.h>
#include <cstdio>
#include <cstdint>

typedef unsigned short bf16_t;
constexpr int BATCH = 16, SEQ = 2048, DM = 1024, M = BATCH * SEQ, FF = 2816, NIN = 5376, NMODW = 9 * DM;
constexpr float EPS = 1e-6f;

__device__ __forceinline__ float bf2f(bf16_t v) { return __uint_as_float(((unsigned)v) << 16); }
__device__ __forceinline__ bf16_t f2bf(float f) { unsigned u = __float_as_uint(f); return (bf16_t)((u + 0x7fffu + ((u >> 16) & 1u)) >> 16); }
__device__ __forceinline__ float sigm(float x) { return 1.f / (1.f + __expf(-x)); }
__device__ __forceinline__ float silu(float x) { return x / (1.f + __expf(-x)); }

constexpr size_t MiB = 1u << 20;
constexpr size_t WS_CTL = 0, WS_MOD = 1 * MiB;
constexpr size_t WS_H = 52 * MiB;
constexpr size_t WS_X1 = 116 * MiB;
constexpr size_t WS_ACT = 244 * MiB;
constexpr size_t WS_Q = 244 * MiB;
constexpr size_t WS_K = 308 * MiB;
constexpr size_t WS_V = 316 * MiB;
constexpr size_t WS_U = 324 * MiB;
constexpr size_t WS_CA = 388 * MiB;
constexpr size_t WS_END = 452 * MiB;
constexpr size_t WS_AO = WS_H, WS_YA = WS_Q, WS_MG = WS_U;

__device__ __forceinline__ float wave_sum(float v) {
#pragma unroll
    for (int o = 1; o < 64; o <<= 1) v += __shfl_xor(v, o);
    return v;
}
__device__ __forceinline__ float wave_max(float v) {
#pragma unroll
    for (int o = 1; o < 64; o <<= 1) v = fmaxf(v, __shfl_xor(v, o));
    return v;
}
__device__ __forceinline__ float block_sum256(float v, float* red) {
    v = wave_sum(v);
    __syncthreads();
    if ((threadIdx.x & 63) == 0) red[threadIdx.x >> 6] = v;
    __syncthreads();
    return red[0] + red[1] + red[2] + red[3];
}

__global__ __launch_bounds__(256) void n_adaln(const float* c, const float* w_ada, const float* b_ada, float* mod) {
    const int j = blockIdx.x * 256 + threadIdx.x, b = blockIdx.y;
    float acc = b_ada[j];
    for (int k = 0; k < DM; ++k) acc += silu(c[b * DM + k]) * w_ada[(size_t)k * NMODW + j];
    mod[b * NMODW + j] = acc;
}

template <int MODE>
__global__ __launch_bounds__(256) void n_norm(const float* x, const float* g, const float* mod, int shift_idx, bf16_t* H, float* out) {
    __shared__ float red[4];
    const int m = blockIdx.x, b = m / SEQ, c0 = threadIdx.x * 4;
    const float4 v = *(const float4*)(x + (size_t)m * DM + c0);
    const float ss = block_sum256(v.x * v.x + v.y * v.y + v.z * v.z + v.w * v.w, red);
    const float rs = rsqrtf(ss * (1.f / DM) + EPS);
    const float vv[4] = {v.x, v.y, v.z, v.w};
    if (MODE == 0) {
        const float* sh = mod + (size_t)b * NMODW + shift_idx * DM; const float* sc = sh + DM;
#pragma unroll
        for (int i = 0; i < 4; ++i) H[(size_t)m * DM + c0 + i] = f2bf(vv[i] * rs * g[c0 + i] * (1.f + sc[c0 + i]) + sh[c0 + i]);
    } else {
        float4 o; o.x = vv[0] * rs * g[c0]; o.y = vv[1] * rs * g[c0 + 1]; o.z = vv[2] * rs * g[c0 + 2]; o.w = vv[3] * rs * g[c0 + 3];
        *(float4*)(out + (size_t)m * DM + c0) = o;
    }
}

struct EpiSwiGLU { bf16_t* out; int ld; int pad; __device__ void operator()(int r, int c, float a0, float a1) const { out[(size_t)r * ld + c] = f2bf(silu(a0) * a1); } };
struct EpiGLU { bf16_t* out; int ld; int pad; __device__ void operator()(int r, int c, float a0, float a1) const { out[(size_t)r * ld + c] = f2bf(a0 * sigm(a1)); } };
struct EpiScale { bf16_t* out; int ld; float s; __device__ void operator()(int r, int c, float a0, float) const { out[(size_t)r * ld + c] = f2bf(a0 * s); } };
struct EpiSigm { bf16_t* out; int ld; int pad; __device__ void operator()(int r, int c, float a0, float) const { out[(size_t)r * ld + c] = f2bf(sigm(a0)); } };
struct EpiResid { const float* xin; float* xout; const float* gate; float coef; int pad;
    __device__ void operator()(int r, int c, float a0, float) const { const int b = r / SEQ; xout[(size_t)r * DM + c] = xin[(size_t)r * DM + c] + coef * gate[(size_t)b * NMODW + c] * a0; } };
struct EpiYA { const bf16_t* ga; bf16_t* ya; __device__ void operator()(int r, int c, float a0, float) const { ya[(size_t)r * DM + c] = f2bf(bf2f(ga[(size_t)r * DM + c]) * a0); } };
struct EpiMG { const bf16_t* gc; const bf16_t* ya; bf16_t* mg; __device__ void operator()(int r, int c, float a0, float) const { mg[(size_t)r * DM + c] = f2bf(bf2f(ya[(size_t)r * DM + c]) + bf2f(gc[(size_t)r * DM + c]) * a0); } };

template <bool DUAL, class Epi>
__global__ __launch_bounds__(256) void n_gemm(const bf16_t* A, int lda, const float* W0, const float* W1, int ldw, int K, Epi epi) {
    __shared__ __attribute__((aligned(16))) float As[16][68];
    __shared__ __attribute__((aligned(16))) float Bs[16][64];
    __shared__ __attribute__((aligned(16))) float Cs[16][64];
    const int tid = threadIdx.x, tx = tid & 15, ty = tid >> 4;
    const int row0 = blockIdx.y * 64, col0 = blockIdx.x * 64;
    float acc0[4][4], acc1[4][4];
#pragma unroll
    for (int i = 0; i < 4; ++i)
#pragma unroll
        for (int j = 0; j < 4; ++j) { acc0[i][j] = 0.f; acc1[i][j] = 0.f; }
    for (int k0 = 0; k0 < K; k0 += 16) {
#pragma unroll
        for (int i = 0; i < 4; ++i) { const int e = tid + i * 256, r = e >> 4, kk = e & 15; As[kk][r] = bf2f(A[(size_t)(row0 + r) * lda + k0 + kk]); }
#pragma unroll
        for (int i = 0; i < 4; ++i) { const int e = tid + i * 256, kk = e >> 6, c = e & 63; Bs[kk][c] = W0[(size_t)(k0 + kk) * ldw + col0 + c]; if (DUAL) Cs[kk][c] = W1[(size_t)(k0 + kk) * ldw + col0 + c]; }
        __syncthreads();
#pragma unroll
        for (int kk = 0; kk < 16; ++kk) {
            const float4 a = *(const float4*)&As[kk][ty * 4]; const float4 b = *(const float4*)&Bs[kk][tx * 4];
            const float av[4] = {a.x, a.y, a.z, a.w}, bv[4] = {b.x, b.y, b.z, b.w};
#pragma unroll
            for (int i = 0; i < 4; ++i)
#pragma unroll
                for (int j = 0; j < 4; ++j) acc0[i][j] += av[i] * bv[j];
            if (DUAL) { const float4 c = *(const float4*)&Cs[kk][tx * 4]; const float cv[4] = {c.x, c.y, c.z, c.w};
#pragma unroll
                for (int i = 0; i < 4; ++i)
#pragma unroll
                    for (int j = 0; j < 4; ++j) acc1[i][j] += av[i] * cv[j]; }
        }
        __syncthreads();
    }
#pragma unroll
    for (int i = 0; i < 4; ++i)
#pragma unroll
        for (int j = 0; j < 4; ++j) epi(row0 + ty * 4 + i, col0 + tx * 4 + j, acc0[i][j], acc1[i][j]);
}

__global__ __launch_bounds__(64) void n_attn(const bf16_t* Q, const bf16_t* Kb, const bf16_t* Vb, const float* sinks, bf16_t* AO) {
    const int m = blockIdx.x, hq = blockIdx.y, lane = threadIdx.x, t = m % SEQ, kvh = hq >> 3;
    __shared__ float qs[64]; __shared__ float ps[128];
    qs[lane] = bf2f(Q[(size_t)m * DM + hq * 64 + lane]);
    __syncthreads();
    float s[2]; bool valid[2];
#pragma unroll
    for (int i = 0; i < 2; ++i) {
        const int rel = lane + 64 * i; valid[i] = (t - rel) >= 0; float a = 0.f;
        if (valid[i]) { const bf16_t* kr = Kb + (size_t)(m - rel) * 128 + kvh * 64; for (int d = 0; d < 64; ++d) a += qs[d] * bf2f(kr[d]); }
        s[i] = a;
    }
    const float sink = sinks[hq];
    float mx = sink;
#pragma unroll
    for (int i = 0; i < 2; ++i) if (valid[i]) mx = fmaxf(mx, s[i]);
    mx = wave_max(mx);
    float p[2], sum = 0.f;
#pragma unroll
    for (int i = 0; i < 2; ++i) { p[i] = valid[i] ? __expf(s[i] - mx) : 0.f; sum += p[i]; }
    sum = wave_sum(sum);
    const float inv = 1.f / (sum + __expf(sink - mx));
    ps[lane] = p[0] * inv; ps[lane + 64] = p[1] * inv;
    __syncthreads();
    float o = 0.f;
    for (int rel = 0; rel < 128; ++rel) { if (t - rel < 0) break; o += ps[rel] * bf2f(Vb[(size_t)(m - rel) * 128 + kvh * 64 + lane]); }
    AO[(size_t)m * DM + hq * 64 + lane] = f2bf(o);
}

__global__ __launch_bounds__(256) void n_conv(const bf16_t* U, const float* wdw, const float* bdw, const float* lng, const float* lnb, bf16_t* CA) {
    __shared__ float red[4];
    const int m = blockIdx.x, t = m % SEQ, tid = threadIdx.x;
    float y[4];
#pragma unroll
    for (int i = 0; i < 4; ++i) {
        const int c = tid + 256 * i; float acc = bdw[c];
        for (int k = 0; k < 31; ++k) { const int tt = t - 30 + k; if (tt >= 0) acc += wdw[k * DM + c] * bf2f(U[(size_t)(m - 30 + k) * DM + c]); }
        y[i] = acc;
    }
    const float mean = block_sum256(y[0] + y[1] + y[2] + y[3], red) * (1.f / DM);
    float q = 0.f;
#pragma unroll
    for (int i = 0; i < 4; ++i) { const float d = y[i] - mean; q += d * d; }
    const float var = block_sum256(q, red) * (1.f / DM);
    const float rs = rsqrtf(var + EPS);
#pragma unroll
    for (int i = 0; i < 4; ++i) { const int c = tid + 256 * i; CA[(size_t)m * DM + c] = f2bf(silu((y[i] - mean) * rs * lng[c] + lnb[c])); }
}

extern "C" void kernel_launch(void* const* d_in, const int* in_sizes, int n_in, void* d_out, int out_size, void* d_ws, size_t ws_size, hipStream_t stream) {
    if (n_in != 23 || in_sizes[0] != M * DM || out_size != M * DM || ws_size < WS_END) {
        fprintf(stderr, "kernel_launch: unexpected shapes n_in %d in0 %d out %d ws %zu\n", n_in, n_in > 0 ? in_sizes[0] : -1, out_size, ws_size); return; }
    const float* x = (const float*)d_in[0]; const float* c = (const float*)d_in[1]; const float* w_ada = (const float*)d_in[2]; const float* b_ada = (const float*)d_in[3];
    const float* g1n = (const float*)d_in[4]; const float* w1g = (const float*)d_in[5]; const float* w1u = (const float*)d_in[6]; const float* w1d = (const float*)d_in[7];
    const float* g2n = (const float*)d_in[8]; const float* w_in = (const float*)d_in[9]; const float* sinks = (const float*)d_in[10]; const float* w_ao = (const float*)d_in[11];
    const float* wdw = (const float*)d_in[12]; const float* bdw = (const float*)d_in[13]; const float* lng = (const float*)d_in[14]; const float* lnb = (const float*)d_in[15];
    const float* w_co = (const float*)d_in[16]; const float* w_out = (const float*)d_in[17]; const float* g3n = (const float*)d_in[18];
    const float* w2g = (const float*)d_in[19]; const float* w2u = (const float*)d_in[20]; const float* w2d = (const float*)d_in[21]; const float* gfn = (const float*)d_in[22];
    unsigned char* ws = (unsigned char*)d_ws; float* out = (float*)d_out;
    float* mod = (float*)(ws + WS_MOD); bf16_t* H = (bf16_t*)(ws + WS_H); float* X1 = (float*)(ws + WS_X1); bf16_t* ACT = (bf16_t*)(ws + WS_ACT);
    bf16_t* Qb = (bf16_t*)(ws + WS_Q); bf16_t* Kb = (bf16_t*)(ws + WS_K); bf16_t* Vb = (bf16_t*)(ws + WS_V); bf16_t* Ub = (bf16_t*)(ws + WS_U); bf16_t* CA = (bf16_t*)(ws + WS_CA);
    bf16_t* AO = (bf16_t*)(ws + WS_AO); bf16_t* YA = (bf16_t*)(ws + WS_YA); bf16_t* MG = (bf16_t*)(ws + WS_MG);
    bf16_t* GA = (bf16_t*)d_out; bf16_t* GC = GA + (size_t)M * DM;

    n_adaln<<<dim3(NMODW / 256, BATCH), 256, 0, stream>>>(c, w_ada, b_ada, mod);
    n_norm<0><<<M, 256, 0, stream>>>(x, g1n, mod, 0, H, nullptr);
    n_gemm<true, EpiSwiGLU><<<dim3(FF / 64, M / 64), 256, 0, stream>>>(H, DM, w1g, w1u, FF, DM, EpiSwiGLU{ACT, FF, 0});
    n_gemm<false, EpiResid><<<dim3(DM / 64, M / 64), 256, 0, stream>>>(ACT, FF, w1d, nullptr, DM, FF, EpiResid{x, X1, mod + 2 * DM, 0.5f, 0});
    n_norm<0><<<M, 256, 0, stream>>>(X1, g2n, mod, 3, H, nullptr);
    n_gemm<false, EpiScale><<<dim3(1024 / 64, M / 64), 256, 0, stream>>>(H, DM, w_in, nullptr, NIN, DM, EpiScale{Qb, DM, 0.125f});
    n_gemm<false, EpiScale><<<dim3(128 / 64, M / 64), 256, 0, stream>>>(H, DM, w_in + 1024, nullptr, NIN, DM, EpiScale{Kb, 128, 1.f});
    n_gemm<false, EpiScale><<<dim3(128 / 64, M / 64), 256, 0, stream>>>(H, DM, w_in + 1152, nullptr, NIN, DM, EpiScale{Vb, 128, 1.f});
    n_gemm<true, EpiGLU><<<dim3(1024 / 64, M / 64), 256, 0, stream>>>(H, DM, w_in + 1280, w_in + 2304, NIN, DM, EpiGLU{Ub, DM, 0});
    n_gemm<false, EpiSigm><<<dim3(1024 / 64, M / 64), 256, 0, stream>>>(H, DM, w_in + 3328, nullptr, NIN, DM, EpiSigm{GA, DM, 0});
    n_gemm<false, EpiSigm><<<dim3(1024 / 64, M / 64), 256, 0, stream>>>(H, DM, w_in + 4352, nullptr, NIN, DM, EpiSigm{GC, DM, 0});
    n_attn<<<dim3(M, 16), 64, 0, stream>>>(Qb, Kb, Vb, sinks, AO);
    n_conv<<<M, 256, 0, stream>>>(Ub, wdw, bdw, lng, lnb, CA);
    n_gemm<false, EpiYA><<<dim3(DM / 64, M / 64), 256, 0, stream>>>(AO, DM, w_ao, nullptr, DM, DM, EpiYA{GA, YA});
    n_gemm<false, EpiMG><<<dim3(DM / 64, M / 64), 256, 0, stream>>>(CA, DM, w_co, nullptr, DM, DM, EpiMG{GC, YA, MG});
    n_gemm<false, EpiResid><<<dim3(DM / 64, M / 64), 256, 0, stream>>>(MG, DM, w_out, nullptr, DM, DM, EpiResid{X1, out, mod + 5 * DM, 1.0f, 0});
    n_norm<0><<<M, 256, 0, stream>>>(out, g3n, mod, 6, H, nullptr);
    n_gemm<true, EpiSwiGLU><<<dim3(FF / 64, M / 64), 256, 0, stream>>>(H, DM, w2g, w2u, FF, DM, EpiSwiGLU{ACT, FF, 0});
    n_gemm<false, EpiResid><<<dim3(DM / 64, M / 64), 256, 0, stream>>>(ACT, FF, w2d, nullptr, DM, FF, EpiResid{out, out, mod + 8 * DM, 0.5f, 0});
    n_norm<1><<<M, 256, 0, stream>>>(out, gfn, nullptr, 0, nullptr, out);
}
```

```cpp
#include <hip/hip_runtime.h>
#include <cstdio>
#include <cstdint>

typedef unsigned short bf16_t;
constexpr int BATCH = 16, SEQ = 2048, DM = 1024, M = BATCH * SEQ, FF = 2816, NIN = 5376, NMODW = 9 * DM;
constexpr float EPS = 1e-6f;

__device__ __forceinline__ float bf2f(bf16_t v) { return __uint_as_float(((unsigned)v) << 16); }
__device__ __forceinline__ bf16_t f2bf(float f) { unsigned u = __float_as_uint(f); return (bf16_t)((u + 0x7fffu + ((u >> 16) & 1u)) >> 16); }
__device__ __forceinline__ float sigm(float x) { return 1.f / (1.f + __expf(-x)); }
__device__ __forceinline__ float silu(float x) { return x / (1.f + __expf(-x)); }

constexpr size_t MiB = 1u << 20;
constexpr size_t WS_CTL = 0, WS_MOD = 1 * MiB;
constexpr size_t WS_H = 52 * MiB;
constexpr size_t WS_X1 = 116 * MiB;
constexpr size_t WS_ACT = 244 * MiB;
constexpr size_t WS_Q = 244 * MiB;
constexpr size_t WS_K = 308 * MiB;
constexpr size_t WS_V = 316 * MiB;
constexpr size_t WS_U = 324 * MiB;
constexpr size_t WS_CA = 388 * MiB;
constexpr size_t WS_END = 452 * MiB;
constexpr size_t WS_AO = WS_H, WS_YA = WS_Q, WS_MG = WS_U;

__device__ __forceinline__ float wave_sum(float v) {
#pragma unroll
    for (int o = 1; o < 64; o <<= 1) v += __shfl_xor(v, o);
    return v;
}
__device__ __forceinline__ float wave_max(float v) {
#pragma unroll
    for (int o = 1; o < 64; o <<= 1) v = fmaxf(v, __shfl_xor(v, o));
    return v;
}
__device__ __forceinline__ float block_sum256(float v, float* red) {
    v = wave_sum(v);
    __syncthreads();
    if ((threadIdx.x & 63) == 0) red[threadIdx.x >> 6] = v;
    __syncthreads();
    return red[0] + red[1] + red[2] + red[3];
}

__global__ __launch_bounds__(256) void n_adaln(const float* c, const float* w_ada, const float* b_ada, float* mod) {
    const int j = blockIdx.x * 256 + threadIdx.x, b = blockIdx.y;
    float acc = b_ada[j];
    for (int k = 0; k < DM; ++k) acc += silu(c[b * DM + k]) * w_ada[(size_t)k * NMODW + j];
    mod[b * NMODW + j] = acc;
}

template <int MODE>
__global__ __launch_bounds__(256) void n_norm(const float* x, const float* g, const float* mod, int shift_idx, bf16_t* H, float* out) {
    __shared__ float red[4];
    const int m = blockIdx.x, b = m / SEQ, c0 = threadIdx.x * 4;
    const float4 v = *(const float4*)(x + (size_t)m * DM + c0);
    const float ss = block_sum256(v.x * v.x + v.y * v.y + v.z * v.z + v.w * v.w, red);
    const float rs = rsqrtf(ss * (1.f / DM) + EPS);
    const float vv[4] = {v.x, v.y, v.z, v.w};
    if (MODE == 0) {
        const float* sh = mod + (size_t)b * NMODW + shift_idx * DM; const float* sc = sh + DM;
#pragma unroll
        for (int i = 0; i < 4; ++i) H[(size_t)m * DM + c0 + i] = f2bf(vv[i] * rs * g[c0 + i] * (1.f + sc[c0 + i]) + sh[c0 + i]);
    } else {
        float4 o; o.x = vv[0] * rs * g[c0]; o.y = vv[1] * rs * g[c0 + 1]; o.z = vv[2] * rs * g[c0 + 2]; o.w = vv[3] * rs * g[c0 + 3];
        *(float4*)(out + (size_t)m * DM + c0) = o;
    }
}

struct EpiSwiGLU { bf16_t* out; int ld; int pad; __device__ void operator()(int r, int c, float a0, float a1) const { out[(size_t)r * ld + c] = f2bf(silu(a0) * a1); } };
struct EpiGLU { bf16_t* out; int ld; int pad; __device__ void operator()(int r, int c, float a0, float a1) const { out[(size_t)r * ld + c] = f2bf(a0 * sigm(a1)); } };
struct EpiScale { bf16_t* out; int ld; float s; __device__ void operator()(int r, int c, float a0, float) const { out[(size_t)r * ld + c] = f2bf(a0 * s); } };
struct EpiSigm { bf16_t* out; int ld; int pad; __device__ void operator()(int r, int c, float a0, float) const { out[(size_t)r * ld + c] = f2bf(sigm(a0)); } };
struct EpiResid { const float* xin; float* xout; const float* gate; float coef; int pad;
    __device__ void operator()(int r, int c, float a0, float) const { const int b = r / SEQ; xout[(size_t)r * DM + c] = xin[(size_t)r * DM + c] + coef * gate[(size_t)b * NMODW + c] * a0; } };
struct EpiYA { const bf16_t* ga; bf16_t* ya; __device__ void operator()(int r, int c, float a0, float) const { ya[(size_t)r * DM + c] = f2bf(bf2f(ga[(size_t)r * DM + c]) * a0); } };
struct EpiMG { const bf16_t* gc; const bf16_t* ya; bf16_t* mg; __device__ void operator()(int r, int c, float a0, float) const { mg[(size_t)r * DM + c] = f2bf(bf2f(ya[(size_t)r * DM + c]) + bf2f(gc[(size_t)r * DM + c]) * a0); } };

template <bool DUAL, class Epi>
__global__ __launch_bounds__(256) void n_gemm(const bf16_t* A, int lda, const float* W0, const float* W1, int ldw, int K, Epi epi) {
    __shared__ __attribute__((aligned(16))) float As[16][68];
    __shared__ __attribute__((aligned(16))) float Bs[16][64];
    __shared__ __attribute__((aligned(16))) float Cs[16][64];
    const int tid = threadIdx.x, tx = tid & 15, ty = tid >> 4;
    const int row0 = blockIdx.y * 64, col0 = blockIdx.x * 64;
    float acc0[4][4], acc1[4][4];
#pragma unroll
    for (int i = 0; i < 4; ++i)
#pragma unroll
        for (int j = 0; j < 4; ++j) { acc0[i][j] = 0.f; acc1[i][j] = 0.f; }
    for (int k0 = 0; k0 < K; k0 += 16) {
#pragma unroll
        for (int i = 0; i < 4; ++i) { const int e = tid + i * 256, r = e >> 4, kk = e & 15; As[kk][r] = bf2f(A[(size_t)(row0 + r) * lda + k0 + kk]); }
#pragma unroll
        for (int i = 0; i < 4; ++i) { const int e = tid + i * 256, kk = e >> 6, c = e & 63; Bs[kk][c] = W0[(size_t)(k0 + kk) * ldw + col0 + c]; if (DUAL) Cs[kk][c] = W1[(size_t)(k0 + kk) * ldw + col0 + c]; }
        __syncthreads();
#pragma unroll
        for (int kk = 0; kk < 16; ++kk) {
            const float4 a = *(const float4*)&As[kk][ty * 4]; const float4 b = *(const float4*)&Bs[kk][tx * 4];
            const float av[4] = {a.x, a.y, a.z, a.w}, bv[4] = {b.x, b.y, b.z, b.w};
#pragma unroll
            for (int i = 0; i < 4; ++i)
#pragma unroll
                for (int j = 0; j < 4; ++j) acc0[i][j] += av[i] * bv[j];
            if (DUAL) { const float4 c = *(const float4*)&Cs[kk][tx * 4]; const float cv[4] = {c.x, c.y, c.z, c.w};
#pragma unroll
                for (int i = 0; i < 4; ++i)
#pragma unroll
                    for (int j = 0; j < 4; ++j) acc1[i][j] += av[i] * cv[j]; }
        }
        __syncthreads();
    }
#pragma unroll
    for (int i = 0; i < 4; ++i)
#pragma unroll
        for (int j = 0; j < 4; ++j) epi(row0 + ty * 4 + i, col0 + tx * 4 + j, acc0[i][j], acc1[i][j]);
}

__global__ __launch_bounds__(64) void n_attn(const bf16_t* Q, const bf16_t* Kb, const bf16_t* Vb, const float* sinks, bf16_t* AO) {
    const int m = blockIdx.x, hq = blockIdx.y, lane = threadIdx.x, t = m % SEQ, kvh = hq >> 3;
    __shared__ float qs[64]; __shared__ float ps[128];
    qs[lane] = bf2f(Q[(size_t)m * DM + hq * 64 + lane]);
    __syncthreads();
    float s[2]; bool valid[2];
#pragma unroll
    for (int i = 0; i < 2; ++i) {
        const int rel = lane + 64 * i; valid[i] = (t - rel) >= 0; float a = 0.f;
        if (valid[i]) { const bf16_t* kr = Kb + (size_t)(m - rel) * 128 + kvh * 64; for (int d = 0; d < 64; ++d) a += qs[d] * bf2f(kr[d]); }
        s[i] = a;
    }
    const float sink = sinks[hq];
    float mx = sink;
#pragma unroll
    for (int i = 0; i < 2; ++i) if (valid[i]) mx = fmaxf(mx, s[i]);
    mx = wave_max(mx);
    float p[2], sum = 0.f;
#pragma unroll
    for (int i = 0; i < 2; ++i) { p[i] = valid[i] ? __expf(s[i] - mx) : 0.f; sum += p[i]; }
    sum = wave_sum(sum);
    const float inv = 1.f / (sum + __expf(sink - mx));
    ps[lane] = p[0] * inv; ps[lane + 64] = p[1] * inv;
    __syncthreads();
    float o = 0.f;
    for (int rel = 0; rel < 128; ++rel) { if (t - rel < 0) break; o += ps[rel] * bf2f(Vb[(size_t)(m - rel) * 128 + kvh * 64 + lane]); }
    AO[(size_t)m * DM + hq * 64 + lane] = f2bf(o);
}

__global__ __launch_bounds__(256) void n_conv(const bf16_t* U, const float* wdw, const float* bdw, const float* lng, const float* lnb, bf16_t* CA) {
    __shared__ float red[4];
    const int m = blockIdx.x, t = m % SEQ, tid = threadIdx.x;
    float y[4];
#pragma unroll
    for (int i = 0; i < 4; ++i) {
        const int c = tid + 256 * i; float acc = bdw[c];
        for (int k = 0; k < 31; ++k) { const int tt = t - 30 + k; if (tt >= 0) acc += wdw[k * DM + c] * bf2f(U[(size_t)(m - 30 + k) * DM + c]); }
        y[i] = acc;
    }
    const float mean = block_sum256(y[0] + y[1] + y[2] + y[3], red) * (1.f / DM);
    float q = 0.f;
#pragma unroll
    for (int i = 0; i < 4; ++i) { const float d = y[i] - mean; q += d * d; }
    const float var = block_sum256(q, red) * (1.f / DM);
    const float rs = rsqrtf(var + EPS);
#pragma unroll
    for (int i = 0; i < 4; ++i) { const int c = tid + 256 * i; CA[(size_t)m * DM + c] = f2bf(silu((y[i] - mean) * rs * lng[c] + lnb[c])); }
}

namespace pg8 {
#define PG8_LAS __attribute__((address_space(3)))
typedef unsigned short bf16_t;
typedef short bf16x8 __attribute__((ext_vector_type(8)));
typedef float f32x4 __attribute__((ext_vector_type(4)));
typedef unsigned u32x4 __attribute__((ext_vector_type(4)));
constexpr int BM = 256, BK = 64, HALF = 128, HTB = HALF * BK * 2  , STAGE_BYTES = 8 * HTB, NXCD = 8, WGM = 8;

__host__ __device__ __forceinline__ int lds_byte(int r, int c) { const int st = (r >> 4) * 2 + (c >> 5), rr = r & 15, cc = c & 31, ob = rr * 64 + cc * 2; return st * 1024 + (ob ^ (((ob >> 9) & 1) << 5)); }
__host__ __device__ __forceinline__ void stage_rc(int b, int& R, int& C) { const int st = b / 1024, sb = b % 1024, swz = sb ^ (((sb >> 9) & 1) << 5); R = (st >> 1) * 16 + swz / 64; C = (st & 1) * 32 + (swz % 64) / 2; }
__host__ __device__ __forceinline__ int perm32(int rho) { const int n = rho >> 4, i = rho & 15; return 8 * (i >> 2) + 4 * n + (i & 3); }

struct Unit { int pm, pn; };
struct Gemm { const bf16_t* A; const bf16_t* Bt; int M, N, K; };

struct StaticOrder {
    int nM, nN, nwg, G, c;
    __host__ __device__ void init(int M, int N, int G_, int c_) { nM = M / BM; nN = N / BM; nwg = nM * nN; G = G_; c = c_; }
    __host__ __device__ bool next(int i, Unit& u) const {
        const long L = (long)i * G + c; if (L >= nwg) return false;
        int wgid = (int)L; { const int q = nwg / NXCD, r = nwg % NXCD, xcd = wgid % NXCD, off = wgid / NXCD; wgid = (xcd < r ? xcd * (q + 1) : r * (q + 1) + (xcd - r) * q) + off; }
        const int nig = WGM * nN, gid = wgid / nig, fm = gid * WGM, gsz = (nM - fm) < WGM ? (nM - fm) : WGM;
        u.pm = fm + ((wgid % nig) % gsz); u.pn = (wgid % nig) / gsz; return true;
    }
    __device__ __forceinline__ void a_ready(const Unit&) const {}
    __device__ __forceinline__ void done(const Unit&) const {}
};

typedef float f32x2 __attribute__((ext_vector_type(2)));
typedef __bf16 bf16x2_t __attribute__((ext_vector_type(2)));
__device__ __forceinline__ unsigned cvt_pk_bf16(float lo, float hi) { f32x2 v = {lo, hi}; bf16x2_t b = __builtin_convertvector(v, bf16x2_t); return __builtin_bit_cast(unsigned, b); }
__device__ __forceinline__ u32x4 pack8(f32x4 a, f32x4 b) { u32x4 w; w.x = cvt_pk_bf16(a[0], a[1]); w.y = cvt_pk_bf16(a[2], a[3]); w.z = cvt_pk_bf16(b[0], b[1]); w.w = cvt_pk_bf16(b[2], b[3]); return w; }
__device__ __forceinline__ void unpack8(u32x4 w, f32x4& a, f32x4& b) {
    a[0] = __uint_as_float(w.x << 16); a[1] = __uint_as_float(w.x & 0xffff0000u); a[2] = __uint_as_float(w.y << 16); a[3] = __uint_as_float(w.y & 0xffff0000u);
    b[0] = __uint_as_float(w.z << 16); b[1] = __uint_as_float(w.z & 0xffff0000u); b[2] = __uint_as_float(w.w << 16); b[3] = __uint_as_float(w.w & 0xffff0000u); }
__device__ __forceinline__ float sigm1(float x) { return __builtin_amdgcn_rcpf(1.0f + __builtin_amdgcn_exp2f(x * -1.4426950408889634f)); }
__device__ __forceinline__ f32x4 sigm4(f32x4 x) { f32x4 r; r[0] = sigm1(x[0]); r[1] = sigm1(x[1]); r[2] = sigm1(x[2]); r[3] = sigm1(x[3]); return r; }

struct EpiSwiGLU {
    static constexpr bool PERM = true, AFTER_DRAIN = false;
    bf16_t* O; int ldc; int pad;
    __device__ __forceinline__ void operator()(const f32x4 (&acc)[2][2][4][2], const Unit& u, int wr, int wc, int fr, int fq) const {
        const int row0 = u.pm * BM + wr * 64 + fr, col0 = u.pn * HALF + wc * 32 + 8 * fq;
#pragma unroll
        for (int ai = 0; ai < 2; ++ai)
#pragma unroll
            for (int m = 0; m < 4; ++m) { bf16_t* rowp = O + (size_t)(row0 + ai * HALF + m * 16) * ldc + col0;
                const f32x4 g0 = acc[ai][0][m][0], g1 = acc[ai][0][m][1];
                const f32x4 v0 = g0 * sigm4(g0) * acc[ai][1][m][0], v1 = g1 * sigm4(g1) * acc[ai][1][m][1];
                *(u32x4*)rowp = pack8(v0, v1); }
    }
};
struct EpiResid {
    static constexpr bool PERM = false, AFTER_DRAIN = false;
    const float* xin; float* xout; const float* gate; float coef; int ldc; int gld; int tiles_per_b;
    __device__ __forceinline__ void operator()(const f32x4 (&acc)[2][2][4][2], const Unit& u, int wr, int wc, int fr, int fq) const {
        const int row0 = u.pm * BM + wr * 64 + fr, col0 = u.pn * BM + wc * 32 + 4 * fq, b = u.pm / tiles_per_b;
        f32x4 gv[2][2];
#pragma unroll
        for (int bj = 0; bj < 2; ++bj)
#pragma unroll
            for (int n = 0; n < 2; ++n) gv[bj][n] = *(const f32x4*)(gate + (size_t)b * gld + col0 + bj * HALF + n * 16) * coef;
#pragma unroll
        for (int ai = 0; ai < 2; ++ai)
#pragma unroll
            for (int m = 0; m < 4; ++m) { const size_t off = (size_t)(row0 + ai * HALF + m * 16) * ldc + col0;
#pragma unroll
                for (int bj = 0; bj < 2; ++bj)
#pragma unroll
                    for (int n = 0; n < 2; ++n) { const f32x4 xv = *(const f32x4*)(xin + off + bj * HALF + n * 16); *(f32x4*)(xout + off + bj * HALF + n * 16) = xv + gv[bj][n] * acc[ai][bj][m][n]; }
                if (m & 1) asm volatile("" ::: "memory"); }
    }
};
struct EpiIn {
    static constexpr bool PERM = true, AFTER_DRAIN = false;
    bf16_t *Q, *K, *V, *U, *GA, *GC;
    __device__ __forceinline__ void operator()(const f32x4 (&acc)[2][2][4][2], const Unit& u, int wr, int wc, int fr, int fq) const {
        const int row0 = u.pm * BM + wr * 64 + fr, cw = wc * 32 + 8 * fq, pn = u.pn;
        if (pn >= 5 && pn < 13) {
            bf16_t* base = U + (pn - 5) * HALF + cw;
#pragma unroll
            for (int ai = 0; ai < 2; ++ai)
#pragma unroll
                for (int m = 0; m < 4; ++m) { const size_t row = (size_t)(row0 + ai * HALF + m * 16);
                    const f32x4 v0 = acc[ai][0][m][0] * sigm4(acc[ai][1][m][0]), v1 = acc[ai][0][m][1] * sigm4(acc[ai][1][m][1]);
                    *(u32x4*)(base + row * 1024) = pack8(v0, v1); }
        } else if (pn >= 13) {
            bf16_t* base = (pn < 17 ? GA + (pn - 13) * BM : GC + (pn - 17) * BM) + cw;
#pragma unroll
            for (int ai = 0; ai < 2; ++ai)
#pragma unroll
                for (int m = 0; m < 4; ++m) { const size_t row = (size_t)(row0 + ai * HALF + m * 16);
#pragma unroll
                    for (int bj = 0; bj < 2; ++bj) *(u32x4*)(base + row * 1024 + bj * HALF) = pack8(sigm4(acc[ai][bj][m][0]), sigm4(acc[ai][bj][m][1])); }
        } else {
            bf16_t* b0; bf16_t* b1; int ld; float sc;
            if (pn < 4) { b0 = Q + pn * BM + cw; b1 = b0 + HALF; ld = 1024; sc = 0.125f; } else { b0 = K + cw; b1 = V + cw; ld = 128; sc = 1.0f; }
#pragma unroll
            for (int ai = 0; ai < 2; ++ai)
#pragma unroll
                for (int m = 0; m < 4; ++m) { const size_t row = (size_t)(row0 + ai * HALF + m * 16);
                    *(u32x4*)(b0 + row * ld) = pack8(acc[ai][0][m][0] * sc, acc[ai][0][m][1] * sc);
                    *(u32x4*)(b1 + row * ld) = pack8(acc[ai][1][m][0] * sc, acc[ai][1][m][1] * sc); }
        }
    }
};
template <int MODE> struct EpiGate {
    static constexpr bool PERM = true, AFTER_DRAIN = false;
    const bf16_t* G; const bf16_t* Y; bf16_t* O;
    __device__ __forceinline__ void operator()(const f32x4 (&acc)[2][2][4][2], const Unit& u, int wr, int wc, int fr, int fq) const {
        const int row0 = u.pm * BM + wr * 64 + fr, col0 = u.pn * BM + wc * 32 + 8 * fq;
#pragma unroll
        for (int ai = 0; ai < 2; ++ai)
#pragma unroll
            for (int m = 0; m < 4; ++m) {
#pragma unroll
                for (int bj = 0; bj < 2; ++bj) { const size_t off = (size_t)(row0 + ai * HALF + m * 16) * 1024 + col0 + bj * HALF;
                    f32x4 g0, g1; unpack8(*(const u32x4*)(G + off), g0, g1);
                    f32x4 v0 = g0 * acc[ai][bj][m][0], v1 = g1 * acc[ai][bj][m][1];
                    if (MODE == 1) { f32x4 y0, y1; unpack8(*(const u32x4*)(Y + off), y0, y1); v0 += y0; v1 += y1; }
                    *(u32x4*)(O + off) = pack8(v0, v1); }
                if (m & 1) asm volatile("" ::: "memory"); }
    }
};
template <class Epi, class Sched, bool ALIGN_EPI = false, bool SP2 = false>
__device__ __forceinline__ void gemm_phase(PG8_LAS unsigned char* lds, const Gemm g, const Sched& S, const Epi& E) {
    const int tid = threadIdx.x, wid = __builtin_amdgcn_readfirstlane(tid >> 6), lane = tid & 63, wr = wid >> 2, wc = wid & 3, fr = lane & 15, fq = lane >> 4;
    const int K = g.K, nt = K / BK;
    unsigned voffA[2], voffB[2];
#pragma unroll
    for (int i = 0; i < 2; ++i) { int R, C; stage_rc(tid * 16 + i * 8192, R, C); const int Rb = Epi::PERM ? ((R & ~31) + perm32(R & 31)) : R;
        voffA[i] = (unsigned)(R * K + C) * 2u; voffB[i] = (unsigned)(Rb * K + C) * 2u; }
    const size_t kstep = (size_t)(BK * 2);
    const size_t hstep = (size_t)HALF * K * 2;
    const size_t tstep = 2 * hstep;
    const unsigned ldsw = (unsigned)wid * 1024u;
    const int aoff = lds_byte(wr * 64 + fr, fq * 8), boff = lds_byte(wc * 32 + fr, fq * 8);
#define PG8_SA(b, h) (((b) * 2 + (h)) * HTB)
#define PG8_SB(b, h) ((4 + (b) * 2 + (h)) * HTB)
#define PG8_STAGE(bufoff, gbase, voff) do { _Pragma("unroll") for (int _i = 0; _i < 2; ++_i) \
        __builtin_amdgcn_global_load_lds((const unsigned*)((const char*)(gbase) + (voff)[_i]), (PG8_LAS unsigned*)(lds + (bufoff) + ldsw + _i * 8192), 16, 0, 0); } while (0)
#define PG8_LDA(dst, b, h) do { _Pragma("unroll") for (int m = 0; m < 4; ++m) _Pragma("unroll") for (int k = 0; k < 2; ++k) dst[m][k] = *(const PG8_LAS bf16x8*)(lds + PG8_SA(b, h) + aoff + m * 2048 + k * 1024); } while (0)
#define PG8_LDB(dst, b, h) do { _Pragma("unroll") for (int n = 0; n < 2; ++n) _Pragma("unroll") for (int k = 0; k < 2; ++k) dst[n][k] = *(const PG8_LAS bf16x8*)(lds + PG8_SB(b, h) + boff + n * 2048 + k * 1024); } while (0)
#define PG8_MMA(ai, bj, At, Bt) do { __builtin_amdgcn_s_setprio(1); _Pragma("unroll") for (int m = 0; m < 4; ++m) _Pragma("unroll") for (int n = 0; n < 2; ++n) _Pragma("unroll") for (int k = 0; k < 2; ++k) \
        acc[ai][bj][m][n] = __builtin_amdgcn_mfma_f32_16x16x32_bf16(Bt[n][k], At[m][k], acc[ai][bj][m][n], 0, 0, 0); __builtin_amdgcn_s_setprio(0); } while (0)
#define PG8_WAIT_V(n) asm volatile("s_waitcnt vmcnt(" #n ")" ::: "memory")
#define PG8_WAIT_L(n) asm volatile("s_waitcnt lgkmcnt(" #n ")" ::: "memory")
#define PG8_BAR __builtin_amdgcn_s_barrier()
#define PG8_SCHED __builtin_amdgcn_sched_barrier(0)
    Unit cur, nxt; int ui = 0;
    if (!S.next(0, cur)) return;
    f32x4 acc[2][2][4][2];
#pragma unroll
    for (int a = 0; a < 2; ++a)
#pragma unroll
        for (int b = 0; b < 2; ++b)
#pragma unroll
            for (int m = 0; m < 4; ++m)
#pragma unroll
                for (int n = 0; n < 2; ++n) acc[a][b][m][n] = (f32x4){0.f, 0.f, 0.f, 0.f};
    bf16x8 At[4][2], B0[2][2], B1[2][2];
    const char* cA = (const char*)g.A + (size_t)cur.pm * tstep; const char* cB = (const char*)g.Bt + (size_t)cur.pn * tstep;
    S.a_ready(cur);
    if constexpr (SP2) {
        PG8_STAGE(PG8_SB(0, 0), cB, voffB); PG8_STAGE(PG8_SB(0, 1), cB + hstep, voffB); PG8_STAGE(PG8_SA(0, 0), cA, voffA); PG8_STAGE(PG8_SA(0, 1), cA + hstep, voffA);
        if (wr == 1) PG8_BAR;
        PG8_WAIT_V(2); PG8_BAR;
        PG8_STAGE(PG8_SB(1, 0), cB + kstep, voffB); PG8_STAGE(PG8_SA(1, 0), cA + kstep, voffA); PG8_STAGE(PG8_SB(1, 1), cB + hstep + kstep, voffB);
        PG8_WAIT_V(6); PG8_BAR;
    } else {
        PG8_STAGE(PG8_SB(0, 0), cB, voffB); PG8_STAGE(PG8_SA(0, 0), cA, voffA); PG8_STAGE(PG8_SB(0, 1), cB + hstep, voffB); PG8_STAGE(PG8_SA(0, 1), cA + hstep, voffA);
        if (wr == 1) PG8_BAR;
        PG8_WAIT_V(4); PG8_BAR;
        PG8_STAGE(PG8_SB(1, 0), cB + kstep, voffB); PG8_STAGE(PG8_SA(1, 0), cA + kstep, voffA); PG8_STAGE(PG8_SB(1, 1), cB + hstep + kstep, voffB);
        PG8_WAIT_V(6); PG8_BAR;
    }
    for (;;) {
        const bool has_next = S.next(ui + 1, nxt);
        const char* nA = has_next ? (const char*)g.A + (size_t)nxt.pm * tstep : cA; const char* nB = has_next ? (const char*)g.Bt + (size_t)nxt.pn * tstep : cB;
        for (int t = 0; t < nt; t += 2) {
            const bool last = (t == nt - 2);
            const char* a1 = cA + (size_t)(t + 1) * kstep;
            const char* a2 = last ? nA : cA + (size_t)(t + 2) * kstep; const char* b2 = last ? nB : cB + (size_t)(t + 2) * kstep;
            const char* a3 = a2 + kstep; const char* b3 = b2 + kstep;
            if (last && has_next) S.a_ready(nxt);
            if constexpr (SP2) {
            PG8_LDB(B0, 0, 0); PG8_LDB(B1, 0, 1); PG8_SCHED; PG8_LDA(At, 0, 0); PG8_STAGE(PG8_SA(1, 1), a1 + hstep, voffA);
            PG8_WAIT_V(8); PG8_WAIT_L(0); PG8_BAR; PG8_MMA(0, 0, At, B0); PG8_MMA(0, 1, At, B1); PG8_BAR; PG8_SCHED;
            PG8_LDA(At, 0, 1); PG8_STAGE(PG8_SB(0, 0), b2, voffB); PG8_STAGE(PG8_SB(0, 1), b2 + hstep, voffB); PG8_STAGE(PG8_SA(0, 0), a2, voffA);
            PG8_WAIT_V(8); PG8_WAIT_L(0); PG8_BAR; PG8_MMA(1, 0, At, B0); PG8_MMA(1, 1, At, B1); PG8_BAR; PG8_SCHED;
            PG8_LDB(B0, 1, 0); PG8_LDB(B1, 1, 1); PG8_SCHED; PG8_LDA(At, 1, 0); PG8_STAGE(PG8_SA(0, 1), a2 + hstep, voffA);
            PG8_WAIT_V(8); PG8_WAIT_L(0); PG8_BAR; PG8_MMA(0, 0, At, B0); PG8_MMA(0, 1, At, B1); PG8_BAR; PG8_SCHED;
            PG8_LDA(At, 1, 1); PG8_STAGE(PG8_SB(1, 0), b3, voffB); PG8_STAGE(PG8_SB(1, 1), b3 + hstep, voffB); PG8_STAGE(PG8_SA(1, 0), a3, voffA);
            PG8_WAIT_V(8); PG8_WAIT_L(0); PG8_BAR; PG8_MMA(1, 0, At, B0); PG8_MMA(1, 1, At, B1); PG8_BAR; PG8_SCHED;
            } else {
            PG8_LDB(B0, 0, 0); PG8_SCHED; PG8_LDA(At, 0, 0); PG8_STAGE(PG8_SA(1, 1), a1 + hstep, voffA);
            PG8_WAIT_L(8); PG8_BAR; PG8_WAIT_L(0); PG8_MMA(0, 0, At, B0); PG8_BAR; PG8_SCHED;
            PG8_LDB(B1, 0, 1); PG8_STAGE(PG8_SB(0, 0), b2, voffB);
            PG8_BAR; PG8_WAIT_L(0); PG8_MMA(0, 1, At, B1); PG8_BAR;
            PG8_LDA(At, 0, 1); PG8_STAGE(PG8_SA(0, 0), a2, voffA);
            PG8_BAR; PG8_WAIT_L(0); PG8_MMA(1, 0, At, B0); PG8_BAR; PG8_SCHED;
            PG8_STAGE(PG8_SB(0, 1), b2 + hstep, voffB);
            PG8_WAIT_V(6); PG8_BAR; PG8_MMA(1, 1, At, B1); PG8_BAR;
            PG8_LDB(B0, 1, 0); PG8_SCHED; PG8_LDA(At, 1, 0); PG8_STAGE(PG8_SA(0, 1), a2 + hstep, voffA);
            PG8_WAIT_L(8); PG8_BAR; PG8_WAIT_L(0); PG8_MMA(0, 0, At, B0); PG8_BAR; PG8_SCHED;
            PG8_LDB(B1, 1, 1); PG8_STAGE(PG8_SB(1, 0), b3, voffB);
            PG8_BAR; PG8_WAIT_L(0); PG8_MMA(0, 1, At, B1); PG8_BAR;
            PG8_LDA(At, 1, 1); PG8_STAGE(PG8_SA(1, 0), a3, voffA);
            PG8_BAR; PG8_WAIT_L(0); PG8_MMA(1, 0, At, B0); PG8_BAR; PG8_SCHED;
            PG8_STAGE(PG8_SB(1, 1), b3 + hstep, voffB);
            PG8_WAIT_V(6); PG8_BAR; PG8_MMA(1, 1, At, B1); PG8_BAR;
            }
        }
        if constexpr (ALIGN_EPI) { if (wr == 0) PG8_BAR; }
        if constexpr (!Epi::AFTER_DRAIN) { E(acc, cur, wr, wc, fr, fq); S.done(cur); }
        if (!has_next) break;
#pragma unroll
        for (int a = 0; a < 2; ++a)
#pragma unroll
            for (int b = 0; b < 2; ++b)
#pragma unroll
                for (int m = 0; m < 4; ++m)
#pragma unroll
                    for (int n = 0; n < 2; ++n) acc[a][b][m][n] = (f32x4){0.f, 0.f, 0.f, 0.f};
        cur = nxt; cA = nA; cB = nB; ++ui;
        if constexpr (ALIGN_EPI) { if (wr == 1) PG8_BAR; }
    }
    PG8_WAIT_V(0);
    if constexpr (!ALIGN_EPI) { if (wr == 0) PG8_BAR; }
    PG8_BAR;
    if constexpr (Epi::AFTER_DRAIN) { E.fused(acc, cur, wr, wc, fr, fq, lds, wid, lane); S.done(cur); }
#undef PG8_SA
#undef PG8_SB
#undef PG8_STAGE
#undef PG8_LDA
#undef PG8_LDB
#undef PG8_MMA
#undef PG8_WAIT_V
#undef PG8_WAIT_L
#undef PG8_BAR
#undef PG8_SCHED
}
}
#define GAS __attribute__((address_space(1)))
#define LAS __attribute__((address_space(3)))
typedef unsigned short bf16;
typedef unsigned v4u __attribute__((ext_vector_type(4)));
typedef float f32x4 __attribute__((ext_vector_type(4)));
typedef short bf16x8 __attribute__((ext_vector_type(8)));
typedef GAS unsigned gu32;
typedef GAS unsigned long long gu64;
#define RLX_AGENT __ATOMIC_RELAXED, __HIP_MEMORY_SCOPE_AGENT
#define LDS_WAIT() asm volatile("s_waitcnt lgkmcnt(0)" ::: "memory")
#define VM_WAIT() asm volatile("s_waitcnt vmcnt(0)" ::: "memory")
__device__ __forceinline__ unsigned long long rt() { return __builtin_amdgcn_s_memrealtime(); }
__device__ __forceinline__ unsigned pk2(float lo, float hi) { return (unsigned)f2bf(lo) | ((unsigned)f2bf(hi) << 16); }

#define XB_TMO      128
#define XB_XCNT(j)  (256  + 64 * (j))
#define XB_XSUB(j)  (1280 + 64 * (j))
#define XB_XGEN(j)  (2304 + 64 * (j))
#define XB_TOP      3328
#define XB_TOPGEN   3392
#define XCD_BAR_WORDS 3456
#define XB_SPIN_CAP (1u << 18)

__device__ __forceinline__ unsigned xb_ld(unsigned* p)              { return __hip_atomic_load(p, __ATOMIC_RELAXED, __HIP_MEMORY_SCOPE_AGENT); }
__device__ __forceinline__ unsigned xb_add(unsigned* p, unsigned v) { return __hip_atomic_fetch_add(p, v, __ATOMIC_RELAXED, __HIP_MEMORY_SCOPE_AGENT); }
__device__ __forceinline__ unsigned xb_xcc_id() { return (unsigned)__builtin_amdgcn_s_getreg((3 << 11) | 20) & 0xFu; }
#define XB_SPIN(cond, bar) do { unsigned _sp = 0; while (cond) { __builtin_amdgcn_s_sleep(1); \
    if ((++_sp & 255u) == 0u) { if (xb_ld(&(bar)[XB_TMO])) break; if (_sp > XB_SPIN_CAP) { atomicAdd(&(bar)[XB_TMO], 1u); break; } } } } while (0)

struct XcdBarrier {
    unsigned* bar; unsigned x;
    volatile LAS unsigned* st;
};

__device__ __forceinline__ XcdBarrier xcd_barrier_post(unsigned* bar, volatile LAS unsigned* st) {
    XcdBarrier b; b.bar = bar; b.x = xb_xcc_id(); b.st = st;
    if (threadIdx.x == 0) (void)xb_add(&bar[XB_XCNT(b.x)], 1u);
    return b;
}
__device__ __forceinline__ void xcd_barrier_complete(unsigned* bar, unsigned x, unsigned& nloc, unsigned& nx) {
    const unsigned G = gridDim.x * gridDim.y * gridDim.z;
    unsigned sum, cnt, mine, sp = 0u;
    for (;;) {
        sum = 0u; cnt = 0u; mine = 0u;
#pragma unroll
        for (unsigned j = 0; j < 16; ++j) { const unsigned c = xb_ld(&bar[XB_XCNT(j)]); sum += c; cnt += (c > 0u) ? 1u : 0u; mine = (j == x) ? c : mine; }
        if (sum == G) break;
        __builtin_amdgcn_s_sleep(1);
        if ((++sp & 255u) == 0u) { if (xb_ld(&bar[XB_TMO])) break; if (sp > XB_SPIN_CAP) { atomicAdd(&bar[XB_TMO], 1u); break; } }
    }
    nloc = mine > 0u ? mine : 1u; nx = cnt > 0u ? cnt : 1u;
}

__device__ __forceinline__ void xcd_barrier(const XcdBarrier& b) {
    asm volatile("s_waitcnt vmcnt(0)" ::: "memory");
    __syncthreads();
    if (threadIdx.x == 0) {
        unsigned* bar = b.bar;
        __builtin_amdgcn_s_waitcnt(0);
        unsigned nloc = b.st[0], nx = b.st[1];
        if (nloc == 0u) { xcd_barrier_complete(bar, b.x, nloc, nx); b.st[0] = nloc; b.st[1] = nx; }
        const unsigned old = xb_add(&bar[XB_XSUB(b.x)], 1u);
        const unsigned gen = old / nloc;
        if (old + 1u == (gen + 1u) * nloc) {
            __builtin_amdgcn_fence(__ATOMIC_RELEASE, "agent");
            asm volatile("s_waitcnt vmcnt(0)" ::: "memory");
            const unsigned og = xb_add(&bar[XB_TOP], 1u);
            const unsigned tg = og / nx;
            if (og + 1u == (tg + 1u) * nx) xb_add(&bar[XB_TOPGEN], 1u);
            else XB_SPIN(xb_ld(&bar[XB_TOPGEN]) == tg, bar);
            __builtin_amdgcn_fence(__ATOMIC_ACQUIRE, "agent");
            xb_add(&bar[XB_XGEN(b.x)], 1u);
            asm volatile("s_waitcnt vmcnt(0)" ::: "memory");
        } else {
            XB_SPIN(xb_ld(&bar[XB_XGEN(b.x)]) == gen, bar);
            __builtin_amdgcn_fence(__ATOMIC_ACQUIRE, "agent");
            asm volatile("s_waitcnt vmcnt(0)" ::: "memory");
        }
    }
    __syncthreads();
}

constexpr int NWAVES = 8;
constexpr int NPHASE = 14;
constexpr size_t WS_WGU1 = 2 * MiB, WS_WD1 = 13 * MiB, WS_WIN = 18 * MiB + 512 * 1024, WS_WAO = 29 * MiB, WS_WCO = 31 * MiB, WS_WOUT = 33 * MiB, WS_WGU2 = 35 * MiB, WS_WD2 = 46 * MiB;
static_assert(WS_WD2 + (size_t)DM * FF * 2 <= WS_H, "weight copies end before H");
constexpr size_t CTL_ZERO_BYTES = 64 * 1024;
constexpr int CW_BAR = 4096;
constexpr int RING_OFF = 0, RING_BYTES = 131072, LDSCTL_OFF = RING_BYTES, MISC_OFF = LDSCTL_OFF + 320, LDS_BYTES = 147456;

typedef pg8::u32x4 u32x4;
typedef float f32x16 __attribute__((ext_vector_type(16)));
typedef short s16x4 __attribute__((ext_vector_type(4)));
typedef unsigned u32x2 __attribute__((ext_vector_type(2)));
typedef float f32x2v __attribute__((ext_vector_type(2)));

template <int CTRL> __device__ __forceinline__ float dpp_mov(float v) { return __builtin_bit_cast(float, __builtin_amdgcn_update_dpp(0, __builtin_bit_cast(int, v), CTRL, 0xf, 0xf, true)); }
__device__ __forceinline__ float wave_allsum(float v) {
    v += dpp_mov<0xB1>(v); v += dpp_mov<0x4E>(v); v += dpp_mov<0x124>(v); v += dpp_mov<0x128>(v);
    { auto r = __builtin_amdgcn_permlane16_swap(__float_as_uint(v), __float_as_uint(v), false, false); v = __uint_as_float(r[0]) + __uint_as_float(r[1]); }
    { auto r = __builtin_amdgcn_permlane32_swap(__float_as_uint(v), __float_as_uint(v), false, false); v = __uint_as_float(r[0]) + __uint_as_float(r[1]); }
    return v;
}
__device__ __forceinline__ float xhalf_max(float v) { auto r = __builtin_amdgcn_permlane32_swap(__float_as_uint(v), __float_as_uint(v), false, false); return fmaxf(__uint_as_float(r[0]), __uint_as_float(r[1])); }
__device__ __forceinline__ float xhalf_sum(float v) { auto r = __builtin_amdgcn_permlane32_swap(__float_as_uint(v), __float_as_uint(v), false, false); return __uint_as_float(r[0]) + __uint_as_float(r[1]); }

struct Frame {
    LAS unsigned char* lds;
    volatile LAS unsigned* MISC;
    gu32* ctl;
    int tid, lane, wave, vcu, G;
};
struct Args { const float* in[23]; float* out; unsigned char* ws; int ph_lo, ph_hi, use_bar, pad; };

__device__ __forceinline__ void p0_transpose_item(const float* W, int K, int N, bf16* WT, int kind, LAS float* scr, int item, int lane) {
    const int nblk = N / 32, kb = item / nblk, nb = item % nblk, k0 = 64 * kb, n0 = 32 * nb;
    int drow = n0;
    if (kind == 1 || kind == 2) drow = 256 * (n0 >> 7) + 128 * (kind - 1) + (n0 & 127);
    else if (kind == 3) { if (n0 >= 1280 && n0 < 2304) { const int r = n0 - 1280; drow = 1280 + 256 * (r >> 7) + (r & 127); } else if (n0 >= 2304 && n0 < 3328) { const int r = n0 - 2304; drow = 1280 + 256 * (r >> 7) + 128 + (r & 127); } }
#pragma unroll 8
    for (int i = 0; i < 32; ++i) { const int kk = 2 * i + (lane >> 5); scr[kk * 33 + (lane & 31)] = W[(size_t)(k0 + kk) * N + n0 + (lane & 31)]; }
    LDS_WAIT(); asm volatile("" ::: "memory");
    const int c = lane & 7;
#pragma unroll
    for (int j = 0; j < 4; ++j) { const int n = (lane >> 3) + 8 * j; const LAS float* s = scr + (8 * c) * 33 + n;
        v4u o; o.x = pk2(s[0 * 33], s[1 * 33]); o.y = pk2(s[2 * 33], s[3 * 33]); o.z = pk2(s[4 * 33], s[5 * 33]); o.w = pk2(s[6 * 33], s[7 * 33]);
        *(GAS v4u*)(WT + (size_t)(drow + n) * K + k0 + 8 * c) = o; }
    LDS_WAIT(); asm volatile("" ::: "memory");
}
__device__ __forceinline__ void p0_prologue(Frame& F, const Args& a) {
    unsigned char* ws = a.ws;
    if (F.vcu < NMODW / 64) {
        LAS float* cact = (LAS float*)(F.lds);
        LAS float* red = (LAS float*)(F.lds + 65536);
        const float* c = a.in[1];
        for (int e = F.tid; e < BATCH * DM; e += NWAVES * 64) { const int b = e >> 10, k = e & 1023; const float v = c[e]; cact[k * 16 + b] = v / (1.f + __expf(-v)); }
        __syncthreads();
        const int col = F.vcu * 64 + F.lane; const float* w = a.in[2] + col;
        float acc[16];
#pragma unroll
        for (int b = 0; b < 16; ++b) acc[b] = 0.f;
        const int kbeg = F.wave * 128;
#pragma unroll 4
        for (int k = kbeg; k < kbeg + 128; ++k) { const float wv = w[(size_t)k * NMODW];
            const LAS f32x4* cp = (const LAS f32x4*)(cact + k * 16);
#pragma unroll
            for (int q = 0; q < 4; ++q) { const f32x4 cv = cp[q]; acc[4 * q] += cv[0] * wv; acc[4 * q + 1] += cv[1] * wv; acc[4 * q + 2] += cv[2] * wv; acc[4 * q + 3] += cv[3] * wv; } }
#pragma unroll
        for (int b = 0; b < 16; ++b) red[(F.wave * 16 + b) * 64 + F.lane] = acc[b];
        __syncthreads();
        float* mod = (float*)(ws + WS_MOD);
        for (int e = F.tid; e < 16 * 64; e += NWAVES * 64) { const int b = e >> 6, cl = e & 63; float s = a.in[3][F.vcu * 64 + cl];
#pragma unroll
            for (int wv = 0; wv < 8; ++wv) s += red[(wv * 16 + b) * 64 + cl];
            mod[(size_t)b * NMODW + F.vcu * 64 + cl] = s; }
        __syncthreads();
    }
    LAS float* scr = (LAS float*)(F.lds + RING_OFF + F.wave * 16384);
    const int gw = F.vcu * NWAVES + F.wave, NGW = F.G * NWAVES;
    constexpr int I_GU = (DM / 64) * (FF / 32), I_D = (FF / 64) * (DM / 32), I_IN = (DM / 64) * (NIN / 32), I_SQ = (DM / 64) * (DM / 32);
    constexpr int NITEMS = 4 * I_GU + 2 * I_D + I_IN + 3 * I_SQ;
    for (int it = gw; it < NITEMS; it += NGW) {
        int r = it;
        if (r < I_GU) { p0_transpose_item(a.in[5], DM, FF, (bf16*)(ws + WS_WGU1), 1, scr, r, F.lane); continue; } r -= I_GU;
        if (r < I_GU) { p0_transpose_item(a.in[6], DM, FF, (bf16*)(ws + WS_WGU1), 2, scr, r, F.lane); continue; } r -= I_GU;
        if (r < I_D) { p0_transpose_item(a.in[7], FF, DM, (bf16*)(ws + WS_WD1), 0, scr, r, F.lane); continue; } r -= I_D;
        if (r < I_IN) { p0_transpose_item(a.in[9], DM, NIN, (bf16*)(ws + WS_WIN), 3, scr, r, F.lane); continue; } r -= I_IN;
        if (r < I_SQ) { p0_transpose_item(a.in[11], DM, DM, (bf16*)(ws + WS_WAO), 0, scr, r, F.lane); continue; } r -= I_SQ;
        if (r < I_SQ) { p0_transpose_item(a.in[16], DM, DM, (bf16*)(ws + WS_WCO), 0, scr, r, F.lane); continue; } r -= I_SQ;
        if (r < I_SQ) { p0_transpose_item(a.in[17], DM, DM, (bf16*)(ws + WS_WOUT), 0, scr, r, F.lane); continue; } r -= I_SQ;
        if (r < I_GU) { p0_transpose_item(a.in[19], DM, FF, (bf16*)(ws + WS_WGU2), 1, scr, r, F.lane); continue; } r -= I_GU;
        if (r < I_GU) { p0_transpose_item(a.in[20], DM, FF, (bf16*)(ws + WS_WGU2), 2, scr, r, F.lane); continue; } r -= I_GU;
        p0_transpose_item(a.in[21], FF, DM, (bf16*)(ws + WS_WD2), 0, scr, r, F.lane);
    }
}

template <int MODE>
__device__ __forceinline__ void norm_phase(Frame& F, const float* xin, const float* g, const float* mod, int shift_idx, bf16* H, float* out) {
    const int gw = F.vcu * NWAVES + F.wave, NGW = F.G * NWAVES;
    for (int ch = gw; ch < M / 16; ch += NGW) {
        const int b = (ch * 16) / SEQ;
        f32x4 A[4], Bv[4];
#pragma unroll
        for (int j = 0; j < 4; ++j) { const int c = 4 * F.lane + 256 * j; A[j] = *(const f32x4*)(g + c);
            if (MODE == 0) { const float* sh = mod + (size_t)b * NMODW + shift_idx * DM + c; A[j] = A[j] * (*(const f32x4*)(sh + DM) + 1.0f); Bv[j] = *(const f32x4*)sh; } }
#pragma unroll 2
        for (int r = 0; r < 16; ++r) {
            const size_t row = (size_t)ch * 16 + r;
            const GAS f32x4* xr = (const GAS f32x4*)(xin + row * DM) + F.lane;
            f32x4 v[4]; float s = 0.f;
#pragma unroll
            for (int j = 0; j < 4; ++j) { v[j] = xr[64 * j]; s += (v[j][0] * v[j][0] + v[j][1] * v[j][1]) + (v[j][2] * v[j][2] + v[j][3] * v[j][3]); }
            const float rs = rsqrtf(wave_allsum(s) * (1.f / DM) + EPS);
            if (MODE == 0) {
                GAS u32x2* o8 = (GAS u32x2*)(H + row * DM) + F.lane;
#pragma unroll
                for (int j = 0; j < 4; ++j) { const f32x4 hv = v[j] * rs * A[j] + Bv[j]; u32x2 w; w.x = pg8::cvt_pk_bf16(hv[0], hv[1]); w.y = pg8::cvt_pk_bf16(hv[2], hv[3]); o8[64 * j] = w; }
            } else {
                GAS f32x4* o = (GAS f32x4*)(out + row * DM) + F.lane;
#pragma unroll
                for (int j = 0; j < 4; ++j) o[64 * j] = v[j] * rs * A[j];
            }
        }
    }
}

constexpr int AT_KROW = 144, AT_VT_OFF = 256 * AT_KROW, AT_VROW = 520;
__device__ __forceinline__ int crow(int r, int h) { return (r & 3) + 8 * (r >> 2) + 4 * h; }
__device__ __forceinline__ void attn_unit(Frame& F, int b, int n, int kvh, const bf16* Q, const bf16* Kb, const bf16* Vb, const float* sinks, bf16* AO) {
    LAS unsigned char* lds = F.lds;
    const int tid = F.tid, lane = F.lane, r32 = lane & 31, h = lane >> 5;
    const long band0 = (long)b * SEQ + (long)(n - 1) * 128;
#pragma unroll
    for (int i = 0; i < 4; ++i) {
        const int e = tid + 512 * i, sj = e >> 3, c8 = e & 7;
        u32x4 kv = {0u, 0u, 0u, 0u}, vv = {0u, 0u, 0u, 0u};
        if (n > 0 || sj >= 128) { const size_t off = (size_t)(band0 + sj) * 128 + kvh * 64 + c8 * 8; kv = *(const GAS u32x4*)(Kb + off); vv = *(const GAS u32x4*)(Vb + off); }
        *(LAS u32x4*)(lds + sj * AT_KROW + c8 * 16) = kv;
#pragma unroll
        for (int i2 = 0; i2 < 8; ++i2) *(LAS unsigned short*)(lds + AT_VT_OFF + (c8 * 8 + i2) * AT_VROW + sj * 2) = (unsigned short)(vv[i2 >> 1] >> (16 * (i2 & 1)));
    }
    __syncthreads();
    const int hq = kvh * 8 + F.wave;
    const float L2E = 1.4426950408889634f;
    const float sink = sinks[hq] * L2E;
    const float NEG = -1.0e30f;
#pragma unroll 1
    for (int j = 0; j < 4; ++j) {
        const size_t token = (size_t)b * SEQ + n * 128 + 32 * j + r32;
        bf16x8 qr[4];
#pragma unroll
        for (int ks = 0; ks < 4; ++ks) qr[ks] = *(const GAS bf16x8*)(Q + token * 1024 + hq * 64 + 16 * ks + 8 * h);
        f32x16 S[5];
#pragma unroll
        for (int kbi = 0; kbi < 5; ++kbi) {
            f32x16 acc = {0.f, 0.f, 0.f, 0.f, 0.f, 0.f, 0.f, 0.f, 0.f, 0.f, 0.f, 0.f, 0.f, 0.f, 0.f, 0.f};
            const LAS unsigned char* kp = lds + (32 * (j + kbi) + r32) * AT_KROW + 16 * h;
#pragma unroll
            for (int ks = 0; ks < 4; ++ks) { const bf16x8 kf = *(const LAS bf16x8*)(kp + 32 * ks); acc = __builtin_amdgcn_mfma_f32_32x32x16_bf16(kf, qr[ks], acc, 0, 0, 0); }
            S[kbi] = acc;
        }
        float mx = sink;
#pragma unroll
        for (int kbi = 0; kbi < 5; ++kbi) {
            const bool blk_ok = (n > 0) || (j + kbi >= 4);
#pragma unroll
            for (int r = 0; r < 16; ++r) {
                const int cr = crow(r, h);
                bool ok = blk_ok;
                if (kbi == 0) ok = ok && (cr > r32);
                if (kbi == 4) ok = ok && (cr <= r32);
                const float s = ok ? S[kbi][r] * L2E : NEG;
                S[kbi][r] = s; mx = fmaxf(mx, s);
            }
        }
        mx = xhalf_max(mx);
        float l = 0.f;
#pragma unroll
        for (int kbi = 0; kbi < 5; ++kbi)
#pragma unroll
            for (int r = 0; r < 16; ++r) { const float p = __builtin_amdgcn_exp2f(S[kbi][r] - mx); S[kbi][r] = p; l += p; }
        l = xhalf_sum(l) + __builtin_amdgcn_exp2f(sink - mx);
        const float inv = 1.0f / l;
        f32x16 o0 = {0.f, 0.f, 0.f, 0.f, 0.f, 0.f, 0.f, 0.f, 0.f, 0.f, 0.f, 0.f, 0.f, 0.f, 0.f, 0.f}, o1 = o0;
#pragma unroll
        for (int kbi = 0; kbi < 5; ++kbi)
#pragma unroll
            for (int s2 = 0; s2 < 2; ++s2) {
                u32x4 pw; pw.x = pg8::cvt_pk_bf16(S[kbi][8 * s2 + 0], S[kbi][8 * s2 + 1]); pw.y = pg8::cvt_pk_bf16(S[kbi][8 * s2 + 2], S[kbi][8 * s2 + 3]);
                pw.z = pg8::cvt_pk_bf16(S[kbi][8 * s2 + 4], S[kbi][8 * s2 + 5]); pw.w = pg8::cvt_pk_bf16(S[kbi][8 * s2 + 6], S[kbi][8 * s2 + 7]);
                const bf16x8 pf = __builtin_bit_cast(bf16x8, pw);
                const int key0 = 32 * (j + kbi) + 16 * s2 + 4 * h;
                const LAS unsigned char* vp = lds + AT_VT_OFF + r32 * AT_VROW + key0 * 2;
                const s16x4 a0 = *(const LAS s16x4*)(vp), a1 = *(const LAS s16x4*)(vp + 16);
                const s16x4 c0 = *(const LAS s16x4*)(vp + 32 * AT_VROW), c1 = *(const LAS s16x4*)(vp + 32 * AT_VROW + 16);
                const bf16x8 vf0 = __builtin_shufflevector(a0, a1, 0, 1, 2, 3, 4, 5, 6, 7), vf1 = __builtin_shufflevector(c0, c1, 0, 1, 2, 3, 4, 5, 6, 7);
                o0 = __builtin_amdgcn_mfma_f32_32x32x16_bf16(vf0, pf, o0, 0, 0, 0);
                o1 = __builtin_amdgcn_mfma_f32_32x32x16_bf16(vf1, pf, o1, 0, 0, 0);
            }
        bf16* orow = AO + token * 1024 + hq * 64 + 4 * h;
#pragma unroll
        for (int g4 = 0; g4 < 4; ++g4) {
            u32x2 w0, w1;
            w0.x = pg8::cvt_pk_bf16(o0[4 * g4] * inv, o0[4 * g4 + 1] * inv); w0.y = pg8::cvt_pk_bf16(o0[4 * g4 + 2] * inv, o0[4 * g4 + 3] * inv);
            w1.x = pg8::cvt_pk_bf16(o1[4 * g4] * inv, o1[4 * g4 + 1] * inv); w1.y = pg8::cvt_pk_bf16(o1[4 * g4 + 2] * inv, o1[4 * g4 + 3] * inv);
            *(GAS u32x2*)(orow + 8 * g4) = w0; *(GAS u32x2*)(orow + 32 + 8 * g4) = w1;
        }
    }
    __syncthreads();
}

constexpr int CV_T = 32, CV_ROWS = CV_T + 30;
__device__ __forceinline__ void conv_unit(Frame& F, int cu, const bf16* U, const float* wdw, const float* bdw, const float* lng, const float* lnb, bf16* CA) {
    LAS unsigned char* lds = F.lds;
    const int tid = F.tid;
    const long m0 = (long)cu * CV_T; const int t0 = (int)(m0 % SEQ);
#pragma unroll 4
    for (int i = 0; i < 16; ++i) {
        const int e = tid + 512 * i, row = e >> 7, ch = e & 127;
        if (row < CV_ROWS) { u32x4 v = {0u, 0u, 0u, 0u}; if (t0 - 30 + row >= 0) v = *(const GAS u32x4*)(U + (size_t)(m0 - 30 + row) * 1024 + ch * 8); *(LAS u32x4*)(lds + row * 2048 + ch * 16) = v; }
    }
    __syncthreads();
    float w0[31], w1[31];
#pragma unroll
    for (int k = 0; k < 31; ++k) { const f32x2v wv = *(const GAS f32x2v*)(wdw + k * 1024 + 2 * tid); w0[k] = wv[0]; w1[k] = wv[1]; }
    const f32x2v bv = *(const GAS f32x2v*)(bdw + 2 * tid);
    const f32x2v gv = *(const GAS f32x2v*)(lng + 2 * tid), bv2 = *(const GAS f32x2v*)(lnb + 2 * tid);
    LAS float* red = (LAS float*)(lds + CV_ROWS * 2048);
    LAS float* stat = (LAS float*)(lds + CV_ROWS * 2048 + 1024);
#pragma unroll 1
    for (int gq = 0; gq < CV_T / 8; ++gq) {
        float y0[8], y1[8];
#pragma unroll
        for (int t = 0; t < 8; ++t) { y0[t] = bv[0]; y1[t] = bv[1]; }
        const LAS unsigned char* wp = lds + gq * 8 * 2048 + tid * 4;
#pragma unroll
        for (int i = 0; i < 38; ++i) {
            const unsigned uu = *(const LAS unsigned*)(wp + i * 2048);
            const float u0 = __uint_as_float(uu << 16), u1 = __uint_as_float(uu & 0xffff0000u);
#pragma unroll
            for (int t = 0; t < 8; ++t) { const int k = i - t; if (k >= 0 && k < 31) { y0[t] += w0[k] * u0; y1[t] += w1[k] * u1; } }
        }
#pragma unroll
        for (int t = 0; t < 8; ++t) {
            const float s = wave_allsum(y0[t] + y1[t]), q = wave_allsum(y0[t] * y0[t] + y1[t] * y1[t]);
            if (F.lane == 0) { red[(t * 8 + F.wave) * 2] = s; red[(t * 8 + F.wave) * 2 + 1] = q; }
        }
        __syncthreads();
        if (tid < 8) { float s = 0.f, q = 0.f;
#pragma unroll
            for (int w = 0; w < 8; ++w) { s += red[(tid * 8 + w) * 2]; q += red[(tid * 8 + w) * 2 + 1]; }
            const float mean = s * (1.f / DM), var = fmaxf(q * (1.f / DM) - mean * mean, 0.f);
            stat[tid * 2] = mean; stat[tid * 2 + 1] = rsqrtf(var + EPS); }
        __syncthreads();
#pragma unroll
        for (int t = 0; t < 8; ++t) {
            const float mean = stat[t * 2], rs = stat[t * 2 + 1];
            const float a = (y0[t] - mean) * rs * gv[0] + bv2[0], c = (y1[t] - mean) * rs * gv[1] + bv2[1];
            const float sa = a * pg8::sigm1(a), sc = c * pg8::sigm1(c);
            *(GAS unsigned*)(CA + (size_t)(m0 + gq * 8 + t) * 1024 + 2 * tid) = pg8::cvt_pk_bf16(sa, sc);
        }
    }
    __syncthreads();
}

__global__ void __launch_bounds__(NWAVES * 64, 2) mk_fwd(Args args) {
    extern __shared__ __attribute__((aligned(16))) unsigned char lds[];
    Frame F;
    F.lds = (LAS unsigned char*)lds;
    F.MISC = (volatile LAS unsigned*)(F.lds + MISC_OFF);
    F.tid = threadIdx.x; F.lane = F.tid & 63; F.wave = __builtin_amdgcn_readfirstlane(F.tid >> 6);
    F.G = gridDim.x; { const int bx = blockIdx.x; F.vcu = (F.G % 8 == 0) ? (bx % 8) * (F.G / 8) + bx / 8 : bx; }
    unsigned char* ws = args.ws;
    F.ctl = (gu32*)(ws + WS_CTL);
    for (int u = F.tid; u < (LDS_BYTES - LDSCTL_OFF) / 4; u += NWAVES * 64) ((LAS unsigned*)(F.lds + LDSCTL_OFF))[u] = 0u;
    __syncthreads();
    XcdBarrier bar; bar.bar = (unsigned*)(F.ctl + CW_BAR); bar.x = 0; bar.st = nullptr;
    if (args.use_bar) bar = xcd_barrier_post((unsigned*)(F.ctl + CW_BAR), F.MISC + 8);
    const int lo = args.ph_lo, hi = args.ph_hi;
#ifndef PHM
#define PHM 0x3FFF
#endif
#define IN(k) (((PHM >> (k)) & 1) && lo <= (k) && (k) < hi)
#define SEAM(k) do { if (IN(k) && IN((k) + 1)) xcd_barrier(bar); } while (0)

    const float* x = args.in[0]; float* out = args.out;
    float* mod = (float*)(ws + WS_MOD); bf16* H = (bf16*)(ws + WS_H); float* X1 = (float*)(ws + WS_X1); bf16* ACT = (bf16*)(ws + WS_ACT);
    bf16* Qb = (bf16*)(ws + WS_Q); bf16* Kb = (bf16*)(ws + WS_K); bf16* Vb = (bf16*)(ws + WS_V); bf16* Ub = (bf16*)(ws + WS_U); bf16* CA = (bf16*)(ws + WS_CA);
    bf16* AO = (bf16*)(ws + WS_AO); bf16* YA = (bf16*)(ws + WS_YA); bf16* MG = (bf16*)(ws + WS_MG);
    bf16* GA = (bf16*)out; bf16* GC = GA + (size_t)M * DM;

    if (IN(0)) { p0_prologue(F, args); } SEAM(0);
    if (IN(1)) { norm_phase<0>(F, x, args.in[4], mod, 0, H, nullptr); } SEAM(1);
    if (IN(2)) { pg8::Gemm g{H, (const bf16*)(ws + WS_WGU1), M, 2 * FF, DM}; pg8::StaticOrder S; S.init(M, 2 * FF, F.G, (int)blockIdx.x);
        pg8::EpiSwiGLU E{ACT, FF, 0};
        pg8::gemm_phase<pg8::EpiSwiGLU, pg8::StaticOrder, true, true>(F.lds + RING_OFF, g, S, E); } SEAM(2);
    if (IN(3)) { pg8::Gemm g{ACT, (const bf16*)(ws + WS_WD1), M, DM, FF}; pg8::StaticOrder S; S.init(M, DM, F.G, (int)blockIdx.x);
        pg8::EpiResid E{x, X1, mod + 2 * DM, 0.5f, DM, NMODW, SEQ / 256};
        pg8::gemm_phase<pg8::EpiResid, pg8::StaticOrder, true, true>(F.lds + RING_OFF, g, S, E); } SEAM(3);
    if (IN(4)) { norm_phase<0>(F, X1, args.in[8], mod, 3, H, nullptr); } SEAM(4);
    if (IN(5)) { pg8::Gemm g{H, (const bf16*)(ws + WS_WIN), M, NIN, DM}; pg8::StaticOrder S; S.init(M, NIN, F.G, (int)blockIdx.x);
        pg8::EpiIn E{Qb, Kb, Vb, Ub, GA, GC};
        pg8::gemm_phase<pg8::EpiIn, pg8::StaticOrder, true, true>(F.lds + RING_OFF, g, S, E); } SEAM(5);
    if (IN(6)) {
#ifndef NO_ATTN
        for (int uidx = F.vcu; uidx < BATCH * 16 * 2; uidx += F.G) { const int kvh = uidx & 1, n = (uidx >> 1) & 15, b = uidx >> 5; attn_unit(F, b, n, kvh, Qb, Kb, Vb, args.in[10], AO); }
#endif
#ifndef NO_CONV
        for (int cu = F.vcu; cu < M / CV_T; cu += F.G) conv_unit(F, cu, Ub, args.in[12], args.in[13], args.in[14], args.in[15], CA);
#endif
    } SEAM(6);
    if (IN(7)) { pg8::Gemm g{AO, (const bf16*)(ws + WS_WAO), M, DM, DM}; pg8::StaticOrder S; S.init(M, DM, F.G, (int)blockIdx.x);
        pg8::EpiGate<0> E{GA, nullptr, YA};
        pg8::gemm_phase<pg8::EpiGate<0>, pg8::StaticOrder, true, true>(F.lds + RING_OFF, g, S, E); } SEAM(7);
    if (IN(8)) { pg8::Gemm g{CA, (const bf16*)(ws + WS_WCO), M, DM, DM}; pg8::StaticOrder S; S.init(M, DM, F.G, (int)blockIdx.x);
        pg8::EpiGate<1> E{GC, YA, MG};
        pg8::gemm_phase<pg8::EpiGate<1>, pg8::StaticOrder, true, true>(F.lds + RING_OFF, g, S, E); } SEAM(8);
    if (IN(9)) { pg8::Gemm g{MG, (const bf16*)(ws + WS_WOUT), M, DM, DM}; pg8::StaticOrder S; S.init(M, DM, F.G, (int)blockIdx.x);
        pg8::EpiResid E{X1, out, mod + 5 * DM, 1.0f, DM, NMODW, SEQ / 256};
        pg8::gemm_phase<pg8::EpiResid, pg8::StaticOrder, true, true>(F.lds + RING_OFF, g, S, E); } SEAM(9);
    if (IN(10)) { norm_phase<0>(F, out, args.in[18], mod, 6, H, nullptr); } SEAM(10);
    if (IN(11)) { pg8::Gemm g{H, (const bf16*)(ws + WS_WGU2), M, 2 * FF, DM}; pg8::StaticOrder S; S.init(M, 2 * FF, F.G, (int)blockIdx.x);
        pg8::EpiSwiGLU E{ACT, FF, 0};
        pg8::gemm_phase<pg8::EpiSwiGLU, pg8::StaticOrder, true, true>(F.lds + RING_OFF, g, S, E); } SEAM(11);
    if (IN(12)) { pg8::Gemm g{ACT, (const bf16*)(ws + WS_WD2), M, DM, FF}; pg8::StaticOrder S; S.init(M, DM, F.G, (int)blockIdx.x);
        pg8::EpiResid E{out, out, mod + 8 * DM, 0.5f, DM, NMODW, SEQ / 256};
        pg8::gemm_phase<pg8::EpiResid, pg8::StaticOrder, true, true>(F.lds + RING_OFF, g, S, E); } SEAM(12);
    if (IN(13)) { norm_phase<1>(F, out, args.in[22], nullptr, 0, nullptr, out); }
#undef IN
#undef SEAM
}

#ifndef FAST_MASK
#define FAST_MASK 0x3FFF
#endif
extern "C" void kernel_launch(void* const* d_in, const int* in_sizes, int n_in, void* d_out, int out_size, void* d_ws, size_t ws_size, hipStream_t stream) {
    static int grid = 0;
    if (grid == 0) {
        if (n_in != 23 || in_sizes[0] != M * DM || out_size != M * DM || ws_size < WS_END) {
            fprintf(stderr, "kernel_launch: unexpected shapes n_in %d in0 %d out %d ws %zu\n", n_in, n_in > 0 ? in_sizes[0] : -1, out_size, ws_size); grid = -1; return; }
        int dev = 0, cus = 0, per_cu = 0;
        if (hipGetDevice(&dev) != hipSuccess || hipDeviceGetAttribute(&cus, hipDeviceAttributeMultiprocessorCount, dev) != hipSuccess) { fprintf(stderr, "kernel_launch: device query failed\n"); grid = -1; return; }
        if (hipFuncSetAttribute((const void*)mk_fwd, hipFuncAttributeMaxDynamicSharedMemorySize, LDS_BYTES) != hipSuccess) { fprintf(stderr, "kernel_launch: hipFuncSetAttribute failed\n"); grid = -1; return; }
        if (hipOccupancyMaxActiveBlocksPerMultiprocessor(&per_cu, (const void*)mk_fwd, NWAVES * 64, LDS_BYTES) != hipSuccess || per_cu < 1) { fprintf(stderr, "kernel_launch: occupancy query reports %d workgroups per CU\n", per_cu); }
        (void)hipGetLastError();
        grid = cus;
    }
    if (grid < 0) return;
    const float* x = (const float*)d_in[0]; const float* c = (const float*)d_in[1]; const float* w_ada = (const float*)d_in[2]; const float* b_ada = (const float*)d_in[3];
    const float* g1n = (const float*)d_in[4]; const float* w1g = (const float*)d_in[5]; const float* w1u = (const float*)d_in[6]; const float* w1d = (const float*)d_in[7];
    const float* g2n = (const float*)d_in[8]; const float* w_in = (const float*)d_in[9]; const float* sinks = (const float*)d_in[10]; const float* w_ao = (const float*)d_in[11];
    const float* wdw = (const float*)d_in[12]; const float* bdw = (const float*)d_in[13]; const float* lng = (const float*)d_in[14]; const float* lnb = (const float*)d_in[15];
    const float* w_co = (const float*)d_in[16]; const float* w_out = (const float*)d_in[17]; const float* g3n = (const float*)d_in[18];
    const float* w2g = (const float*)d_in[19]; const float* w2u = (const float*)d_in[20]; const float* w2d = (const float*)d_in[21]; const float* gfn = (const float*)d_in[22];
    unsigned char* ws = (unsigned char*)d_ws; float* out = (float*)d_out;
    float* mod = (float*)(ws + WS_MOD); bf16_t* H = (bf16_t*)(ws + WS_H); float* X1 = (float*)(ws + WS_X1); bf16_t* ACT = (bf16_t*)(ws + WS_ACT);
    bf16_t* Qb = (bf16_t*)(ws + WS_Q); bf16_t* Kb = (bf16_t*)(ws + WS_K); bf16_t* Vb = (bf16_t*)(ws + WS_V); bf16_t* Ub = (bf16_t*)(ws + WS_U); bf16_t* CA = (bf16_t*)(ws + WS_CA);
    bf16_t* AO = (bf16_t*)(ws + WS_AO); bf16_t* YA = (bf16_t*)(ws + WS_YA); bf16_t* MG = (bf16_t*)(ws + WS_MG);
    bf16_t* GA = (bf16_t*)d_out; bf16_t* GC = GA + (size_t)M * DM;
    (void)hipMemsetAsync(ws + WS_CTL, 0, CTL_ZERO_BYTES, stream);
    Args a{};
    for (int i = 0; i < 23; ++i) a.in[i] = (const float*)d_in[i];
    a.out = out; a.ws = ws;
#ifndef SPLIT_LAUNCH
#define SPLIT_LAUNCH 0
#endif
    if ((FAST_MASK & 0x3FFF) == 0x3FFF && !SPLIT_LAUNCH) {
        a.ph_lo = 0; a.ph_hi = NPHASE; a.use_bar = 1;
        hipLaunchKernelGGL(mk_fwd, dim3(grid), dim3(NWAVES * 64), LDS_BYTES, stream, a);
        return;
    }
#define FASTP(k) do { a.ph_lo = (k); a.ph_hi = (k) + 1; a.use_bar = 0; hipLaunchKernelGGL(mk_fwd, dim3(grid), dim3(NWAVES * 64), LDS_BYTES, stream, a); } while (0)
#define ISF(k) ((FAST_MASK >> (k)) & 1)
    if (FAST_MASK & 0x3FFF) FASTP(0);
    if (!ISF(0)) n_adaln<<<dim3(NMODW / 256, BATCH), 256, 0, stream>>>(c, w_ada, b_ada, mod);
    if (ISF(1)) FASTP(1); else n_norm<0><<<M, 256, 0, stream>>>(x, g1n, mod, 0, H, nullptr);
    if (ISF(2)) FASTP(2); else n_gemm<true, EpiSwiGLU><<<dim3(FF / 64, M / 64), 256, 0, stream>>>(H, DM, w1g, w1u, FF, DM, EpiSwiGLU{ACT, FF, 0});
    if (ISF(3)) FASTP(3); else n_gemm<false, EpiResid><<<dim3(DM / 64, M / 64), 256, 0, stream>>>(ACT, FF, w1d, nullptr, DM, FF, EpiResid{x, X1, mod + 2 * DM, 0.5f, 0});
    if (ISF(4)) FASTP(4); else n_norm<0><<<M, 256, 0, stream>>>(X1, g2n, mod, 3, H, nullptr);
    if (ISF(5)) FASTP(5); else {
        n_gemm<false, EpiScale><<<dim3(1024 / 64, M / 64), 256, 0, stream>>>(H, DM, w_in, nullptr, NIN, DM, EpiScale{Qb, DM, 0.125f});
        n_gemm<false, EpiScale><<<dim3(128 / 64, M / 64), 256, 0, stream>>>(H, DM, w_in + 1024, nullptr, NIN, DM, EpiScale{Kb, 128, 1.f});
        n_gemm<false, EpiScale><<<dim3(128 / 64, M / 64), 256, 0, stream>>>(H, DM, w_in + 1152, nullptr, NIN, DM, EpiScale{Vb, 128, 1.f});
        n_gemm<true, EpiGLU><<<dim3(1024 / 64, M / 64), 256, 0, stream>>>(H, DM, w_in + 1280, w_in + 2304, NIN, DM, EpiGLU{Ub, DM, 0});
        n_gemm<false, EpiSigm><<<dim3(1024 / 64, M / 64), 256, 0, stream>>>(H, DM, w_in + 3328, nullptr, NIN, DM, EpiSigm{GA, DM, 0});
        n_gemm<false, EpiSigm><<<dim3(1024 / 64, M / 64), 256, 0, stream>>>(H, DM, w_in + 4352, nullptr, NIN, DM, EpiSigm{GC, DM, 0}); }
    if (ISF(6)) FASTP(6); else {
        n_attn<<<dim3(M, 16), 64, 0, stream>>>(Qb, Kb, Vb, sinks, AO);
        n_conv<<<M, 256, 0, stream>>>(Ub, wdw, bdw, lng, lnb, CA); }
    if (ISF(7)) FASTP(7); else n_gemm<false, EpiYA><<<dim3(DM / 64, M / 64), 256, 0, stream>>>(AO, DM, w_ao, nullptr, DM, DM, EpiYA{GA, YA});
    if (ISF(8)) FASTP(8); else n_gemm<false, EpiMG><<<dim3(DM / 64, M / 64), 256, 0, stream>>>(CA, DM, w_co, nullptr, DM, DM, EpiMG{GC, YA, MG});
    if (ISF(9)) FASTP(9); else n_gemm<false, EpiResid><<<dim3(DM / 64, M / 64), 256, 0, stream>>>(MG, DM, w_out, nullptr, DM, DM, EpiResid{X1, out, mod + 5 * DM, 1.0f, 0});
    if (ISF(10)) FASTP(10); else n_norm<0><<<M, 256, 0, stream>>>(out, g3n, mod, 6, H, nullptr);
    if (ISF(11)) FASTP(11); else n_gemm<true, EpiSwiGLU><<<dim3(FF / 64, M / 64), 256, 0, stream>>>(H, DM, w2g, w2u, FF, DM, EpiSwiGLU{ACT, FF, 0});
    if (ISF(12)) FASTP(12); else n_gemm<false, EpiResid><<<dim3(DM / 64, M / 64), 256, 0, stream>>>(ACT, FF, w2d, nullptr, DM, FF, EpiResid{out, out, mod + 8 * DM, 0.5f, 0});
    if (ISF(13)) FASTP(13); else n_norm<1><<<M, 256, 0, stream>>>(out, gfn, nullptr, 0, nullptr, out);
}
```

```cpp
#include <hip/hip_runtime.h>
#include <cstdio>
#include <cstdint>

typedef unsigned short bf16_t;
constexpr int BATCH = 16, SEQ = 2048, DM = 1024, M = BATCH * SEQ, FF = 2816, NIN = 5376, NMODW = 9 * DM;
constexpr float EPS = 1e-6f;

__device__ __forceinline__ float bf2f(bf16_t v) { return __uint_as_float(((unsigned)v) << 16); }
__device__ __forceinline__ bf16_t f2bf(float f) { unsigned u = __float_as_uint(f); return (bf16_t)((u + 0x7fffu + ((u >> 16) & 1u)) >> 16); }
__device__ __forceinline__ float sigm(float x) { return 1.f / (1.f + __expf(-x)); }
__device__ __forceinline__ float silu(float x) { return x / (1.f + __expf(-x)); }

constexpr size_t MiB = 1u << 20;
constexpr size_t WS_CTL = 0, WS_MOD = 1 * MiB;
constexpr size_t WS_H = 52 * MiB;
constexpr size_t WS_Y1 = 116 * MiB, WS_Y2 = 180 * MiB;
constexpr size_t WS_ACT = 244 * MiB;
constexpr size_t WS_Q = 244 * MiB;
constexpr size_t WS_K = 308 * MiB;
constexpr size_t WS_V = 316 * MiB;
constexpr size_t WS_U = 324 * MiB;
constexpr size_t WS_CA = 388 * MiB;
constexpr size_t WS_END = 452 * MiB;
constexpr size_t WS_AO = WS_H, WS_YA = WS_Q, WS_MG = WS_U;

namespace pg8 {
#define PG8_LAS __attribute__((address_space(3)))
typedef unsigned short bf16_t;
typedef short bf16x8 __attribute__((ext_vector_type(8)));
typedef float f32x4 __attribute__((ext_vector_type(4)));
typedef unsigned u32x4 __attribute__((ext_vector_type(4)));
constexpr int BM = 256, BK = 64, HALF = 128, HTB = HALF * BK * 2  , STAGE_BYTES = 8 * HTB, NXCD = 8, WGM = 8;

__host__ __device__ __forceinline__ int lds_byte(int r, int c) { const int st = (r >> 4) * 2 + (c >> 5), rr = r & 15, cc = c & 31, ob = rr * 64 + cc * 2; return st * 1024 + (ob ^ (((ob >> 9) & 1) << 5)); }
__host__ __device__ __forceinline__ void stage_rc(int b, int& R, int& C) { const int st = b / 1024, sb = b % 1024, swz = sb ^ (((sb >> 9) & 1) << 5); R = (st >> 1) * 16 + swz / 64; C = (st & 1) * 32 + (swz % 64) / 2; }
__host__ __device__ __forceinline__ int perm32(int rho) { const int n = rho >> 4, i = rho & 15; return 8 * (i >> 2) + 4 * n + (i & 3); }

struct Unit { int pm, pn; };
struct Gemm { const bf16_t* A; const bf16_t* Bt; int M, N, K, skip_epi; };

struct StaticOrder {
    int nM, nN, nwg, G, c;
    __host__ __device__ void init(int M, int N, int G_, int c_) { nM = M / BM; nN = N / BM; nwg = nM * nN; G = G_; c = c_; }
    __host__ __device__ bool next(int i, Unit& u) const {
        const long L = (long)i * G + c; if (L >= nwg) return false;
        int wgid = (int)L; { const int q = nwg / NXCD, r = nwg % NXCD, xcd = wgid % NXCD, off = wgid / NXCD; wgid = (xcd < r ? xcd * (q + 1) : r * (q + 1) + (xcd - r) * q) + off; }
        const int nig = WGM * nN, gid = wgid / nig, fm = gid * WGM, gsz = (nM - fm) < WGM ? (nM - fm) : WGM;
        u.pm = fm + ((wgid % nig) % gsz); u.pn = (wgid % nig) / gsz; return true;
    }
    __device__ __forceinline__ void a_ready(const Unit&) const {}
    __device__ __forceinline__ void done(const Unit&) const {}
};

typedef float f32x2 __attribute__((ext_vector_type(2)));
typedef __bf16 bf16x2_t __attribute__((ext_vector_type(2)));
constexpr int EPI_ROWB = 144, EPI_WAVE_BYTES = 16 * EPI_ROWB;
__device__ __forceinline__ unsigned cvt_pk_bf16(float lo, float hi) { f32x2 v = {lo, hi}; bf16x2_t b = __builtin_convertvector(v, bf16x2_t); return __builtin_bit_cast(unsigned, b); }
__device__ __forceinline__ u32x4 pack8(f32x4 a, f32x4 b) { u32x4 w; w.x = cvt_pk_bf16(a[0], a[1]); w.y = cvt_pk_bf16(a[2], a[3]); w.z = cvt_pk_bf16(b[0], b[1]); w.w = cvt_pk_bf16(b[2], b[3]); return w; }
__device__ __forceinline__ void unpack8(u32x4 w, f32x4& a, f32x4& b) {
    a[0] = __uint_as_float(w.x << 16); a[1] = __uint_as_float(w.x & 0xffff0000u); a[2] = __uint_as_float(w.y << 16); a[3] = __uint_as_float(w.y & 0xffff0000u);
    b[0] = __uint_as_float(w.z << 16); b[1] = __uint_as_float(w.z & 0xffff0000u); b[2] = __uint_as_float(w.w << 16); b[3] = __uint_as_float(w.w & 0xffff0000u); }
__device__ __forceinline__ float sigm1(float x) { return __builtin_amdgcn_rcpf(1.0f + __builtin_amdgcn_exp2f(x * -1.4426950408889634f)); }
__device__ __forceinline__ f32x4 sigm4(f32x4 x) { f32x4 r; r[0] = sigm1(x[0]); r[1] = sigm1(x[1]); r[2] = sigm1(x[2]); r[3] = sigm1(x[3]); return r; }
template <bool PERM> __device__ __forceinline__ void epi_put(PG8_LAS unsigned char* scr, int fr, int fq, f32x4 v0, f32x4 v1) {
    const int c0 = PERM ? 8 * fq : 4 * fq, c1 = PERM ? 8 * fq + 4 : 16 + 4 * fq;
    *(PG8_LAS f32x4*)(scr + fr * EPI_ROWB + c0 * 4) = v0; *(PG8_LAS f32x4*)(scr + fr * EPI_ROWB + c1 * 4) = v1; }
__device__ __forceinline__ void epi_get8(PG8_LAS unsigned char* scr, int lane, f32x4& a, f32x4& b) {
    PG8_LAS unsigned char* p = scr + (lane >> 2) * EPI_ROWB + (lane & 3) * 32; a = *(PG8_LAS f32x4*)p; b = *(PG8_LAS f32x4*)(p + 16); }
__device__ __forceinline__ f32x4 epi_get4(PG8_LAS unsigned char* scr, int lane, int pass) {
    return *(PG8_LAS f32x4*)(scr + ((lane >> 3) + 8 * pass) * EPI_ROWB + (lane & 7) * 16); }

struct EpiSwiGLU {
    static constexpr bool PERM = true, AFTER_DRAIN = false;
    bf16_t* O; int ldc; PG8_LAS unsigned char* scr; int local;
    __device__ __forceinline__ void operator()(const f32x4 (&acc)[2][2][4][2], const Unit& u, int wr, int wc, int fr, int fq) const {
        const int lane = fr + 16 * fq;
        bf16_t* base = O + (size_t)((local ? 0 : u.pm * BM) + wr * 64 + (lane >> 2)) * ldc + (local ? 0 : u.pn * HALF) + wc * 32 + 8 * (lane & 3);
#pragma unroll
        for (int ai = 0; ai < 2; ++ai)
#pragma unroll
            for (int m = 0; m < 4; ++m) {
                const f32x4 g0 = acc[ai][0][m][0], g1 = acc[ai][0][m][1];
                epi_put<true>(scr, fr, fq, g0 * sigm4(g0) * acc[ai][1][m][0], g1 * sigm4(g1) * acc[ai][1][m][1]);
                f32x4 a, b; epi_get8(scr, lane, a, b);
                *(u32x4*)(base + (size_t)(ai * HALF + m * 16) * ldc) = pack8(a, b); }
    }
};
template <int GLD, int TPB, int HALFCOEF> struct EpiDelta {
    static constexpr bool PERM = true, AFTER_DRAIN = false;
    bf16_t* Y; const float* gate; PG8_LAS unsigned char* scr;
    __device__ __forceinline__ void operator()(const f32x4 (&acc)[2][2][4][2], const Unit& u, int wr, int wc, int fr, int fq) const {
        const int lane = fr + 16 * fq, b = u.pm / TPB, col0 = u.pn * BM + wc * 32 + 8 * (lane & 3); const float coef = HALFCOEF ? 0.5f : 1.0f;
        bf16_t* base = Y + (size_t)(u.pm * BM + wr * 64 + (lane >> 2)) * 1024 + col0;
        const float* gp = gate + (size_t)b * GLD + col0;
        const f32x4 g00 = *(const f32x4*)(gp) * coef, g01 = *(const f32x4*)(gp + 4) * coef, g10 = *(const f32x4*)(gp + HALF) * coef, g11 = *(const f32x4*)(gp + HALF + 4) * coef;
#pragma unroll
        for (int ai = 0; ai < 2; ++ai)
#pragma unroll
            for (int m = 0; m < 4; ++m) {
                { epi_put<true>(scr, fr, fq, acc[ai][0][m][0], acc[ai][0][m][1]); f32x4 a, c; epi_get8(scr, lane, a, c);
                  *(u32x4*)(base + (size_t)(ai * HALF + m * 16) * 1024) = pack8(a * g00, c * g01); }
                { epi_put<true>(scr, fr, fq, acc[ai][1][m][0], acc[ai][1][m][1]); f32x4 a, c; epi_get8(scr, lane, a, c);
                  *(u32x4*)(base + (size_t)(ai * HALF + m * 16) * 1024 + HALF) = pack8(a * g10, c * g11); } }
    }
};
struct EpiIn {
    static constexpr bool PERM = true, AFTER_DRAIN = false;
    bf16_t *Q, *K, *V, *U, *GA, *GC; PG8_LAS unsigned char* scr;
    __device__ __forceinline__ void operator()(const f32x4 (&acc)[2][2][4][2], const Unit& u, int wr, int wc, int fr, int fq) const {
        const int lane = fr + 16 * fq, pn = u.pn, cw = wc * 32 + 8 * (lane & 3);
        const size_t row0 = (size_t)(u.pm * BM + wr * 64 + (lane >> 2));
        if (pn >= 5 && pn < 13) {
            bf16_t* base = U + row0 * 1024 + (pn - 5) * HALF + cw;
#pragma unroll
            for (int ai = 0; ai < 2; ++ai)
#pragma unroll
                for (int m = 0; m < 4; ++m) {
                    epi_put<true>(scr, fr, fq, acc[ai][0][m][0] * sigm4(acc[ai][1][m][0]), acc[ai][0][m][1] * sigm4(acc[ai][1][m][1]));
                    f32x4 a, b; epi_get8(scr, lane, a, b);
                    *(u32x4*)(base + (size_t)(ai * HALF + m * 16) * 1024) = pack8(a, b); }
        } else if (pn >= 13) {
            bf16_t* base = (pn < 17 ? GA + (pn - 13) * BM : GC + (pn - 17) * BM) + row0 * 1024 + cw;
#pragma unroll
            for (int ai = 0; ai < 2; ++ai)
#pragma unroll
                for (int m = 0; m < 4; ++m)
#pragma unroll
                    for (int bj = 0; bj < 2; ++bj) {
                        epi_put<true>(scr, fr, fq, sigm4(acc[ai][bj][m][0]), sigm4(acc[ai][bj][m][1]));
                        f32x4 a, b; epi_get8(scr, lane, a, b);
                        *(u32x4*)(base + (size_t)(ai * HALF + m * 16) * 1024 + bj * HALF) = pack8(a, b); }
        } else {
            bf16_t* b0; bf16_t* b1; int ld; float sc;
            if (pn < 4) { b0 = Q + row0 * 1024 + pn * BM + cw; b1 = b0 + HALF; ld = 1024; sc = 0.125f; } else { b0 = K + row0 * 128 + cw; b1 = V + row0 * 128 + cw; ld = 128; sc = 1.0f; }
#pragma unroll
            for (int ai = 0; ai < 2; ++ai)
#pragma unroll
                for (int m = 0; m < 4; ++m)
#pragma unroll
                    for (int bj = 0; bj < 2; ++bj) {
                        epi_put<true>(scr, fr, fq, acc[ai][bj][m][0] * sc, acc[ai][bj][m][1] * sc);
                        f32x4 a, b; epi_get8(scr, lane, a, b);
                        *(u32x4*)((bj ? b1 : b0) + (size_t)(ai * HALF + m * 16) * ld) = pack8(a, b); }
        }
    }
};
template <int MODE> struct EpiGate {
    static constexpr bool PERM = true, AFTER_DRAIN = false;
    const bf16_t* G; const bf16_t* Y; bf16_t* O; PG8_LAS unsigned char* scr;
    __device__ __forceinline__ void operator()(const f32x4 (&acc)[2][2][4][2], const Unit& u, int wr, int wc, int fr, int fq) const {
        const int lane = fr + 16 * fq;
        const size_t off0 = (size_t)(u.pm * BM + wr * 64 + (lane >> 2)) * 1024 + u.pn * BM + wc * 32 + 8 * (lane & 3);
#pragma unroll
        for (int ai = 0; ai < 2; ++ai) {
            u32x4 gw[4][2], yw[4][2];
#pragma unroll
            for (int m = 0; m < 4; ++m)
#pragma unroll
                for (int bj = 0; bj < 2; ++bj) { const size_t off = off0 + (size_t)(ai * HALF + m * 16) * 1024 + bj * HALF; gw[m][bj] = *(const u32x4*)(G + off); if (MODE == 1) yw[m][bj] = *(const u32x4*)(Y + off); }
            asm volatile("" ::: "memory");
#pragma unroll
            for (int m = 0; m < 4; ++m)
#pragma unroll
                for (int bj = 0; bj < 2; ++bj) { const size_t off = off0 + (size_t)(ai * HALF + m * 16) * 1024 + bj * HALF;
                    epi_put<true>(scr, fr, fq, acc[ai][bj][m][0], acc[ai][bj][m][1]);
                    f32x4 a, b; epi_get8(scr, lane, a, b);
                    f32x4 g0, g1; unpack8(gw[m][bj], g0, g1);
                    f32x4 v0 = g0 * a, v1 = g1 * b;
                    if (MODE == 1) { f32x4 y0, y1; unpack8(yw[m][bj], y0, y1); v0 += y0; v1 += y1; }
                    *(u32x4*)(O + off) = pack8(v0, v1); }
            asm volatile("" ::: "memory");
        }
    }
};
template <class Epi, class Sched, bool ALIGN_EPI = false, bool SP2 = false>
__device__ __forceinline__ void gemm_phase(PG8_LAS unsigned char* lds, const Gemm g, const Sched& S, const Epi& E) {
    const int tid = threadIdx.x, wid = __builtin_amdgcn_readfirstlane(tid >> 6), lane = tid & 63, wr = wid >> 2, wc = wid & 3, fr = lane & 15, fq = lane >> 4;
    const int K = g.K, nt = K / BK;
    unsigned voffA[2], voffB[2];
#pragma unroll
    for (int i = 0; i < 2; ++i) { int R, C; stage_rc(tid * 16 + i * 8192, R, C); const int Rb = Epi::PERM ? ((R & ~31) + perm32(R & 31)) : R;
        voffA[i] = (unsigned)(R * K + C) * 2u; voffB[i] = (unsigned)(Rb * K + C) * 2u; }
    const size_t kstep = (size_t)(BK * 2);
    const size_t hstep = (size_t)HALF * K * 2;
    const size_t tstep = 2 * hstep;
    const unsigned ldsw = (unsigned)wid * 1024u;
    const int aoff = lds_byte(wr * 64 + fr, fq * 8), boff = lds_byte(wc * 32 + fr, fq * 8);
#define PG8_SA(b, h) (((b) * 2 + (h)) * HTB)
#define PG8_SB(b, h) ((4 + (b) * 2 + (h)) * HTB)
#define PG8_STAGE(bufoff, gbase, voff) do { _Pragma("unroll") for (int _i = 0; _i < 2; ++_i) \
        __builtin_amdgcn_global_load_lds((const unsigned*)((const char*)(gbase) + (voff)[_i]), (PG8_LAS unsigned*)(lds + (bufoff) + ldsw + _i * 8192), 16, 0, 0); } while (0)
#define PG8_LDA(dst, b, h) do { _Pragma("unroll") for (int m = 0; m < 4; ++m) _Pragma("unroll") for (int k = 0; k < 2; ++k) dst[m][k] = *(const PG8_LAS bf16x8*)(lds + PG8_SA(b, h) + aoff + m * 2048 + k * 1024); } while (0)
#define PG8_LDB(dst, b, h) do { _Pragma("unroll") for (int n = 0; n < 2; ++n) _Pragma("unroll") for (int k = 0; k < 2; ++k) dst[n][k] = *(const PG8_LAS bf16x8*)(lds + PG8_SB(b, h) + boff + n * 2048 + k * 1024); } while (0)
#define PG8_MMA(ai, bj, At, Bt) do { __builtin_amdgcn_s_setprio(1); _Pragma("unroll") for (int m = 0; m < 4; ++m) _Pragma("unroll") for (int n = 0; n < 2; ++n) _Pragma("unroll") for (int k = 0; k < 2; ++k) \
        acc[ai][bj][m][n] = __builtin_amdgcn_mfma_f32_16x16x32_bf16(Bt[n][k], At[m][k], acc[ai][bj][m][n], 0, 0, 0); __builtin_amdgcn_s_setprio(0); } while (0)
#define PG8_WAIT_V(n) asm volatile("s_waitcnt vmcnt(" #n ")" ::: "memory")
#define PG8_WAIT_L(n) asm volatile("s_waitcnt lgkmcnt(" #n ")" ::: "memory")
#define PG8_BAR __builtin_amdgcn_s_barrier()
#define PG8_SCHED __builtin_amdgcn_sched_barrier(0)
    Unit cur, nxt; int ui = 0;
    if (!S.next(0, cur)) return;
    f32x4 acc[2][2][4][2];
#pragma unroll
    for (int a = 0; a < 2; ++a)
#pragma unroll
        for (int b = 0; b < 2; ++b)
#pragma unroll
            for (int m = 0; m < 4; ++m)
#pragma unroll
                for (int n = 0; n < 2; ++n) acc[a][b][m][n] = (f32x4){0.f, 0.f, 0.f, 0.f};
    bf16x8 At[4][2], B0[2][2], B1[2][2];
    const char* cA = (const char*)g.A + (size_t)cur.pm * tstep; const char* cB = (const char*)g.Bt + (size_t)cur.pn * tstep;
    S.a_ready(cur);
    if constexpr (SP2) {
        PG8_STAGE(PG8_SB(0, 0), cB, voffB); PG8_STAGE(PG8_SB(0, 1), cB + hstep, voffB); PG8_STAGE(PG8_SA(0, 0), cA, voffA); PG8_STAGE(PG8_SA(0, 1), cA + hstep, voffA);
        if (wr == 1) PG8_BAR;
        PG8_WAIT_V(2); PG8_BAR;
        PG8_STAGE(PG8_SB(1, 0), cB + kstep, voffB); PG8_STAGE(PG8_SA(1, 0), cA + kstep, voffA); PG8_STAGE(PG8_SB(1, 1), cB + hstep + kstep, voffB);
        PG8_WAIT_V(6); PG8_BAR;
    } else {
        PG8_STAGE(PG8_SB(0, 0), cB, voffB); PG8_STAGE(PG8_SA(0, 0), cA, voffA); PG8_STAGE(PG8_SB(0, 1), cB + hstep, voffB); PG8_STAGE(PG8_SA(0, 1), cA + hstep, voffA);
        if (wr == 1) PG8_BAR;
        PG8_WAIT_V(4); PG8_BAR;
        PG8_STAGE(PG8_SB(1, 0), cB + kstep, voffB); PG8_STAGE(PG8_SA(1, 0), cA + kstep, voffA); PG8_STAGE(PG8_SB(1, 1), cB + hstep + kstep, voffB);
        PG8_WAIT_V(6); PG8_BAR;
    }
    for (;;) {
        const bool has_next = S.next(ui + 1, nxt);
        const char* nA = has_next ? (const char*)g.A + (size_t)nxt.pm * tstep : cA; const char* nB = has_next ? (const char*)g.Bt + (size_t)nxt.pn * tstep : cB;
        for (int t = 0; t < nt; t += 2) {
            const bool last = (t == nt - 2);
            const char* a1 = cA + (size_t)(t + 1) * kstep;
            const char* a2 = last ? nA : cA + (size_t)(t + 2) * kstep; const char* b2 = last ? nB : cB + (size_t)(t + 2) * kstep;
            const char* a3 = a2 + kstep; const char* b3 = b2 + kstep;
            if (last && has_next) S.a_ready(nxt);
            if constexpr (SP2) {
            PG8_LDB(B0, 0, 0); PG8_LDB(B1, 0, 1); PG8_SCHED; PG8_LDA(At, 0, 0); PG8_STAGE(PG8_SA(1, 1), a1 + hstep, voffA);
            PG8_WAIT_V(8); PG8_WAIT_L(0); PG8_BAR; PG8_MMA(0, 0, At, B0); PG8_MMA(0, 1, At, B1); PG8_BAR; PG8_SCHED;
            PG8_LDA(At, 0, 1); PG8_STAGE(PG8_SB(0, 0), b2, voffB); PG8_STAGE(PG8_SB(0, 1), b2 + hstep, voffB); PG8_STAGE(PG8_SA(0, 0), a2, voffA);
            PG8_WAIT_V(8); PG8_WAIT_L(0); PG8_BAR; PG8_MMA(1, 0, At, B0); PG8_MMA(1, 1, At, B1); PG8_BAR; PG8_SCHED;
            PG8_LDB(B0, 1, 0); PG8_LDB(B1, 1, 1); PG8_SCHED; PG8_LDA(At, 1, 0); PG8_STAGE(PG8_SA(0, 1), a2 + hstep, voffA);
            PG8_WAIT_V(8); PG8_WAIT_L(0); PG8_BAR; PG8_MMA(0, 0, At, B0); PG8_MMA(0, 1, At, B1); PG8_BAR; PG8_SCHED;
            PG8_LDA(At, 1, 1); PG8_STAGE(PG8_SB(1, 0), b3, voffB); PG8_STAGE(PG8_SB(1, 1), b3 + hstep, voffB); PG8_STAGE(PG8_SA(1, 0), a3, voffA);
            PG8_WAIT_V(8); PG8_WAIT_L(0); PG8_BAR; PG8_MMA(1, 0, At, B0); PG8_MMA(1, 1, At, B1); PG8_BAR; PG8_SCHED;
            } else {
            PG8_LDB(B0, 0, 0); PG8_SCHED; PG8_LDA(At, 0, 0); PG8_STAGE(PG8_SA(1, 1), a1 + hstep, voffA);
            PG8_WAIT_L(8); PG8_BAR; PG8_WAIT_L(0); PG8_MMA(0, 0, At, B0); PG8_BAR; PG8_SCHED;
            PG8_LDB(B1, 0, 1); PG8_STAGE(PG8_SB(0, 0), b2, voffB);
            PG8_BAR; PG8_WAIT_L(0); PG8_MMA(0, 1, At, B1); PG8_BAR;
            PG8_LDA(At, 0, 1); PG8_STAGE(PG8_SA(0, 0), a2, voffA);
            PG8_BAR; PG8_WAIT_L(0); PG8_MMA(1, 0, At, B0); PG8_BAR; PG8_SCHED;
            PG8_STAGE(PG8_SB(0, 1), b2 + hstep, voffB);
            PG8_WAIT_V(6); PG8_BAR; PG8_MMA(1, 1, At, B1); PG8_BAR;
            PG8_LDB(B0, 1, 0); PG8_SCHED; PG8_LDA(At, 1, 0); PG8_STAGE(PG8_SA(0, 1), a2 + hstep, voffA);
            PG8_WAIT_L(8); PG8_BAR; PG8_WAIT_L(0); PG8_MMA(0, 0, At, B0); PG8_BAR; PG8_SCHED;
            PG8_LDB(B1, 1, 1); PG8_STAGE(PG8_SB(1, 0), b3, voffB);
            PG8_BAR; PG8_WAIT_L(0); PG8_MMA(0, 1, At, B1); PG8_BAR;
            PG8_LDA(At, 1, 1); PG8_STAGE(PG8_SA(1, 0), a3, voffA);
            PG8_BAR; PG8_WAIT_L(0); PG8_MMA(1, 0, At, B0); PG8_BAR; PG8_SCHED;
            PG8_STAGE(PG8_SB(1, 1), b3 + hstep, voffB);
            PG8_WAIT_V(6); PG8_BAR; PG8_MMA(1, 1, At, B1); PG8_BAR;
            }
        }
        if constexpr (ALIGN_EPI) { if (wr == 0) PG8_BAR; }
        if constexpr (!Epi::AFTER_DRAIN) { if (!g.skip_epi) E(acc, cur, wr, wc, fr, fq); S.done(cur); }
        if (!has_next) break;
#pragma unroll
        for (int a = 0; a < 2; ++a)
#pragma unroll
            for (int b = 0; b < 2; ++b)
#pragma unroll
                for (int m = 0; m < 4; ++m)
#pragma unroll
                    for (int n = 0; n < 2; ++n) acc[a][b][m][n] = (f32x4){0.f, 0.f, 0.f, 0.f};
        cur = nxt; cA = nA; cB = nB; ++ui;
        if constexpr (ALIGN_EPI) { if (wr == 1) PG8_BAR; }
    }
    PG8_WAIT_V(0);
    if constexpr (!ALIGN_EPI) { if (wr == 0) PG8_BAR; }
    PG8_BAR;
    if constexpr (Epi::AFTER_DRAIN) { E.fused(acc, cur, wr, wc, fr, fq, lds, wid, lane); S.done(cur); }
#undef PG8_SA
#undef PG8_SB
#undef PG8_STAGE
#undef PG8_LDA
#undef PG8_LDB
#undef PG8_MMA
#undef PG8_WAIT_V
#undef PG8_WAIT_L
#undef PG8_BAR
#undef PG8_SCHED
}
}
#define GAS __attribute__((address_space(1)))
#define LAS __attribute__((address_space(3)))
typedef unsigned short bf16;
typedef unsigned v4u __attribute__((ext_vector_type(4)));
typedef float f32x4 __attribute__((ext_vector_type(4)));
typedef short bf16x8 __attribute__((ext_vector_type(8)));
typedef GAS unsigned gu32;
typedef GAS unsigned long long gu64;
#define RLX_AGENT __ATOMIC_RELAXED, __HIP_MEMORY_SCOPE_AGENT
#define LDS_WAIT() asm volatile("s_waitcnt lgkmcnt(0)" ::: "memory")
#define VM_WAIT() asm volatile("s_waitcnt vmcnt(0)" ::: "memory")
__device__ __forceinline__ unsigned long long rt() { return __builtin_amdgcn_s_memrealtime(); }
__device__ __forceinline__ unsigned pk2(float lo, float hi) { return (unsigned)f2bf(lo) | ((unsigned)f2bf(hi) << 16); }

#define XB_TMO      128
#define XB_XCNT(j)  (256  + 64 * (j))
#define XB_XSUB(j)  (1280 + 64 * (j))
#define XB_XGEN(j)  (2304 + 64 * (j))
#define XB_TOP      3328
#define XB_TOPGEN   3392
#define XCD_BAR_WORDS 3456
#define XB_SPIN_CAP (1u << 18)

__device__ __forceinline__ unsigned xb_ld(unsigned* p)              { return __hip_atomic_load(p, __ATOMIC_RELAXED, __HIP_MEMORY_SCOPE_AGENT); }
__device__ __forceinline__ unsigned xb_add(unsigned* p, unsigned v) { return __hip_atomic_fetch_add(p, v, __ATOMIC_RELAXED, __HIP_MEMORY_SCOPE_AGENT); }
__device__ __forceinline__ unsigned xb_xcc_id() { return (unsigned)__builtin_amdgcn_s_getreg((3 << 11) | 20) & 0xFu; }
#define XB_SPIN(cond, bar) do { unsigned _sp = 0; while (cond) { __builtin_amdgcn_s_sleep(1); \
    if ((++_sp & 255u) == 0u) { if (xb_ld(&(bar)[XB_TMO])) break; if (_sp > XB_SPIN_CAP) { atomicAdd(&(bar)[XB_TMO], 1u); break; } } } } while (0)

struct XcdBarrier {
    unsigned* bar; unsigned x;
    volatile LAS unsigned* st;
};

__device__ __forceinline__ XcdBarrier xcd_barrier_post(unsigned* bar, volatile LAS unsigned* st) {
    XcdBarrier b; b.bar = bar; b.x = xb_xcc_id(); b.st = st;
    if (threadIdx.x == 0) (void)xb_add(&bar[XB_XCNT(b.x)], 1u);
    return b;
}
__device__ __forceinline__ void xcd_barrier_complete(unsigned* bar, unsigned x, unsigned& nloc, unsigned& nx) {
    const unsigned G = gridDim.x * gridDim.y * gridDim.z;
    unsigned sum, cnt, mine, sp = 0u;
    for (;;) {
        sum = 0u; cnt = 0u; mine = 0u;
#pragma unroll
        for (unsigned j = 0; j < 16; ++j) { const unsigned c = xb_ld(&bar[XB_XCNT(j)]); sum += c; cnt += (c > 0u) ? 1u : 0u; mine = (j == x) ? c : mine; }
        if (sum == G) break;
        __builtin_amdgcn_s_sleep(1);
        if ((++sp & 255u) == 0u) { if (xb_ld(&bar[XB_TMO])) break; if (sp > XB_SPIN_CAP) { atomicAdd(&bar[XB_TMO], 1u); break; } }
    }
    nloc = mine > 0u ? mine : 1u; nx = cnt > 0u ? cnt : 1u;
}

__device__ __forceinline__ void xcd_barrier(const XcdBarrier& b) {
    asm volatile("s_waitcnt vmcnt(0)" ::: "memory");
    __syncthreads();
    if (threadIdx.x == 0) {
        unsigned* bar = b.bar;
        __builtin_amdgcn_s_waitcnt(0);
        unsigned nloc = b.st[0], nx = b.st[1];
        if (nloc == 0u) { xcd_barrier_complete(bar, b.x, nloc, nx); b.st[0] = nloc; b.st[1] = nx; }
        const unsigned old = xb_add(&bar[XB_XSUB(b.x)], 1u);
        const unsigned gen = old / nloc;
        if (old + 1u == (gen + 1u) * nloc) {
            __builtin_amdgcn_fence(__ATOMIC_RELEASE, "agent");
            asm volatile("s_waitcnt vmcnt(0)" ::: "memory");
            const unsigned og = xb_add(&bar[XB_TOP], 1u);
            const unsigned tg = og / nx;
            if (og + 1u == (tg + 1u) * nx) xb_add(&bar[XB_TOPGEN], 1u);
            else XB_SPIN(xb_ld(&bar[XB_TOPGEN]) == tg, bar);
            __builtin_amdgcn_fence(__ATOMIC_ACQUIRE, "agent");
            xb_add(&bar[XB_XGEN(b.x)], 1u);
            asm volatile("s_waitcnt vmcnt(0)" ::: "memory");
        } else {
            XB_SPIN(xb_ld(&bar[XB_XGEN(b.x)]) == gen, bar);
            __builtin_amdgcn_fence(__ATOMIC_ACQUIRE, "agent");
            asm volatile("s_waitcnt vmcnt(0)" ::: "memory");
        }
    }
    __syncthreads();
}

constexpr int NWAVES = 8;
constexpr int NPHASE = 14;
constexpr size_t WS_WGU1 = 2 * MiB, WS_WD1 = 13 * MiB, WS_WIN = 18 * MiB + 512 * 1024, WS_WAO = 29 * MiB, WS_WCO = 31 * MiB, WS_WOUT = 33 * MiB, WS_WGU2 = 35 * MiB, WS_WD2 = 46 * MiB;
static_assert(WS_WD2 + (size_t)DM * FF * 2 <= WS_H, "weight copies end before H");
constexpr size_t CTL_ZERO_BYTES = 64 * 1024;
constexpr int CW_BAR = 4096;
constexpr int RING_OFF = 0, RING_BYTES = 131072, LDSCTL_OFF = RING_BYTES, MISC_OFF = LDSCTL_OFF + 320, EPI_OFF = RING_BYTES + 512, LDS_BYTES = 151552;
static_assert(EPI_OFF + NWAVES * pg8::EPI_WAVE_BYTES <= LDS_BYTES, "LDS map");

typedef pg8::u32x4 u32x4;
typedef float f32x16 __attribute__((ext_vector_type(16)));
typedef short s16x4 __attribute__((ext_vector_type(4)));
typedef unsigned u32x2 __attribute__((ext_vector_type(2)));
typedef float f32x2v __attribute__((ext_vector_type(2)));

template <int CTRL> __device__ __forceinline__ float dpp_mov(float v) { return __builtin_bit_cast(float, __builtin_amdgcn_update_dpp(0, __builtin_bit_cast(int, v), CTRL, 0xf, 0xf, true)); }
__device__ __forceinline__ float wave_allsum(float v) {
    v += dpp_mov<0xB1>(v); v += dpp_mov<0x4E>(v); v += dpp_mov<0x124>(v); v += dpp_mov<0x128>(v);
    { auto r = __builtin_amdgcn_permlane16_swap(__float_as_uint(v), __float_as_uint(v), false, false); v = __uint_as_float(r[0]) + __uint_as_float(r[1]); }
    { auto r = __builtin_amdgcn_permlane32_swap(__float_as_uint(v), __float_as_uint(v), false, false); v = __uint_as_float(r[0]) + __uint_as_float(r[1]); }
    return v;
}
__device__ __forceinline__ float xhalf_max(float v) { auto r = __builtin_amdgcn_permlane32_swap(__float_as_uint(v), __float_as_uint(v), false, false); return fmaxf(__uint_as_float(r[0]), __uint_as_float(r[1])); }
__device__ __forceinline__ float xhalf_sum(float v) { auto r = __builtin_amdgcn_permlane32_swap(__float_as_uint(v), __float_as_uint(v), false, false); return __uint_as_float(r[0]) + __uint_as_float(r[1]); }

struct Frame {
    LAS unsigned char* lds;
    volatile LAS unsigned* MISC;
    gu32* ctl;
    int tid, lane, wave, vcu, G;
};
struct Args { const float* in[23]; float* out; unsigned char* ws; int ph_lo, ph_hi, use_bar, variant; };

__device__ __forceinline__ void p0_transpose_item(const float* W, int K, int N, bf16* WT, int kind, LAS float* scr, int item, int lane) {
    const int nblk = N / 32, kb = item / nblk, nb = item % nblk, k0 = 64 * kb, n0 = 32 * nb;
    int drow = n0;
    if (kind == 1 || kind == 2) drow = 256 * (n0 >> 7) + 128 * (kind - 1) + (n0 & 127);
    else if (kind == 3) { if (n0 >= 1280 && n0 < 2304) { const int r = n0 - 1280; drow = 1280 + 256 * (r >> 7) + (r & 127); } else if (n0 >= 2304 && n0 < 3328) { const int r = n0 - 2304; drow = 1280 + 256 * (r >> 7) + 128 + (r & 127); } }
#pragma unroll 8
    for (int i = 0; i < 32; ++i) { const int kk = 2 * i + (lane >> 5); scr[kk * 33 + (lane & 31)] = W[(size_t)(k0 + kk) * N + n0 + (lane & 31)]; }
    LDS_WAIT(); asm volatile("" ::: "memory");
    const int c = lane & 7;
#pragma unroll
    for (int j = 0; j < 4; ++j) { const int n = (lane >> 3) + 8 * j; const LAS float* s = scr + (8 * c) * 33 + n;
        v4u o; o.x = pk2(s[0 * 33], s[1 * 33]); o.y = pk2(s[2 * 33], s[3 * 33]); o.z = pk2(s[4 * 33], s[5 * 33]); o.w = pk2(s[6 * 33], s[7 * 33]);
        *(GAS v4u*)(WT + (size_t)(drow + n) * K + k0 + 8 * c) = o; }
    LDS_WAIT(); asm volatile("" ::: "memory");
}
__device__ __forceinline__ void p0_prologue(Frame& F, const Args& a) {
    unsigned char* ws = a.ws;
    if (F.vcu < NMODW / 64) {
        LAS float* cact = (LAS float*)(F.lds);
        LAS float* red = (LAS float*)(F.lds + 65536);
        const float* c = a.in[1];
        for (int e = F.tid; e < BATCH * DM; e += NWAVES * 64) { const int b = e >> 10, k = e & 1023; const float v = c[e]; cact[k * 16 + b] = v / (1.f + __expf(-v)); }
        __syncthreads();
        const int col = F.vcu * 64 + F.lane; const float* w = a.in[2] + col;
        float acc[16];
#pragma unroll
        for (int b = 0; b < 16; ++b) acc[b] = 0.f;
        const int kbeg = F.wave * 128;
#pragma unroll 4
        for (int k = kbeg; k < kbeg + 128; ++k) { const float wv = w[(size_t)k * NMODW];
            const LAS f32x4* cp = (const LAS f32x4*)(cact + k * 16);
#pragma unroll
            for (int q = 0; q < 4; ++q) { const f32x4 cv = cp[q]; acc[4 * q] += cv[0] * wv; acc[4 * q + 1] += cv[1] * wv; acc[4 * q + 2] += cv[2] * wv; acc[4 * q + 3] += cv[3] * wv; } }
#pragma unroll
        for (int b = 0; b < 16; ++b) red[(F.wave * 16 + b) * 64 + F.lane] = acc[b];
        __syncthreads();
        float* mod = (float*)(ws + WS_MOD);
        for (int e = F.tid; e < 16 * 64; e += NWAVES * 64) { const int b = e >> 6, cl = e & 63; float s = a.in[3][F.vcu * 64 + cl];
#pragma unroll
            for (int wv = 0; wv < 8; ++wv) s += red[(wv * 16 + b) * 64 + cl];
            mod[(size_t)b * NMODW + F.vcu * 64 + cl] = s; }
        __syncthreads();
    }
    LAS float* scr = (LAS float*)(F.lds + RING_OFF + F.wave * 16384);
    const int gw = F.vcu * NWAVES + F.wave, NGW = F.G * NWAVES;
    constexpr int I_GU = (DM / 64) * (FF / 32), I_D = (FF / 64) * (DM / 32), I_IN = (DM / 64) * (NIN / 32), I_SQ = (DM / 64) * (DM / 32);
    constexpr int NITEMS = 4 * I_GU + 2 * I_D + I_IN + 3 * I_SQ;
    for (int it = gw; it < NITEMS; it += NGW) {
        int r = it;
        if (r < I_GU) { p0_transpose_item(a.in[5], DM, FF, (bf16*)(ws + WS_WGU1), 1, scr, r, F.lane); continue; } r -= I_GU;
        if (r < I_GU) { p0_transpose_item(a.in[6], DM, FF, (bf16*)(ws + WS_WGU1), 2, scr, r, F.lane); continue; } r -= I_GU;
        if (r < I_D) { p0_transpose_item(a.in[7], FF, DM, (bf16*)(ws + WS_WD1), 0, scr, r, F.lane); continue; } r -= I_D;
        if (r < I_IN) { p0_transpose_item(a.in[9], DM, NIN, (bf16*)(ws + WS_WIN), 3, scr, r, F.lane); continue; } r -= I_IN;
        if (r < I_SQ) { p0_transpose_item(a.in[11], DM, DM, (bf16*)(ws + WS_WAO), 0, scr, r, F.lane); continue; } r -= I_SQ;
        if (r < I_SQ) { p0_transpose_item(a.in[16], DM, DM, (bf16*)(ws + WS_WCO), 0, scr, r, F.lane); continue; } r -= I_SQ;
        if (r < I_SQ) { p0_transpose_item(a.in[17], DM, DM, (bf16*)(ws + WS_WOUT), 0, scr, r, F.lane); continue; } r -= I_SQ;
        if (r < I_GU) { p0_transpose_item(a.in[19], DM, FF, (bf16*)(ws + WS_WGU2), 1, scr, r, F.lane); continue; } r -= I_GU;
        if (r < I_GU) { p0_transpose_item(a.in[20], DM, FF, (bf16*)(ws + WS_WGU2), 2, scr, r, F.lane); continue; } r -= I_GU;
        p0_transpose_item(a.in[21], FF, DM, (bf16*)(ws + WS_WD2), 0, scr, r, F.lane);
    }
}

__device__ __forceinline__ void add_bf16x4(f32x4& v, u32x2 w) { v[0] += __uint_as_float(w.x << 16); v[1] += __uint_as_float(w.x & 0xffff0000u); v[2] += __uint_as_float(w.y << 16); v[3] += __uint_as_float(w.y & 0xffff0000u); }
template <int MODE, int NY>
__device__ __forceinline__ void norm_phase(Frame& F, const float* xin, const bf16* y1, const bf16* y2, const bf16* y3, const float* g, const float* mod, int shift_idx, bf16* H, float* out) {
    const int gw = F.vcu * NWAVES + F.wave, NGW = F.G * NWAVES;
    for (int ch = gw; ch < M / 16; ch += NGW) {
        const int b = (ch * 16) / SEQ;
        f32x4 A[4], Bv[4];
#pragma unroll
        for (int j = 0; j < 4; ++j) { const int c = 4 * F.lane + 256 * j; A[j] = *(const f32x4*)(g + c);
            if (MODE == 0) { const float* sh = mod + (size_t)b * NMODW + shift_idx * DM + c; A[j] = A[j] * (*(const f32x4*)(sh + DM) + 1.0f); Bv[j] = *(const f32x4*)sh; } }
#pragma unroll 2
        for (int r = 0; r < 16; ++r) {
            const size_t row = (size_t)ch * 16 + r;
            const GAS f32x4* xr = (const GAS f32x4*)(xin + row * DM) + F.lane;
            f32x4 v[4]; u32x2 d1[4], d2[4], d3[4];
#pragma unroll
            for (int j = 0; j < 4; ++j) { v[j] = xr[64 * j];
                if (NY >= 1) d1[j] = ((const GAS u32x2*)(y1 + row * DM) + F.lane)[64 * j];
                if (NY >= 2) d2[j] = ((const GAS u32x2*)(y2 + row * DM) + F.lane)[64 * j];
                if (NY >= 3) d3[j] = ((const GAS u32x2*)(y3 + row * DM) + F.lane)[64 * j]; }
            float s = 0.f;
#pragma unroll
            for (int j = 0; j < 4; ++j) { if (NY >= 1) add_bf16x4(v[j], d1[j]); if (NY >= 2) add_bf16x4(v[j], d2[j]); if (NY >= 3) add_bf16x4(v[j], d3[j]);
                s += (v[j][0] * v[j][0] + v[j][1] * v[j][1]) + (v[j][2] * v[j][2] + v[j][3] * v[j][3]); }
            const float rs = rsqrtf(wave_allsum(s) * (1.f / DM) + EPS);
            if (MODE == 0) {
                GAS u32x2* o8 = (GAS u32x2*)(H + row * DM) + F.lane;
#pragma unroll
                for (int j = 0; j < 4; ++j) { const f32x4 hv = v[j] * rs * A[j] + Bv[j]; u32x2 w; w.x = pg8::cvt_pk_bf16(hv[0], hv[1]); w.y = pg8::cvt_pk_bf16(hv[2], hv[3]); o8[64 * j] = w; }
            } else {
                GAS f32x4* o = (GAS f32x4*)(out + row * DM) + F.lane;
#pragma unroll
                for (int j = 0; j < 4; ++j) o[64 * j] = v[j] * rs * A[j];
            }
        }
    }
}

constexpr int AT_KROW = 144, AT_VT_OFF = 256 * AT_KROW, AT_VROW = 520;
__device__ __forceinline__ int crow(int r, int h) { return (r & 3) + 8 * (r >> 2) + 4 * h; }
__device__ __forceinline__ void attn_unit(Frame& F, int b, int n, int kvh, const bf16* Q, const bf16* Kb, const bf16* Vb, const float* sinks, bf16* AO) {
    LAS unsigned char* lds = F.lds;
    const int tid = F.tid, lane = F.lane, r32 = lane & 31, h = lane >> 5;
    const long band0 = (long)b * SEQ + (long)(n - 1) * 128;
#pragma unroll
    for (int i = 0; i < 4; ++i) {
        const int e = tid + 512 * i, sj = e >> 3, c8 = e & 7;
        u32x4 kv = {0u, 0u, 0u, 0u}, vv = {0u, 0u, 0u, 0u};
        if (n > 0 || sj >= 128) { const size_t off = (size_t)(band0 + sj) * 128 + kvh * 64 + c8 * 8; kv = *(const GAS u32x4*)(Kb + off); vv = *(const GAS u32x4*)(Vb + off); }
        *(LAS u32x4*)(lds + sj * AT_KROW + c8 * 16) = kv;
#pragma unroll
        for (int i2 = 0; i2 < 8; ++i2) *(LAS unsigned short*)(lds + AT_VT_OFF + (c8 * 8 + i2) * AT_VROW + sj * 2) = (unsigned short)(vv[i2 >> 1] >> (16 * (i2 & 1)));
    }
    __syncthreads();
    const int hq = kvh * 8 + F.wave;
    const float L2E = 1.4426950408889634f;
    const float sink = sinks[hq] * L2E;
    const float NEG = -1.0e30f;
#pragma unroll 1
    for (int j = 0; j < 4; ++j) {
        const size_t token = (size_t)b * SEQ + n * 128 + 32 * j + r32;
        bf16x8 qr[4];
#pragma unroll
        for (int ks = 0; ks < 4; ++ks) qr[ks] = *(const GAS bf16x8*)(Q + token * 1024 + hq * 64 + 16 * ks + 8 * h);
        f32x16 S[5];
#pragma unroll
        for (int kbi = 0; kbi < 5; ++kbi) {
            f32x16 acc = {0.f, 0.f, 0.f, 0.f, 0.f, 0.f, 0.f, 0.f, 0.f, 0.f, 0.f, 0.f, 0.f, 0.f, 0.f, 0.f};
            const LAS unsigned char* kp = lds + (32 * (j + kbi) + r32) * AT_KROW + 16 * h;
#pragma unroll
            for (int ks = 0; ks < 4; ++ks) { const bf16x8 kf = *(const LAS bf16x8*)(kp + 32 * ks); acc = __builtin_amdgcn_mfma_f32_32x32x16_bf16(kf, qr[ks], acc, 0, 0, 0); }
            S[kbi] = acc;
        }
        float mx = sink;
#pragma unroll
        for (int kbi = 0; kbi < 5; ++kbi) {
            const bool blk_ok = (n > 0) || (j + kbi >= 4);
#pragma unroll
            for (int r = 0; r < 16; ++r) {
                const int cr = crow(r, h);
                bool ok = blk_ok;
                if (kbi == 0) ok = ok && (cr > r32);
                if (kbi == 4) ok = ok && (cr <= r32);
                const float s = ok ? S[kbi][r] * L2E : NEG;
                S[kbi][r] = s; mx = fmaxf(mx, s);
            }
        }
        mx = xhalf_max(mx);
        float l = 0.f;
#pragma unroll
        for (int kbi = 0; kbi < 5; ++kbi)
#pragma unroll
            for (int r = 0; r < 16; ++r) { const float p = __builtin_amdgcn_exp2f(S[kbi][r] - mx); S[kbi][r] = p; l += p; }
        l = xhalf_sum(l) + __builtin_amdgcn_exp2f(sink - mx);
        const float inv = 1.0f / l;
        f32x16 o0 = {0.f, 0.f, 0.f, 0.f, 0.f, 0.f, 0.f, 0.f, 0.f, 0.f, 0.f, 0.f, 0.f, 0.f, 0.f, 0.f}, o1 = o0;
#pragma unroll
        for (int kbi = 0; kbi < 5; ++kbi)
#pragma unroll
            for (int s2 = 0; s2 < 2; ++s2) {
                u32x4 pw; pw.x = pg8::cvt_pk_bf16(S[kbi][8 * s2 + 0], S[kbi][8 * s2 + 1]); pw.y = pg8::cvt_pk_bf16(S[kbi][8 * s2 + 2], S[kbi][8 * s2 + 3]);
                pw.z = pg8::cvt_pk_bf16(S[kbi][8 * s2 + 4], S[kbi][8 * s2 + 5]); pw.w = pg8::cvt_pk_bf16(S[kbi][8 * s2 + 6], S[kbi][8 * s2 + 7]);
                const bf16x8 pf = __builtin_bit_cast(bf16x8, pw);
                const int key0 = 32 * (j + kbi) + 16 * s2 + 4 * h;
                const LAS unsigned char* vp = lds + AT_VT_OFF + r32 * AT_VROW + key0 * 2;
                const s16x4 a0 = *(const LAS s16x4*)(vp), a1 = *(const LAS s16x4*)(vp + 16);
                const s16x4 c0 = *(const LAS s16x4*)(vp + 32 * AT_VROW), c1 = *(const LAS s16x4*)(vp + 32 * AT_VROW + 16);
                const bf16x8 vf0 = __builtin_shufflevector(a0, a1, 0, 1, 2, 3, 4, 5, 6, 7), vf1 = __builtin_shufflevector(c0, c1, 0, 1, 2, 3, 4, 5, 6, 7);
                o0 = __builtin_amdgcn_mfma_f32_32x32x16_bf16(vf0, pf, o0, 0, 0, 0);
                o1 = __builtin_amdgcn_mfma_f32_32x32x16_bf16(vf1, pf, o1, 0, 0, 0);
            }
        bf16* orow = AO + token * 1024 + hq * 64 + 4 * h;
#pragma unroll
        for (int g4 = 0; g4 < 4; ++g4) {
            u32x2 w0, w1;
            w0.x = pg8::cvt_pk_bf16(o0[4 * g4] * inv, o0[4 * g4 + 1] * inv); w0.y = pg8::cvt_pk_bf16(o0[4 * g4 + 2] * inv, o0[4 * g4 + 3] * inv);
            w1.x = pg8::cvt_pk_bf16(o1[4 * g4] * inv, o1[4 * g4 + 1] * inv); w1.y = pg8::cvt_pk_bf16(o1[4 * g4 + 2] * inv, o1[4 * g4 + 3] * inv);
            *(GAS u32x2*)(orow + 8 * g4) = w0; *(GAS u32x2*)(orow + 32 + 8 * g4) = w1;
        }
    }
    __syncthreads();
}

constexpr int CV_T = 32, CV_ROWS = CV_T + 30;
__device__ __forceinline__ void conv_unit(Frame& F, int cu, const bf16* U, const float* wdw, const float* bdw, const float* lng, const float* lnb, bf16* CA) {
    LAS unsigned char* lds = F.lds;
    const int tid = F.tid;
    const long m0 = (long)cu * CV_T; const int t0 = (int)(m0 % SEQ);
#pragma unroll 4
    for (int i = 0; i < 16; ++i) {
        const int e = tid + 512 * i, row = e >> 7, ch = e & 127;
        if (row < CV_ROWS) { u32x4 v = {0u, 0u, 0u, 0u}; if (t0 - 30 + row >= 0) v = *(const GAS u32x4*)(U + (size_t)(m0 - 30 + row) * 1024 + ch * 8); *(LAS u32x4*)(lds + row * 2048 + ch * 16) = v; }
    }
    __syncthreads();
    float w0[31], w1[31];
#pragma unroll
    for (int k = 0; k < 31; ++k) { const f32x2v wv = *(const GAS f32x2v*)(wdw + k * 1024 + 2 * tid); w0[k] = wv[0]; w1[k] = wv[1]; }
    const f32x2v bv = *(const GAS f32x2v*)(bdw + 2 * tid);
    const f32x2v gv = *(const GAS f32x2v*)(lng + 2 * tid), bv2 = *(const GAS f32x2v*)(lnb + 2 * tid);
    LAS float* red = (LAS float*)(lds + CV_ROWS * 2048);
    LAS float* stat = (LAS float*)(lds + CV_ROWS * 2048 + 1024);
#pragma unroll 1
    for (int gq = 0; gq < CV_T / 8; ++gq) {
        float y0[8], y1[8];
#pragma unroll
        for (int t = 0; t < 8; ++t) { y0[t] = bv[0]; y1[t] = bv[1]; }
        const LAS unsigned char* wp = lds + gq * 8 * 2048 + tid * 4;
#pragma unroll
        for (int i = 0; i < 38; ++i) {
            const unsigned uu = *(const LAS unsigned*)(wp + i * 2048);
            const float u0 = __uint_as_float(uu << 16), u1 = __uint_as_float(uu & 0xffff0000u);
#pragma unroll
            for (int t = 0; t < 8; ++t) { const int k = i - t; if (k >= 0 && k < 31) { y0[t] += w0[k] * u0; y1[t] += w1[k] * u1; } }
        }
#pragma unroll
        for (int t = 0; t < 8; ++t) {
            const float s = wave_allsum(y0[t] + y1[t]), q = wave_allsum(y0[t] * y0[t] + y1[t] * y1[t]);
            if (F.lane == 0) { red[(t * 8 + F.wave) * 2] = s; red[(t * 8 + F.wave) * 2 + 1] = q; }
        }
        __syncthreads();
        if (tid < 8) { float s = 0.f, q = 0.f;
#pragma unroll
            for (int w = 0; w < 8; ++w) { s += red[(tid * 8 + w) * 2]; q += red[(tid * 8 + w) * 2 + 1]; }
            const float mean = s * (1.f / DM), var = fmaxf(q * (1.f / DM) - mean * mean, 0.f);
            stat[tid * 2] = mean; stat[tid * 2 + 1] = rsqrtf(var + EPS); }
        __syncthreads();
#pragma unroll
        for (int t = 0; t < 8; ++t) {
            const float mean = stat[t * 2], rs = stat[t * 2 + 1];
            const float a = (y0[t] - mean) * rs * gv[0] + bv2[0], c = (y1[t] - mean) * rs * gv[1] + bv2[1];
            const float sa = a * pg8::sigm1(a), sc = c * pg8::sigm1(c);
            *(GAS unsigned*)(CA + (size_t)(m0 + gq * 8 + t) * 1024 + 2 * tid) = pg8::cvt_pk_bf16(sa, sc);
        }
    }
    __syncthreads();
}

__global__ void __launch_bounds__(NWAVES * 64, 2) mk_fwd(Args args) {
    extern __shared__ __attribute__((aligned(16))) unsigned char lds[];
    Frame F;
    F.lds = (LAS unsigned char*)lds;
    F.MISC = (volatile LAS unsigned*)(F.lds + MISC_OFF);
    F.tid = threadIdx.x; F.lane = F.tid & 63; F.wave = __builtin_amdgcn_readfirstlane(F.tid >> 6);
    F.G = gridDim.x; { const int bx = blockIdx.x; F.vcu = (F.G % 8 == 0) ? (bx % 8) * (F.G / 8) + bx / 8 : bx; }
    unsigned char* ws = args.ws;
    F.ctl = (gu32*)(ws + WS_CTL);
    for (int u = F.tid; u < 512 / 4; u += NWAVES * 64) ((LAS unsigned*)(F.lds + LDSCTL_OFF))[u] = 0u;
    __syncthreads();
    XcdBarrier bar; bar.bar = (unsigned*)(F.ctl + CW_BAR); bar.x = 0; bar.st = nullptr;
    if (args.use_bar) bar = xcd_barrier_post((unsigned*)(F.ctl + CW_BAR), F.MISC + 8);
    const int lo = args.ph_lo, hi = args.ph_hi;
#ifndef PHM
#define PHM 0x3FFF
#endif
#define IN(k) (((PHM >> (k)) & 1) && lo <= (k) && (k) < hi)
#define SEAM(k) do { if (IN(k) && IN((k) + 1)) xcd_barrier(bar); } while (0)

    const float* x = args.in[0]; float* out = args.out;
    LAS unsigned char* escr = F.lds + EPI_OFF + F.wave * pg8::EPI_WAVE_BYTES;
    float* mod = (float*)(ws + WS_MOD); bf16* H = (bf16*)(ws + WS_H); bf16* Y1 = (bf16*)(ws + WS_Y1); bf16* Y2 = (bf16*)(ws + WS_Y2); bf16* Y3 = H; bf16* ACT = (bf16*)(ws + WS_ACT);
    bf16* Qb = (bf16*)(ws + WS_Q); bf16* Kb = (bf16*)(ws + WS_K); bf16* Vb = (bf16*)(ws + WS_V); bf16* Ub = (bf16*)(ws + WS_U); bf16* CA = (bf16*)(ws + WS_CA);
    bf16* AO = (bf16*)(ws + WS_AO); bf16* YA = (bf16*)(ws + WS_YA); bf16* MG = (bf16*)(ws + WS_MG);
    bf16* GA = (bf16*)out; bf16* GC = GA + (size_t)M * DM;

    if (IN(0)) { p0_prologue(F, args); } SEAM(0);
    if (IN(1)) { norm_phase<0, 0>(F, x, nullptr, nullptr, nullptr, args.in[4], mod, 0, H, nullptr); } SEAM(1);
#ifndef STAGGER_TICKS
#define STAGGER_TICKS 0
#endif
#define STAGGER() do { if (STAGGER_TICKS) { const unsigned long long t0_ = __builtin_amdgcn_s_memrealtime(); const unsigned long long dl_ = (unsigned long long)(F.vcu & 3) * STAGGER_TICKS; while (__builtin_amdgcn_s_memrealtime() - t0_ < dl_) __builtin_amdgcn_s_sleep(8); __syncthreads(); } } while (0)
    if (IN(2)) { STAGGER(); pg8::Gemm g{H, (const bf16*)(ws + WS_WGU1), M, 2 * FF, DM, args.variant == 1}; pg8::StaticOrder S; S.init(M, 2 * FF, F.G, (int)blockIdx.x);
        pg8::EpiSwiGLU E{ACT, FF, escr, 0}; if (args.variant == 2) { E.O = (bf16*)(ws + WS_END) + (size_t)blockIdx.x * 32768; E.ldc = 128; E.local = 1; }
        pg8::gemm_phase<pg8::EpiSwiGLU, pg8::StaticOrder, true, true>(F.lds + RING_OFF, g, S, E); } SEAM(2);
    if (IN(3)) { pg8::Gemm g{ACT, (const bf16*)(ws + WS_WD1), M, DM, FF, args.variant}; pg8::StaticOrder S; S.init(M, DM, F.G, (int)blockIdx.x);
        typedef pg8::EpiDelta<NMODW, SEQ / 256, 1> EpiD; EpiD E{Y1, mod + 2 * DM, escr};
        pg8::gemm_phase<EpiD, pg8::StaticOrder, true, true>(F.lds + RING_OFF, g, S, E); } SEAM(3);
    if (IN(4)) { norm_phase<0, 1>(F, x, Y1, nullptr, nullptr, args.in[8], mod, 3, H, nullptr); } SEAM(4);
    if (IN(5)) { STAGGER(); pg8::Gemm g{H, (const bf16*)(ws + WS_WIN), M, NIN, DM, args.variant}; pg8::StaticOrder S; S.init(M, NIN, F.G, (int)blockIdx.x);
        pg8::EpiIn E{Qb, Kb, Vb, Ub, GA, GC, escr};
        pg8::gemm_phase<pg8::EpiIn, pg8::StaticOrder, true, true>(F.lds + RING_OFF, g, S, E); } SEAM(5);
    if (IN(6)) {
#ifndef ATTN_REP
#define ATTN_REP 1
#endif
#ifndef CONV_REP
#define CONV_REP 1
#endif
#ifndef NO_ATTN
        for (int rep_ = 0; rep_ < ATTN_REP; ++rep_) for (int uidx = F.vcu; uidx < BATCH * 16 * 2; uidx += F.G) { const int kvh = uidx & 1, n = (uidx >> 1) & 15, b = uidx >> 5; attn_unit(F, b, n, kvh, Qb, Kb, Vb, args.in[10], AO); }
#endif
#ifndef NO_CONV
        for (int rep_ = 0; rep_ < CONV_REP; ++rep_) for (int cu = F.vcu; cu < M / CV_T; cu += F.G) conv_unit(F, cu, Ub, args.in[12], args.in[13], args.in[14], args.in[15], CA);
#endif
    } SEAM(6);
    if (IN(7)) { pg8::Gemm g{AO, (const bf16*)(ws + WS_WAO), M, DM, DM, args.variant}; pg8::StaticOrder S; S.init(M, DM, F.G, (int)blockIdx.x);
        pg8::EpiGate<0> E{GA, nullptr, YA, escr};
        pg8::gemm_phase<pg8::EpiGate<0>, pg8::StaticOrder, true, true>(F.lds + RING_OFF, g, S, E); }
    if (IN(8)) { pg8::Gemm g{CA, (const bf16*)(ws + WS_WCO), M, DM, DM, args.variant}; pg8::StaticOrder S; S.init(M, DM, F.G, (int)blockIdx.x);
        pg8::EpiGate<1> E{GC, YA, MG, escr};
        pg8::gemm_phase<pg8::EpiGate<1>, pg8::StaticOrder, true, true>(F.lds + RING_OFF, g, S, E); } SEAM(8);
    if (IN(9)) { pg8::Gemm g{MG, (const bf16*)(ws + WS_WOUT), M, DM, DM, args.variant}; pg8::StaticOrder S; S.init(M, DM, F.G, (int)blockIdx.x);
        typedef pg8::EpiDelta<NMODW, SEQ / 256, 0> EpiD; EpiD E{Y2, mod + 5 * DM, escr};
        pg8::gemm_phase<EpiD, pg8::StaticOrder, true, true>(F.lds + RING_OFF, g, S, E); } SEAM(9);
    if (IN(10)) { norm_phase<0, 2>(F, x, Y1, Y2, nullptr, args.in[18], mod, 6, H, nullptr); } SEAM(10);
    if (IN(11)) { STAGGER(); pg8::Gemm g{H, (const bf16*)(ws + WS_WGU2), M, 2 * FF, DM, args.variant}; pg8::StaticOrder S; S.init(M, 2 * FF, F.G, (int)blockIdx.x);
        pg8::EpiSwiGLU E{ACT, FF, escr, 0};
        pg8::gemm_phase<pg8::EpiSwiGLU, pg8::StaticOrder, true, true>(F.lds + RING_OFF, g, S, E); } SEAM(11);
    if (IN(12)) { pg8::Gemm g{ACT, (const bf16*)(ws + WS_WD2), M, DM, FF, args.variant}; pg8::StaticOrder S; S.init(M, DM, F.G, (int)blockIdx.x);
        typedef pg8::EpiDelta<NMODW, SEQ / 256, 1> EpiD; EpiD E{Y3, mod + 8 * DM, escr};
        pg8::gemm_phase<EpiD, pg8::StaticOrder, true, true>(F.lds + RING_OFF, g, S, E); } SEAM(12);
    if (IN(13)) { norm_phase<1, 3>(F, x, Y1, Y2, Y3, args.in[22], nullptr, 0, nullptr, out); }
#undef IN
#undef SEAM
}

#ifndef SPLIT_LAUNCH
#define SPLIT_LAUNCH 0
#endif
#ifndef REPEAT_MASK
#define REPEAT_MASK 0
#endif
#ifndef PROBE_VARIANT
#define PROBE_VARIANT 0
#endif
extern "C" void kernel_launch(void* const* d_in, const int* in_sizes, int n_in, void* d_out, int out_size, void* d_ws, size_t ws_size, hipStream_t stream) {
    static int grid = 0;
    if (grid == 0) {
        if (n_in != 23 || in_sizes[0] != M * DM || out_size != M * DM || ws_size < WS_END + 16 * MiB) {
            fprintf(stderr, "kernel_launch: unexpected shapes n_in %d in0 %d out %d ws %zu\n", n_in, n_in > 0 ? in_sizes[0] : -1, out_size, ws_size); grid = -1; return; }
        int dev = 0, cus = 0, per_cu = 0;
        if (hipGetDevice(&dev) != hipSuccess || hipDeviceGetAttribute(&cus, hipDeviceAttributeMultiprocessorCount, dev) != hipSuccess) { fprintf(stderr, "kernel_launch: device query failed\n"); grid = -1; return; }
        if (hipFuncSetAttribute((const void*)mk_fwd, hipFuncAttributeMaxDynamicSharedMemorySize, LDS_BYTES) != hipSuccess) { fprintf(stderr, "kernel_launch: hipFuncSetAttribute failed\n"); grid = -1; return; }
        if (hipOccupancyMaxActiveBlocksPerMultiprocessor(&per_cu, (const void*)mk_fwd, NWAVES * 64, LDS_BYTES) != hipSuccess || per_cu < 1) { fprintf(stderr, "kernel_launch: occupancy query reports %d workgroups per CU\n", per_cu); }
        (void)hipGetLastError();
        grid = cus;
    }
    if (grid < 0) return;
    (void)hipMemsetAsync((unsigned char*)d_ws + WS_CTL, 0, CTL_ZERO_BYTES, stream);
    Args a{};
    for (int i = 0; i < 23; ++i) a.in[i] = (const float*)d_in[i];
    a.out = (float*)d_out; a.ws = (unsigned char*)d_ws;
    if (!SPLIT_LAUNCH) {
        a.ph_lo = 0; a.ph_hi = NPHASE; a.use_bar = 1; a.variant = 0;
        hipLaunchKernelGGL(mk_fwd, dim3(grid), dim3(NWAVES * 64), LDS_BYTES, stream, a);
        return;
    }
    for (int k = 0; k < NPHASE; ++k) {
        a.ph_lo = k; a.ph_hi = k + 1; a.use_bar = 0;
        for (int rep = 0; rep < 1 + ((REPEAT_MASK >> k) & 1); ++rep) { a.variant = (((REPEAT_MASK >> k) & 1) && rep == 0) ? PROBE_VARIANT : 0; hipLaunchKernelGGL(mk_fwd, dim3(grid), dim3(NWAVES * 64), LDS_BYTES, stream, a); }
    }
}
```

```cpp
#include <hip/hip_runtime.h>
#include <cstdio>
#include <cstdint>

typedef unsigned short bf16_t;
constexpr int BATCH = 16, SEQ = 2048, DM = 1024, M = BATCH * SEQ, FF = 2816, NIN = 5376, NMODW = 9 * DM;
constexpr float EPS = 1e-6f;

__device__ __forceinline__ float bf2f(bf16_t v) { return __uint_as_float(((unsigned)v) << 16); }
__device__ __forceinline__ bf16_t f2bf(float f) { unsigned u = __float_as_uint(f); return (bf16_t)((u + 0x7fffu + ((u >> 16) & 1u)) >> 16); }
__device__ __forceinline__ float sigm(float x) { return 1.f / (1.f + __expf(-x)); }
__device__ __forceinline__ float silu(float x) { return x / (1.f + __expf(-x)); }

constexpr size_t MiB = 1u << 20;
constexpr size_t WS_CTL = 0, WS_MOD = 1 * MiB;
constexpr size_t WS_H = 52 * MiB;
constexpr size_t WS_Y1 = 116 * MiB, WS_Y2 = 180 * MiB;
constexpr size_t WS_ACT = 244 * MiB;
constexpr size_t WS_Q = 244 * MiB;
constexpr size_t WS_K = 308 * MiB;
constexpr size_t WS_V = 316 * MiB;
constexpr size_t WS_U = 324 * MiB;
constexpr size_t WS_CA = 388 * MiB;
constexpr size_t WS_END = 452 * MiB;
constexpr size_t WS_AO = WS_H, WS_YA = WS_Q, WS_MG = WS_U;

namespace pg8 {
#define PG8_LAS __attribute__((address_space(3)))
typedef unsigned short bf16_t;
typedef short bf16x8 __attribute__((ext_vector_type(8)));
typedef float f32x4 __attribute__((ext_vector_type(4)));
typedef unsigned u32x4 __attribute__((ext_vector_type(4)));
constexpr int BM = 256, BK = 64, HALF = 128, HTB = HALF * BK * 2  , STAGE_BYTES = 8 * HTB, NXCD = 8, WGM = 8;

__host__ __device__ __forceinline__ int lds_byte(int r, int c) { const int st = (r >> 4) * 2 + (c >> 5), rr = r & 15, cc = c & 31, ob = rr * 64 + cc * 2; return st * 1024 + (ob ^ (((ob >> 9) & 1) << 5)); }
__host__ __device__ __forceinline__ void stage_rc(int b, int& R, int& C) { const int st = b / 1024, sb = b % 1024, swz = sb ^ (((sb >> 9) & 1) << 5); R = (st >> 1) * 16 + swz / 64; C = (st & 1) * 32 + (swz % 64) / 2; }
__host__ __device__ __forceinline__ int perm32(int rho) { const int n = rho >> 4, i = rho & 15; return 8 * (i >> 2) + 4 * n + (i & 3); }

__device__ __forceinline__ int lane_id() { unsigned z; asm volatile("s_mov_b32 %0, 0" : "=s"(z)); return (int)__builtin_amdgcn_mbcnt_hi(~0u, __builtin_amdgcn_mbcnt_lo(~0u, z)); }
struct Unit { int pm, pn; };
struct Gemm { const bf16_t* A; const bf16_t* Bt; int M, N, K, wave; };

struct StaticOrder {
    int nM, nN, nwg, G, c;
    __host__ __device__ void init(int M, int N, int G_, int c_) { nM = M / BM; nN = N / BM; nwg = nM * nN; G = G_; c = c_; }
    __host__ __device__ bool next(int i, Unit& u) const {
        const long L = (long)i * G + c; if (L >= nwg) return false;
        int wgid = (int)L; { const int q = nwg / NXCD, r = nwg % NXCD, xcd = wgid % NXCD, off = wgid / NXCD; wgid = (xcd < r ? xcd * (q + 1) : r * (q + 1) + (xcd - r) * q) + off; }
        const int nig = WGM * nN, gid = wgid / nig, fm = gid * WGM, gsz = (nM - fm) < WGM ? (nM - fm) : WGM;
        u.pm = fm + ((wgid % nig) % gsz); u.pn = (wgid % nig) / gsz; return true;
    }
    __device__ __forceinline__ void a_ready(const Unit&) const {}
    __device__ __forceinline__ void done(const Unit&) const {}
};

typedef float f32x2 __attribute__((ext_vector_type(2)));
typedef __bf16 bf16x2_t __attribute__((ext_vector_type(2)));
constexpr int EPI_ROWB = 144, EPI_WAVE_BYTES = 16 * EPI_ROWB;
__device__ __forceinline__ unsigned cvt_pk_bf16(float lo, float hi) { f32x2 v = {lo, hi}; bf16x2_t b = __builtin_convertvector(v, bf16x2_t); return __builtin_bit_cast(unsigned, b); }
__device__ __forceinline__ u32x4 pack8(f32x4 a, f32x4 b) { u32x4 w; w.x = cvt_pk_bf16(a[0], a[1]); w.y = cvt_pk_bf16(a[2], a[3]); w.z = cvt_pk_bf16(b[0], b[1]); w.w = cvt_pk_bf16(b[2], b[3]); return w; }
__device__ __forceinline__ void unpack8(u32x4 w, f32x4& a, f32x4& b) {
    a[0] = __uint_as_float(w.x << 16); a[1] = __uint_as_float(w.x & 0xffff0000u); a[2] = __uint_as_float(w.y << 16); a[3] = __uint_as_float(w.y & 0xffff0000u);
    b[0] = __uint_as_float(w.z << 16); b[1] = __uint_as_float(w.z & 0xffff0000u); b[2] = __uint_as_float(w.w << 16); b[3] = __uint_as_float(w.w & 0xffff0000u); }
__device__ __forceinline__ float sigm1(float x) { return __builtin_amdgcn_rcpf(1.0f + __builtin_amdgcn_exp2f(x * -1.4426950408889634f)); }
__device__ __forceinline__ f32x4 sigm4(f32x4 x) { f32x4 r; r[0] = sigm1(x[0]); r[1] = sigm1(x[1]); r[2] = sigm1(x[2]); r[3] = sigm1(x[3]); return r; }
template <bool PERM> __device__ __forceinline__ void epi_put(PG8_LAS unsigned char* scr, int fr, int fq, f32x4 v0, f32x4 v1) {
    const int c0 = PERM ? 8 * fq : 4 * fq, c1 = PERM ? 8 * fq + 4 : 16 + 4 * fq;
    *(PG8_LAS f32x4*)(scr + fr * EPI_ROWB + c0 * 4) = v0; *(PG8_LAS f32x4*)(scr + fr * EPI_ROWB + c1 * 4) = v1; }
__device__ __forceinline__ void epi_get8(PG8_LAS unsigned char* scr, int lane, f32x4& a, f32x4& b) {
    PG8_LAS unsigned char* p = scr + (lane >> 2) * EPI_ROWB + (lane & 3) * 32; a = *(PG8_LAS f32x4*)p; b = *(PG8_LAS f32x4*)(p + 16); }
__device__ __forceinline__ f32x4 epi_get4(PG8_LAS unsigned char* scr, int lane, int pass) {
    return *(PG8_LAS f32x4*)(scr + ((lane >> 3) + 8 * pass) * EPI_ROWB + (lane & 7) * 16); }

struct EpiSwiGLU {
    static constexpr bool PERM = true, AFTER_DRAIN = false; static constexpr int NST = 8;
    bf16_t* O; int ldc; PG8_LAS unsigned char* scr; int local;
    __device__ __forceinline__ void operator()(const f32x4 (&acc)[2][2][4][2], const Unit& u, int wr, int wc, int fr, int fq) const {
        asm volatile("" : "+v"(fr), "+v"(fq));
        const int lane = fr + 16 * fq;
        bf16_t* base = O + (size_t)((local ? 0 : u.pm * BM) + wr * 64 + (lane >> 2)) * ldc + (local ? 0 : u.pn * HALF) + wc * 32 + 8 * (lane & 3);
#pragma unroll
        for (int ai = 0; ai < 2; ++ai)
#pragma unroll
            for (int m = 0; m < 4; ++m) {
                const f32x4 g0 = acc[ai][0][m][0], g1 = acc[ai][0][m][1];
                epi_put<true>(scr, fr, fq, g0 * sigm4(g0) * acc[ai][1][m][0], g1 * sigm4(g1) * acc[ai][1][m][1]);
                f32x4 a, b; epi_get8(scr, lane, a, b);
                *(u32x4*)(base + (size_t)(ai * HALF + m * 16) * ldc) = pack8(a, b); }
    }
};
template <int GLD, int TPB, int HALFCOEF> struct EpiDelta {
    static constexpr bool PERM = true, AFTER_DRAIN = false; static constexpr int NST = 16;
    bf16_t* Y; const float* gate; PG8_LAS unsigned char* scr;
    __device__ __forceinline__ void operator()(const f32x4 (&acc)[2][2][4][2], const Unit& u, int wr, int wc, int fr, int fq) const {
        asm volatile("" : "+v"(fr), "+v"(fq));
        const int lane = fr + 16 * fq, b = u.pm / TPB, col0 = u.pn * BM + wc * 32 + 8 * (lane & 3); const float coef = HALFCOEF ? 0.5f : 1.0f;
        bf16_t* base = Y + (size_t)(u.pm * BM + wr * 64 + (lane >> 2)) * 1024 + col0;
        const float* gp = gate + (size_t)b * GLD + col0;
        const f32x4 g00 = *(const f32x4*)(gp) * coef, g01 = *(const f32x4*)(gp + 4) * coef, g10 = *(const f32x4*)(gp + HALF) * coef, g11 = *(const f32x4*)(gp + HALF + 4) * coef;
#pragma unroll
        for (int ai = 0; ai < 2; ++ai)
#pragma unroll
            for (int m = 0; m < 4; ++m) {
                { epi_put<true>(scr, fr, fq, acc[ai][0][m][0], acc[ai][0][m][1]); f32x4 a, c; epi_get8(scr, lane, a, c);
                  *(u32x4*)(base + (size_t)(ai * HALF + m * 16) * 1024) = pack8(a * g00, c * g01); }
                { epi_put<true>(scr, fr, fq, acc[ai][1][m][0], acc[ai][1][m][1]); f32x4 a, c; epi_get8(scr, lane, a, c);
                  *(u32x4*)(base + (size_t)(ai * HALF + m * 16) * 1024 + HALF) = pack8(a * g10, c * g11); } }
    }
};
struct EpiIn {
    static constexpr bool PERM = true, AFTER_DRAIN = false; static constexpr int NST = 8;
    bf16_t *Q, *K, *V, *U, *GA, *GC; PG8_LAS unsigned char* scr;
    __device__ __forceinline__ void operator()(const f32x4 (&acc)[2][2][4][2], const Unit& u, int wr, int wc, int fr, int fq) const {
        asm volatile("" : "+v"(fr), "+v"(fq));
        const int lane = fr + 16 * fq, pn = u.pn, cw = wc * 32 + 8 * (lane & 3);
        const size_t row0 = (size_t)(u.pm * BM + wr * 64 + (lane >> 2));
        if (pn >= 5 && pn < 13) {
            bf16_t* base = U + row0 * 1024 + (pn - 5) * HALF + cw;
#pragma unroll
            for (int ai = 0; ai < 2; ++ai)
#pragma unroll
                for (int m = 0; m < 4; ++m) {
                    epi_put<true>(scr, fr, fq, acc[ai][0][m][0] * sigm4(acc[ai][1][m][0]), acc[ai][0][m][1] * sigm4(acc[ai][1][m][1]));
                    f32x4 a, b; epi_get8(scr, lane, a, b);
                    *(u32x4*)(base + (size_t)(ai * HALF + m * 16) * 1024) = pack8(a, b); }
        } else if (pn >= 13) {
            bf16_t* base = (pn < 17 ? GA + (pn - 13) * BM : GC + (pn - 17) * BM) + row0 * 1024 + cw;
#pragma unroll
            for (int ai = 0; ai < 2; ++ai)
#pragma unroll
                for (int m = 0; m < 4; ++m)
#pragma unroll
                    for (int bj = 0; bj < 2; ++bj) {
                        epi_put<true>(scr, fr, fq, sigm4(acc[ai][bj][m][0]), sigm4(acc[ai][bj][m][1]));
                        f32x4 a, b; epi_get8(scr, lane, a, b);
                        *(u32x4*)(base + (size_t)(ai * HALF + m * 16) * 1024 + bj * HALF) = pack8(a, b); }
        } else {
            bf16_t* b0; bf16_t* b1; int ld; float sc;
            if (pn < 4) { b0 = Q + row0 * 1024 + pn * BM + cw; b1 = b0 + HALF; ld = 1024; sc = 0.125f; } else { b0 = K + row0 * 128 + cw; b1 = V + row0 * 128 + cw; ld = 128; sc = 1.0f; }
#pragma unroll
            for (int ai = 0; ai < 2; ++ai)
#pragma unroll
                for (int m = 0; m < 4; ++m)
#pragma unroll
                    for (int bj = 0; bj < 2; ++bj) {
                        epi_put<true>(scr, fr, fq, acc[ai][bj][m][0] * sc, acc[ai][bj][m][1] * sc);
                        f32x4 a, b; epi_get8(scr, lane, a, b);
                        *(u32x4*)((bj ? b1 : b0) + (size_t)(ai * HALF + m * 16) * ld) = pack8(a, b); }
        }
    }
};
template <int MODE> struct EpiGate {
    static constexpr bool PERM = true, AFTER_DRAIN = false; static constexpr int NST = 16;
    const bf16_t* G; const bf16_t* Y; bf16_t* O; PG8_LAS unsigned char* scr;
    __device__ __forceinline__ void operator()(const f32x4 (&acc)[2][2][4][2], const Unit& u, int wr, int wc, int fr, int fq) const {
        asm volatile("" : "+v"(fr), "+v"(fq));
        const int lane = fr + 16 * fq;
        const size_t off0 = (size_t)(u.pm * BM + wr * 64 + (lane >> 2)) * 1024 + u.pn * BM + wc * 32 + 8 * (lane & 3);
#pragma unroll
        for (int ai = 0; ai < 2; ++ai) {
            u32x4 gw[4][2], yw[4][2];
#pragma unroll
            for (int m = 0; m < 4; ++m)
#pragma unroll
                for (int bj = 0; bj < 2; ++bj) { const size_t off = off0 + (size_t)(ai * HALF + m * 16) * 1024 + bj * HALF; gw[m][bj] = *(const u32x4*)(G + off); if (MODE == 1) yw[m][bj] = *(const u32x4*)(Y + off); }
            asm volatile("" ::: "memory");
#pragma unroll
            for (int m = 0; m < 4; ++m)
#pragma unroll
                for (int bj = 0; bj < 2; ++bj) { const size_t off = off0 + (size_t)(ai * HALF + m * 16) * 1024 + bj * HALF;
                    epi_put<true>(scr, fr, fq, acc[ai][bj][m][0], acc[ai][bj][m][1]);
                    f32x4 a, b; epi_get8(scr, lane, a, b);
                    f32x4 g0, g1; unpack8(gw[m][bj], g0, g1);
                    f32x4 v0 = g0 * a, v1 = g1 * b;
                    if (MODE == 1) { f32x4 y0, y1; unpack8(yw[m][bj], y0, y1); v0 += y0; v1 += y1; }
                    *(u32x4*)(O + off) = pack8(v0, v1); }
            asm volatile("" ::: "memory");
        }
    }
};
template <class Epi, class Sched, bool ALIGN_EPI = false, bool SP2 = false>
__device__ __forceinline__ void gemm_phase(PG8_LAS unsigned char* lds, const Gemm g, const Sched& S, const Epi& E) {
    int tid = (g.wave << 6) | lane_id(); asm volatile("" : "+v"(tid));
    const int wid = __builtin_amdgcn_readfirstlane(tid >> 6), lane = tid & 63, wr = wid >> 2, wc = wid & 3, fr = lane & 15, fq = lane >> 4;
    const int K = g.K, nt = K / BK;
    unsigned voffA[2], voffB[2];
#pragma unroll
    for (int i = 0; i < 2; ++i) { int R, C; stage_rc(tid * 16 + i * 8192, R, C); const int Rb = Epi::PERM ? ((R & ~31) + perm32(R & 31)) : R;
        voffA[i] = (unsigned)(R * K + C) * 2u; voffB[i] = (unsigned)(Rb * K + C) * 2u; }
    const size_t kstep = (size_t)(BK * 2);
    const size_t hstep = (size_t)HALF * K * 2;
    const size_t tstep = 2 * hstep;
    const unsigned ldsw = (unsigned)wid * 1024u;
    const int aoff = lds_byte(wr * 64 + fr, fq * 8), boff = lds_byte(wc * 32 + fr, fq * 8);
#define PG8_SA(b, h) (((b) * 2 + (h)) * HTB)
#define PG8_SB(b, h) ((4 + (b) * 2 + (h)) * HTB)
#define PG8_STAGE(bufoff, gbase, voff) do { _Pragma("unroll") for (int _i = 0; _i < 2; ++_i) \
        __builtin_amdgcn_global_load_lds((const unsigned*)((const char*)(gbase) + (voff)[_i]), (PG8_LAS unsigned*)(lds + (bufoff) + ldsw + _i * 8192), 16, 0, 0); } while (0)
#define PG8_LDA(dst, b, h) do { _Pragma("unroll") for (int m = 0; m < 4; ++m) _Pragma("unroll") for (int k = 0; k < 2; ++k) dst[m][k] = *(const PG8_LAS bf16x8*)(lds + PG8_SA(b, h) + aoff + m * 2048 + k * 1024); } while (0)
#define PG8_LDB(dst, b, h) do { _Pragma("unroll") for (int n = 0; n < 2; ++n) _Pragma("unroll") for (int k = 0; k < 2; ++k) dst[n][k] = *(const PG8_LAS bf16x8*)(lds + PG8_SB(b, h) + boff + n * 2048 + k * 1024); } while (0)
#define PG8_MMA(ai, bj, At, Bt) do { __builtin_amdgcn_s_setprio(1); _Pragma("unroll") for (int m = 0; m < 4; ++m) _Pragma("unroll") for (int n = 0; n < 2; ++n) _Pragma("unroll") for (int k = 0; k < 2; ++k) \
        acc[ai][bj][m][n] = __builtin_amdgcn_mfma_f32_16x16x32_bf16(Bt[n][k], At[m][k], acc[ai][bj][m][n], 0, 0, 0); __builtin_amdgcn_s_setprio(0); } while (0)
#define PG8_WAIT_V(n) asm volatile("s_waitcnt vmcnt(" #n ")" ::: "memory")
#define PG8_WAIT_L(n) asm volatile("s_waitcnt lgkmcnt(" #n ")" ::: "memory")
#define PG8_BAR __builtin_amdgcn_s_barrier()
#define PG8_SCHED __builtin_amdgcn_sched_barrier(0)
    Unit cur, nxt; int ui = 0;
    if (!S.next(0, cur)) return;
    f32x4 acc[2][2][4][2];
#pragma unroll
    for (int a = 0; a < 2; ++a)
#pragma unroll
        for (int b = 0; b < 2; ++b)
#pragma unroll
            for (int m = 0; m < 4; ++m)
#pragma unroll
                for (int n = 0; n < 2; ++n) acc[a][b][m][n] = (f32x4){0.f, 0.f, 0.f, 0.f};
    bf16x8 At[4][2], B0[2][2], B1[2][2];
    const char* cA = (const char*)g.A + (size_t)cur.pm * tstep; const char* cB = (const char*)g.Bt + (size_t)cur.pn * tstep;
    S.a_ready(cur);
    if constexpr (SP2) {
        PG8_STAGE(PG8_SB(0, 0), cB, voffB); PG8_STAGE(PG8_SB(0, 1), cB + hstep, voffB); PG8_STAGE(PG8_SA(0, 0), cA, voffA); PG8_STAGE(PG8_SA(0, 1), cA + hstep, voffA);
        if (wr == 1) PG8_BAR;
        PG8_WAIT_V(2); PG8_BAR;
        PG8_STAGE(PG8_SB(1, 0), cB + kstep, voffB); PG8_STAGE(PG8_SA(1, 0), cA + kstep, voffA); PG8_STAGE(PG8_SB(1, 1), cB + hstep + kstep, voffB);
        PG8_WAIT_V(6); PG8_BAR;
    } else {
        PG8_STAGE(PG8_SB(0, 0), cB, voffB); PG8_STAGE(PG8_SA(0, 0), cA, voffA); PG8_STAGE(PG8_SB(0, 1), cB + hstep, voffB); PG8_STAGE(PG8_SA(0, 1), cA + hstep, voffA);
        if (wr == 1) PG8_BAR;
        PG8_WAIT_V(4); PG8_BAR;
        PG8_STAGE(PG8_SB(1, 0), cB + kstep, voffB); PG8_STAGE(PG8_SA(1, 0), cA + kstep, voffA); PG8_STAGE(PG8_SB(1, 1), cB + hstep + kstep, voffB);
        PG8_WAIT_V(6); PG8_BAR;
    }
    static_assert(SP2 && ALIGN_EPI && !Epi::AFTER_DRAIN && Epi::NST > 0, "this copy of the body keeps only the SP2 + ALIGN_EPI + store-overlap form");
#define PG8_WAIT_VI(n) asm volatile("s_waitcnt vmcnt(%0)" :: "i"(n) : "memory")
#define PG8_TRIP(STG, WV) do { asm volatile("" : "+v"(voffA[0]), "+v"(voffA[1]), "+v"(voffB[0]), "+v"(voffB[1]));     \
            PG8_LDB(B0, 0, 0); PG8_LDB(B1, 0, 1); PG8_SCHED; PG8_LDA(At, 0, 0); if (STG) { PG8_STAGE(PG8_SA(1, 1), a1 + hstep, voffA); } \
            PG8_WAIT_VI(WV); PG8_WAIT_L(0); PG8_BAR; PG8_MMA(0, 0, At, B0); PG8_MMA(0, 1, At, B1); PG8_BAR; PG8_SCHED; \
            PG8_LDA(At, 0, 1); PG8_STAGE(PG8_SB(0, 0), b2, voffB); PG8_STAGE(PG8_SB(0, 1), b2 + hstep, voffB); PG8_STAGE(PG8_SA(0, 0), a2, voffA); \
            PG8_WAIT_VI(WV); PG8_WAIT_L(0); PG8_BAR; PG8_MMA(1, 0, At, B0); PG8_MMA(1, 1, At, B1); PG8_BAR; PG8_SCHED; \
            PG8_LDB(B0, 1, 0); PG8_LDB(B1, 1, 1); PG8_SCHED; PG8_LDA(At, 1, 0); PG8_STAGE(PG8_SA(0, 1), a2 + hstep, voffA); \
            PG8_WAIT_VI(WV); PG8_WAIT_L(0); PG8_BAR; PG8_MMA(0, 0, At, B0); PG8_MMA(0, 1, At, B1); PG8_BAR; PG8_SCHED; \
            PG8_LDA(At, 1, 1); PG8_STAGE(PG8_SB(1, 0), b3, voffB); PG8_STAGE(PG8_SB(1, 1), b3 + hstep, voffB); PG8_STAGE(PG8_SA(1, 0), a3, voffA); \
            PG8_WAIT_V(8); PG8_WAIT_L(0); PG8_BAR; PG8_MMA(1, 0, At, B0); PG8_MMA(1, 1, At, B1); PG8_BAR; PG8_SCHED; } while (0)
    {
        const char* a1 = cA + kstep; const char* a2 = cA + 2 * kstep; const char* b2 = cB + 2 * kstep; const char* a3 = a2 + kstep; const char* b3 = b2 + kstep;
        PG8_TRIP(true, 8);
    }
    for (;;) {
        const bool has_next = S.next(ui + 1, nxt);
        const char* nA = has_next ? (const char*)g.A + (size_t)nxt.pm * tstep : cA; const char* nB = has_next ? (const char*)g.Bt + (size_t)nxt.pn * tstep : cB;
        for (int t = 2; t < nt; t += 2) {
            const bool last = (t == nt - 2);
            const char* a1 = cA + (size_t)(t + 1) * kstep;
            const char* a2 = last ? nA : cA + (size_t)(t + 2) * kstep; const char* b2 = last ? nB : cB + (size_t)(t + 2) * kstep;
            const char* a3 = a2 + kstep; const char* b3 = b2 + kstep;
            if (last && has_next) S.a_ready(nxt);
            PG8_TRIP(true, 8);
            if (last) { PG8_STAGE(PG8_SA(1, 1), a3 + hstep, voffA); }
        }
        if (wr == 0) PG8_BAR;
        PG8_SCHED; E(acc, cur, wr, wc, fr, fq); PG8_SCHED;
        S.done(cur);
        if (!has_next) break;
#pragma unroll
        for (int a = 0; a < 2; ++a)
#pragma unroll
            for (int b = 0; b < 2; ++b)
#pragma unroll
                for (int m = 0; m < 4; ++m)
#pragma unroll
                    for (int n = 0; n < 2; ++n) acc[a][b][m][n] = (f32x4){0.f, 0.f, 0.f, 0.f};
        cur = nxt; cA = nA; cB = nB; ++ui;
        if (wr == 1) PG8_BAR;
        PG8_SCHED;
        {
            const char* a1 = cA + kstep; const char* a2 = cA + 2 * kstep; const char* b2 = cB + 2 * kstep; const char* a3 = a2 + kstep; const char* b3 = b2 + kstep; (void)a1;
            PG8_TRIP(false, 8 + Epi::NST);
        }
    }
#undef PG8_TRIP
#undef PG8_WAIT_VI
    PG8_WAIT_V(0);
    if constexpr (!ALIGN_EPI) { if (wr == 0) PG8_BAR; }
    PG8_BAR;
    if constexpr (Epi::AFTER_DRAIN) { E.fused(acc, cur, wr, wc, fr, fq, lds, wid, lane); S.done(cur); }
#undef PG8_SA
#undef PG8_SB
#undef PG8_STAGE
#undef PG8_LDA
#undef PG8_LDB
#undef PG8_MMA
#undef PG8_WAIT_V
#undef PG8_WAIT_L
#undef PG8_BAR
#undef PG8_SCHED
}
}
#define GAS __attribute__((address_space(1)))
#define LAS __attribute__((address_space(3)))
typedef unsigned short bf16;
typedef unsigned v4u __attribute__((ext_vector_type(4)));
typedef float f32x4 __attribute__((ext_vector_type(4)));
typedef short bf16x8 __attribute__((ext_vector_type(8)));
typedef GAS unsigned gu32;
typedef GAS unsigned long long gu64;
#define RLX_AGENT __ATOMIC_RELAXED, __HIP_MEMORY_SCOPE_AGENT
#define LDS_WAIT() asm volatile("s_waitcnt lgkmcnt(0)" ::: "memory")
#define VM_WAIT() asm volatile("s_waitcnt vmcnt(0)" ::: "memory")
__device__ __forceinline__ unsigned long long rt() { return __builtin_amdgcn_s_memrealtime(); }
__device__ __forceinline__ unsigned pk2(float lo, float hi) { return (unsigned)f2bf(lo) | ((unsigned)f2bf(hi) << 16); }

#define XB_TMO      128
#define XB_XCNT(j)  (256  + 64 * (j))
#define XB_XSUB(j)  (1280 + 64 * (j))
#define XB_XGEN(j)  (2304 + 64 * (j))
#define XB_TOP      3328
#define XB_TOPGEN   3392
#define XCD_BAR_WORDS 3456
#define XB_SPIN_CAP (1u << 18)

__device__ __forceinline__ unsigned xb_ld(unsigned* p)              { return __hip_atomic_load(p, __ATOMIC_RELAXED, __HIP_MEMORY_SCOPE_AGENT); }
__device__ __forceinline__ unsigned xb_add(unsigned* p, unsigned v) { return __hip_atomic_fetch_add(p, v, __ATOMIC_RELAXED, __HIP_MEMORY_SCOPE_AGENT); }
__device__ __forceinline__ unsigned xb_xcc_id() { return (unsigned)__builtin_amdgcn_s_getreg((3 << 11) | 20) & 0xFu; }
#define XB_SPIN(cond, bar) do { unsigned _sp = 0; while (cond) { __builtin_amdgcn_s_sleep(1); \
    if ((++_sp & 255u) == 0u) { if (xb_ld(&(bar)[XB_TMO])) break; if (_sp > XB_SPIN_CAP) { atomicAdd(&(bar)[XB_TMO], 1u); break; } } } } while (0)

struct XcdBarrier {
    unsigned* bar; unsigned x; int wave;
    volatile LAS unsigned* st;
};

__device__ __forceinline__ XcdBarrier xcd_barrier_post(unsigned* bar, volatile LAS unsigned* st, int wave) {
    XcdBarrier b; b.bar = bar; b.x = xb_xcc_id(); b.st = st; b.wave = wave;
    if (wave == 0 && pg8::lane_id() == 0) (void)xb_add(&bar[XB_XCNT(b.x)], 1u);
    return b;
}
__device__ __forceinline__ void xcd_barrier_complete(unsigned* bar, unsigned x, unsigned& nloc, unsigned& nx) {
    const unsigned G = gridDim.x * gridDim.y * gridDim.z;
    unsigned sum, cnt, mine, sp = 0u;
    for (;;) {
        sum = 0u; cnt = 0u; mine = 0u;
#pragma unroll
        for (unsigned j = 0; j < 16; ++j) { const unsigned c = xb_ld(&bar[XB_XCNT(j)]); sum += c; cnt += (c > 0u) ? 1u : 0u; mine = (j == x) ? c : mine; }
        if (sum == G) break;
        __builtin_amdgcn_s_sleep(1);
        if ((++sp & 255u) == 0u) { if (xb_ld(&bar[XB_TMO])) break; if (sp > XB_SPIN_CAP) { atomicAdd(&bar[XB_TMO], 1u); break; } }
    }
    nloc = mine > 0u ? mine : 1u; nx = cnt > 0u ? cnt : 1u;
}

__device__ __forceinline__ void xcd_barrier(const XcdBarrier& b) {
    asm volatile("s_waitcnt vmcnt(0)" ::: "memory");
    __syncthreads();
    if (b.wave == 0 && pg8::lane_id() == 0) {
        unsigned* bar = b.bar;
        __builtin_amdgcn_s_waitcnt(0);
        unsigned nloc = b.st[0], nx = b.st[1];
        if (nloc == 0u) { xcd_barrier_complete(bar, b.x, nloc, nx); b.st[0] = nloc; b.st[1] = nx; }
        const unsigned old = xb_add(&bar[XB_XSUB(b.x)], 1u);
        const unsigned gen = old / nloc;
        if (old + 1u == (gen + 1u) * nloc) {
            __builtin_amdgcn_fence(__ATOMIC_RELEASE, "agent");
            asm volatile("s_waitcnt vmcnt(0)" ::: "memory");
            const unsigned og = xb_add(&bar[XB_TOP], 1u);
            const unsigned tg = og / nx;
            if (og + 1u == (tg + 1u) * nx) xb_add(&bar[XB_TOPGEN], 1u);
            else XB_SPIN(xb_ld(&bar[XB_TOPGEN]) == tg, bar);
            __builtin_amdgcn_fence(__ATOMIC_ACQUIRE, "agent");
            xb_add(&bar[XB_XGEN(b.x)], 1u);
            asm volatile("s_waitcnt vmcnt(0)" ::: "memory");
        } else {
            XB_SPIN(xb_ld(&bar[XB_XGEN(b.x)]) == gen, bar);
            __builtin_amdgcn_fence(__ATOMIC_ACQUIRE, "agent");
            asm volatile("s_waitcnt vmcnt(0)" ::: "memory");
        }
    }
    __syncthreads();
}

constexpr int NWAVES = 8;
constexpr int NPHASE = 14;
constexpr size_t WS_WGU1 = 2 * MiB, WS_WD1 = 13 * MiB, WS_WIN = 18 * MiB + 512 * 1024, WS_WAO = 29 * MiB, WS_WCO = 31 * MiB, WS_WOUT = 33 * MiB, WS_WGU2 = 35 * MiB, WS_WD2 = 46 * MiB;
static_assert(WS_WD2 + (size_t)DM * FF * 2 <= WS_H, "weight copies end before H");
constexpr size_t CTL_ZERO_BYTES = 64 * 1024;
constexpr int CW_BAR = 4096;
constexpr int RING_OFF = 0, RING_BYTES = 131072, LDSCTL_OFF = RING_BYTES, MISC_OFF = LDSCTL_OFF + 320, EPI_OFF = RING_BYTES + 512, LDS_BYTES = 151552;
static_assert(EPI_OFF + NWAVES * pg8::EPI_WAVE_BYTES <= LDS_BYTES, "LDS map");

typedef pg8::u32x4 u32x4;
typedef float f32x16 __attribute__((ext_vector_type(16)));
typedef short s16x4 __attribute__((ext_vector_type(4)));
typedef unsigned u32x2 __attribute__((ext_vector_type(2)));
typedef float f32x2v __attribute__((ext_vector_type(2)));

template <int CTRL> __device__ __forceinline__ float dpp_mov(float v) { return __builtin_bit_cast(float, __builtin_amdgcn_update_dpp(0, __builtin_bit_cast(int, v), CTRL, 0xf, 0xf, true)); }
__device__ __forceinline__ float wave_allsum(float v) {
    v += dpp_mov<0xB1>(v); v += dpp_mov<0x4E>(v); v += dpp_mov<0x124>(v); v += dpp_mov<0x128>(v);
    { auto r = __builtin_amdgcn_permlane16_swap(__float_as_uint(v), __float_as_uint(v), false, false); v = __uint_as_float(r[0]) + __uint_as_float(r[1]); }
    { auto r = __builtin_amdgcn_permlane32_swap(__float_as_uint(v), __float_as_uint(v), false, false); v = __uint_as_float(r[0]) + __uint_as_float(r[1]); }
    return v;
}
__device__ __forceinline__ float xhalf_max(float v) { auto r = __builtin_amdgcn_permlane32_swap(__float_as_uint(v), __float_as_uint(v), false, false); return fmaxf(__uint_as_float(r[0]), __uint_as_float(r[1])); }
__device__ __forceinline__ float xhalf_sum(float v) { auto r = __builtin_amdgcn_permlane32_swap(__float_as_uint(v), __float_as_uint(v), false, false); return __uint_as_float(r[0]) + __uint_as_float(r[1]); }

struct Frame {
    LAS unsigned char* lds;
    volatile LAS unsigned* MISC;
    gu32* ctl;
    int wave, vcu, G;
    __device__ __forceinline__ int lane_() const { return pg8::lane_id(); }
    __device__ __forceinline__ int tid_() const { return (wave << 6) | pg8::lane_id(); }
};
struct Args { const float* in[23]; float* out; unsigned char* ws; int ph_lo, ph_hi, use_bar, variant; };

__device__ __forceinline__ void p0_transpose_item(const float* W, int K, int N, bf16* WT, int kind, LAS float* scr, int item, int lane) {
    const int nblk = N / 32, kb = item / nblk, nb = item % nblk, k0 = 64 * kb, n0 = 32 * nb;
    int drow = n0;
    if (kind == 1 || kind == 2) drow = 256 * (n0 >> 7) + 128 * (kind - 1) + (n0 & 127);
    else if (kind == 3) { if (n0 >= 1280 && n0 < 2304) { const int r = n0 - 1280; drow = 1280 + 256 * (r >> 7) + (r & 127); } else if (n0 >= 2304 && n0 < 3328) { const int r = n0 - 2304; drow = 1280 + 256 * (r >> 7) + 128 + (r & 127); } }
#pragma unroll 8
    for (int i = 0; i < 32; ++i) { const int kk = 2 * i + (lane >> 5); scr[kk * 33 + (lane & 31)] = W[(size_t)(k0 + kk) * N + n0 + (lane & 31)]; }
    LDS_WAIT(); asm volatile("" ::: "memory");
    const int c = lane & 7;
#pragma unroll
    for (int j = 0; j < 4; ++j) { const int n = (lane >> 3) + 8 * j; const LAS float* s = scr + (8 * c) * 33 + n;
        v4u o; o.x = pk2(s[0 * 33], s[1 * 33]); o.y = pk2(s[2 * 33], s[3 * 33]); o.z = pk2(s[4 * 33], s[5 * 33]); o.w = pk2(s[6 * 33], s[7 * 33]);
        *(GAS v4u*)(WT + (size_t)(drow + n) * K + k0 + 8 * c) = o; }
    LDS_WAIT(); asm volatile("" ::: "memory");
}
__device__ __forceinline__ void p0_prologue(Frame& F, const Args& a) {
    unsigned char* ws = a.ws;
    if (F.vcu < NMODW / 64) {
        LAS float* cact = (LAS float*)(F.lds);
        LAS float* red = (LAS float*)(F.lds + 65536);
        const float* c = a.in[1];
        for (int e = F.tid_(); e < BATCH * DM; e += NWAVES * 64) { const int b = e >> 10, k = e & 1023; const float v = c[e]; cact[k * 16 + b] = v / (1.f + __expf(-v)); }
        __syncthreads();
        const int col = F.vcu * 64 + F.lane_(); const float* w = a.in[2] + col;
        float acc[16];
#pragma unroll
        for (int b = 0; b < 16; ++b) acc[b] = 0.f;
        const int kbeg = F.wave * 128;
#pragma unroll 4
        for (int k = kbeg; k < kbeg + 128; ++k) { const float wv = w[(size_t)k * NMODW];
            const LAS f32x4* cp = (const LAS f32x4*)(cact + k * 16);
#pragma unroll
            for (int q = 0; q < 4; ++q) { const f32x4 cv = cp[q]; acc[4 * q] += cv[0] * wv; acc[4 * q + 1] += cv[1] * wv; acc[4 * q + 2] += cv[2] * wv; acc[4 * q + 3] += cv[3] * wv; } }
#pragma unroll
        for (int b = 0; b < 16; ++b) red[(F.wave * 16 + b) * 64 + F.lane_()] = acc[b];
        __syncthreads();
        float* mod = (float*)(ws + WS_MOD);
        for (int e = F.tid_(); e < 16 * 64; e += NWAVES * 64) { const int b = e >> 6, cl = e & 63; float s = a.in[3][F.vcu * 64 + cl];
#pragma unroll
            for (int wv = 0; wv < 8; ++wv) s += red[(wv * 16 + b) * 64 + cl];
            mod[(size_t)b * NMODW + F.vcu * 64 + cl] = s; }
        __syncthreads();
    }
    LAS float* scr = (LAS float*)(F.lds + RING_OFF + F.wave * 16384);
    const int gw = F.vcu * NWAVES + F.wave, NGW = F.G * NWAVES;
    constexpr int I_GU = (DM / 64) * (FF / 32), I_D = (FF / 64) * (DM / 32), I_IN = (DM / 64) * (NIN / 32), I_SQ = (DM / 64) * (DM / 32);
    constexpr int NITEMS = 4 * I_GU + 2 * I_D + I_IN + 3 * I_SQ;
    for (int it = gw; it < NITEMS; it += NGW) {
        int r = it;
        if (r < I_GU) { p0_transpose_item(a.in[5], DM, FF, (bf16*)(ws + WS_WGU1), 1, scr, r, F.lane_()); continue; } r -= I_GU;
        if (r < I_GU) { p0_transpose_item(a.in[6], DM, FF, (bf16*)(ws + WS_WGU1), 2, scr, r, F.lane_()); continue; } r -= I_GU;
        if (r < I_D) { p0_transpose_item(a.in[7], FF, DM, (bf16*)(ws + WS_WD1), 0, scr, r, F.lane_()); continue; } r -= I_D;
        if (r < I_IN) { p0_transpose_item(a.in[9], DM, NIN, (bf16*)(ws + WS_WIN), 3, scr, r, F.lane_()); continue; } r -= I_IN;
        if (r < I_SQ) { p0_transpose_item(a.in[11], DM, DM, (bf16*)(ws + WS_WAO), 0, scr, r, F.lane_()); continue; } r -= I_SQ;
        if (r < I_SQ) { p0_transpose_item(a.in[16], DM, DM, (bf16*)(ws + WS_WCO), 0, scr, r, F.lane_()); continue; } r -= I_SQ;
        if (r < I_SQ) { p0_transpose_item(a.in[17], DM, DM, (bf16*)(ws + WS_WOUT), 0, scr, r, F.lane_()); continue; } r -= I_SQ;
        if (r < I_GU) { p0_transpose_item(a.in[19], DM, FF, (bf16*)(ws + WS_WGU2), 1, scr, r, F.lane_()); continue; } r -= I_GU;
        if (r < I_GU) { p0_transpose_item(a.in[20], DM, FF, (bf16*)(ws + WS_WGU2), 2, scr, r, F.lane_()); continue; } r -= I_GU;
        p0_transpose_item(a.in[21], FF, DM, (bf16*)(ws + WS_WD2), 0, scr, r, F.lane_());
    }
}

__device__ __forceinline__ void add_bf16x4(f32x4& v, u32x2 w) { v[0] += __uint_as_float(w.x << 16); v[1] += __uint_as_float(w.x & 0xffff0000u); v[2] += __uint_as_float(w.y << 16); v[3] += __uint_as_float(w.y & 0xffff0000u); }
template <int MODE, int NY, bool XBF, bool SNAP>
__device__ __forceinline__ void norm_phase(Frame& F, const float* xin, const bf16* xb, const bf16* y1, const bf16* y2, const bf16* y3, bf16* snap, const float* g, const float* mod, int shift_idx, bf16* H, float* out) {
    const int gw = F.vcu * NWAVES + F.wave, NGW = F.G * NWAVES, lane = F.lane_();
    for (int ch = gw; ch < M / 16; ch += NGW) {
        const int b = (ch * 16) / SEQ;
        f32x4 A[4], Bv[4];
#pragma unroll
        for (int j = 0; j < 4; ++j) { const int c = 4 * lane + 256 * j; A[j] = *(const f32x4*)(g + c);
            if (MODE == 0) { const float* sh = mod + (size_t)b * NMODW + shift_idx * DM + c; A[j] = A[j] * (*(const f32x4*)(sh + DM) + 1.0f); Bv[j] = *(const f32x4*)sh; } }
#pragma unroll 2
        for (int r = 0; r < 16; ++r) {
            const size_t row = (size_t)ch * 16 + r;
            f32x4 v[4]; u32x2 d0[4], d1[4], d2[4], d3[4];
#pragma unroll
            for (int j = 0; j < 4; ++j) {
                if (XBF) d0[j] = ((const GAS u32x2*)(xb + row * DM) + lane)[64 * j]; else v[j] = ((const GAS f32x4*)(xin + row * DM) + lane)[64 * j];
                if (NY >= 1) d1[j] = ((const GAS u32x2*)(y1 + row * DM) + lane)[64 * j];
                if (NY >= 2) d2[j] = ((const GAS u32x2*)(y2 + row * DM) + lane)[64 * j];
                if (NY >= 3) d3[j] = ((const GAS u32x2*)(y3 + row * DM) + lane)[64 * j]; }
            float s = 0.f;
#pragma unroll
            for (int j = 0; j < 4; ++j) { if (XBF) { v[j] = (f32x4){0.f, 0.f, 0.f, 0.f}; add_bf16x4(v[j], d0[j]); }
                if (NY >= 1) add_bf16x4(v[j], d1[j]); if (NY >= 2) add_bf16x4(v[j], d2[j]); if (NY >= 3) add_bf16x4(v[j], d3[j]);
                s += (v[j][0] * v[j][0] + v[j][1] * v[j][1]) + (v[j][2] * v[j][2] + v[j][3] * v[j][3]); }
            const float rs = rsqrtf(wave_allsum(s) * (1.f / DM) + EPS);
            if (SNAP) { GAS u32x2* o8 = (GAS u32x2*)(snap + row * DM) + lane;
#pragma unroll
                for (int j = 0; j < 4; ++j) { u32x2 w; w.x = pg8::cvt_pk_bf16(v[j][0], v[j][1]); w.y = pg8::cvt_pk_bf16(v[j][2], v[j][3]); o8[64 * j] = w; } }
            if (MODE == 0) {
                GAS u32x2* o8 = (GAS u32x2*)(H + row * DM) + lane;
#pragma unroll
                for (int j = 0; j < 4; ++j) { const f32x4 hv = v[j] * rs * A[j] + Bv[j]; u32x2 w; w.x = pg8::cvt_pk_bf16(hv[0], hv[1]); w.y = pg8::cvt_pk_bf16(hv[2], hv[3]); o8[64 * j] = w; }
            } else {
                GAS f32x4* o = (GAS f32x4*)(out + row * DM) + lane;
#pragma unroll
                for (int j = 0; j < 4; ++j) o[64 * j] = v[j] * rs * A[j];
            }
        }
    }
}

constexpr int AT_KROW = 144, AT_VT_OFF = 256 * AT_KROW, AT_VROW = 520;
__device__ __forceinline__ int crow(int r, int h) { return (r & 3) + 8 * (r >> 2) + 4 * h; }
__device__ __forceinline__ void attn_unit(Frame& F, int b, int n, int kvh, const bf16* Q, const bf16* Kb, const bf16* Vb, const float* sinks, bf16* AO) {
    LAS unsigned char* lds = F.lds;
    const int tid = F.tid_(), lane = F.lane_(), r32 = lane & 31, h = lane >> 5;
    const long band0 = (long)b * SEQ + (long)(n - 1) * 128;
#pragma unroll
    for (int i = 0; i < 4; ++i) {
        const int e = tid + 512 * i, sj = e >> 3, c8 = e & 7;
        u32x4 kv = {0u, 0u, 0u, 0u}, vv = {0u, 0u, 0u, 0u};
        if (n > 0 || sj >= 128) { const size_t off = (size_t)(band0 + sj) * 128 + kvh * 64 + c8 * 8; kv = *(const GAS u32x4*)(Kb + off); vv = *(const GAS u32x4*)(Vb + off); }
        *(LAS u32x4*)(lds + sj * AT_KROW + c8 * 16) = kv;
#pragma unroll
        for (int i2 = 0; i2 < 8; ++i2) *(LAS unsigned short*)(lds + AT_VT_OFF + (c8 * 8 + i2) * AT_VROW + sj * 2) = (unsigned short)(vv[i2 >> 1] >> (16 * (i2 & 1)));
    }
    __syncthreads();
    const int hq = kvh * 8 + F.wave;
    const float L2E = 1.4426950408889634f;
    const float sink = sinks[hq] * L2E;
    const float NEG = -1.0e30f;
#pragma unroll 1
    for (int j = 0; j < 4; ++j) {
        const size_t token = (size_t)b * SEQ + n * 128 + 32 * j + r32;
        bf16x8 qr[4];
#pragma unroll
        for (int ks = 0; ks < 4; ++ks) qr[ks] = *(const GAS bf16x8*)(Q + token * 1024 + hq * 64 + 16 * ks + 8 * h);
        f32x16 S[5];
#pragma unroll
        for (int kbi = 0; kbi < 5; ++kbi) {
            f32x16 acc = {0.f, 0.f, 0.f, 0.f, 0.f, 0.f, 0.f, 0.f, 0.f, 0.f, 0.f, 0.f, 0.f, 0.f, 0.f, 0.f};
            const LAS unsigned char* kp = lds + (32 * (j + kbi) + r32) * AT_KROW + 16 * h;
#pragma unroll
            for (int ks = 0; ks < 4; ++ks) { const bf16x8 kf = *(const LAS bf16x8*)(kp + 32 * ks); acc = __builtin_amdgcn_mfma_f32_32x32x16_bf16(kf, qr[ks], acc, 0, 0, 0); }
            S[kbi] = acc;
        }
        float mx = sink;
#pragma unroll
        for (int kbi = 0; kbi < 5; ++kbi) {
            const bool blk_ok = (n > 0) || (j + kbi >= 4);
#pragma unroll
            for (int r = 0; r < 16; ++r) {
                const int cr = crow(r, h);
                bool ok = blk_ok;
                if (kbi == 0) ok = ok && (cr > r32);
                if (kbi == 4) ok = ok && (cr <= r32);
                const float s = ok ? S[kbi][r] * L2E : NEG;
                S[kbi][r] = s; mx = fmaxf(mx, s);
            }
        }
        mx = xhalf_max(mx);
        float l = 0.f;
#pragma unroll
        for (int kbi = 0; kbi < 5; ++kbi)
#pragma unroll
            for (int r = 0; r < 16; ++r) { const float p = __builtin_amdgcn_exp2f(S[kbi][r] - mx); S[kbi][r] = p; l += p; }
        l = xhalf_sum(l) + __builtin_amdgcn_exp2f(sink - mx);
        const float inv = 1.0f / l;
        f32x16 o0 = {0.f, 0.f, 0.f, 0.f, 0.f, 0.f, 0.f, 0.f, 0.f, 0.f, 0.f, 0.f, 0.f, 0.f, 0.f, 0.f}, o1 = o0;
#pragma unroll
        for (int kbi = 0; kbi < 5; ++kbi)
#pragma unroll
            for (int s2 = 0; s2 < 2; ++s2) {
                u32x4 pw; pw.x = pg8::cvt_pk_bf16(S[kbi][8 * s2 + 0], S[kbi][8 * s2 + 1]); pw.y = pg8::cvt_pk_bf16(S[kbi][8 * s2 + 2], S[kbi][8 * s2 + 3]);
                pw.z = pg8::cvt_pk_bf16(S[kbi][8 * s2 + 4], S[kbi][8 * s2 + 5]); pw.w = pg8::cvt_pk_bf16(S[kbi][8 * s2 + 6], S[kbi][8 * s2 + 7]);
                const bf16x8 pf = __builtin_bit_cast(bf16x8, pw);
                const int key0 = 32 * (j + kbi) + 16 * s2 + 4 * h;
                const LAS unsigned char* vp = lds + AT_VT_OFF + r32 * AT_VROW + key0 * 2;
                const s16x4 a0 = *(const LAS s16x4*)(vp), a1 = *(const LAS s16x4*)(vp + 16);
                const s16x4 c0 = *(const LAS s16x4*)(vp + 32 * AT_VROW), c1 = *(const LAS s16x4*)(vp + 32 * AT_VROW + 16);
                const bf16x8 vf0 = __builtin_shufflevector(a0, a1, 0, 1, 2, 3, 4, 5, 6, 7), vf1 = __builtin_shufflevector(c0, c1, 0, 1, 2, 3, 4, 5, 6, 7);
                o0 = __builtin_amdgcn_mfma_f32_32x32x16_bf16(vf0, pf, o0, 0, 0, 0);
                o1 = __builtin_amdgcn_mfma_f32_32x32x16_bf16(vf1, pf, o1, 0, 0, 0);
            }
        bf16* orow = AO + token * 1024 + hq * 64 + 4 * h;
#pragma unroll
        for (int g4 = 0; g4 < 4; ++g4) {
            u32x2 w0, w1;
            w0.x = pg8::cvt_pk_bf16(o0[4 * g4] * inv, o0[4 * g4 + 1] * inv); w0.y = pg8::cvt_pk_bf16(o0[4 * g4 + 2] * inv, o0[4 * g4 + 3] * inv);
            w1.x = pg8::cvt_pk_bf16(o1[4 * g4] * inv, o1[4 * g4 + 1] * inv); w1.y = pg8::cvt_pk_bf16(o1[4 * g4 + 2] * inv, o1[4 * g4 + 3] * inv);
            *(GAS u32x2*)(orow + 8 * g4) = w0; *(GAS u32x2*)(orow + 32 + 8 * g4) = w1;
        }
    }
    __syncthreads();
}

constexpr int CV_T = 32, CV_ROWS = CV_T + 30;
__device__ __forceinline__ void conv_phase(Frame& F, int first, int stride, int nunits, const bf16* U, const float* wdw, const float* bdw, const float* lng, const float* lnb, bf16* CA) {
    LAS unsigned char* lds = F.lds;
    const int tid = F.tid_();
    if (first >= nunits) return;
    float w0[31], w1[31];
#pragma unroll
    for (int k = 0; k < 31; ++k) { const f32x2v wv = *(const GAS f32x2v*)(wdw + k * 1024 + 2 * tid); w0[k] = wv[0]; w1[k] = wv[1]; }
    const f32x2v bv = *(const GAS f32x2v*)(bdw + 2 * tid);
    const f32x2v gv = *(const GAS f32x2v*)(lng + 2 * tid), bv2 = *(const GAS f32x2v*)(lnb + 2 * tid);
    LAS float* red = (LAS float*)(lds + CV_ROWS * 2048);
    LAS float* stat = (LAS float*)(lds + CV_ROWS * 2048 + 1024);
    u32x4 R[16];
    const int r0 = tid >> 7;
    int tbase = r0 * 2048 + (tid & 127) * 16;
#define CV_LOAD(cu_) do { const long m0_ = (long)(cu_) * CV_T; const int t0_ = (int)(m0_ % SEQ); asm volatile("" : "+v"(tbase)); \
        const unsigned char* gb_ = (const unsigned char*)U + (m0_ - 30) * 2048 + tbase; \
        _Pragma("unroll") for (int i = 0; i < 16; ++i) { R[i] = (u32x4){0u, 0u, 0u, 0u}; \
            if ((i < 15 || r0 < 2) && t0_ - 30 + r0 + 4 * i >= 0) R[i] = *(const GAS u32x4*)(gb_ + i * 8192); } } while (0)
#define CV_WRITE() do { asm volatile("" : "+v"(tbase)); _Pragma("unroll") for (int i = 0; i < 16; ++i) { if (i < 15 || r0 < 2) *(LAS u32x4*)(lds + tbase + i * 8192) = R[i]; } } while (0)
    CV_LOAD(first); CV_WRITE();
    __syncthreads();
    for (int cu = first; cu < nunits; cu += stride) {
        const long m0 = (long)cu * CV_T;
        const bool more = cu + stride < nunits;
        if (more) CV_LOAD(cu + stride);
#pragma unroll 1
        for (int gq = 0; gq < CV_T / 8; ++gq) {
            float y0[8], y1[8];
#pragma unroll
            for (int t = 0; t < 8; ++t) { y0[t] = bv[0]; y1[t] = bv[1]; }
            const LAS unsigned char* wp = lds + gq * 8 * 2048 + tid * 4;
#pragma unroll
            for (int i = 0; i < 38; ++i) {
                const unsigned uu = *(const LAS unsigned*)(wp + i * 2048);
                const float u0 = __uint_as_float(uu << 16), u1 = __uint_as_float(uu & 0xffff0000u);
#pragma unroll
                for (int t = 0; t < 8; ++t) { const int k = i - t; if (k >= 0 && k < 31) { y0[t] += w0[k] * u0; y1[t] += w1[k] * u1; } }
                if ((i & 7) == 7) asm volatile("" ::: "memory");
            }
#pragma unroll
            for (int t = 0; t < 8; ++t) {
                const float s = wave_allsum(y0[t] + y1[t]), q = wave_allsum(y0[t] * y0[t] + y1[t] * y1[t]);
                if (F.lane_() == 0) { red[(t * 8 + F.wave) * 2] = s; red[(t * 8 + F.wave) * 2 + 1] = q; }
            }
            __syncthreads();
            if (tid < 8) { float s = 0.f, q = 0.f;
#pragma unroll
                for (int w = 0; w < 8; ++w) { s += red[(tid * 8 + w) * 2]; q += red[(tid * 8 + w) * 2 + 1]; }
                const float mean = s * (1.f / DM), var = fmaxf(q * (1.f / DM) - mean * mean, 0.f);
                stat[tid * 2] = mean; stat[tid * 2 + 1] = rsqrtf(var + EPS); }
            __syncthreads();
#pragma unroll
            for (int t = 0; t < 8; ++t) {
                const float mean = stat[t * 2], rs = stat[t * 2 + 1];
                const float a = (y0[t] - mean) * rs * gv[0] + bv2[0], c = (y1[t] - mean) * rs * gv[1] + bv2[1];
                const float sa = a * pg8::sigm1(a), sc = c * pg8::sigm1(c);
                *(GAS unsigned*)(CA + (size_t)(m0 + gq * 8 + t) * 1024 + 2 * tid) = pg8::cvt_pk_bf16(sa, sc);
            }
        }
        __syncthreads();
        if (more) { CV_WRITE(); __syncthreads(); }
    }
#undef CV_LOAD
#undef CV_WRITE
}

__global__ void __launch_bounds__(NWAVES * 64, 2) mk_fwd(Args args) {
    extern __shared__ __attribute__((aligned(16))) unsigned char lds[];
    Frame F;
    F.lds = (LAS unsigned char*)lds;
    F.MISC = (volatile LAS unsigned*)(F.lds + MISC_OFF);
    F.wave = __builtin_amdgcn_readfirstlane((int)threadIdx.x >> 6);
    F.G = gridDim.x; { const int bx = blockIdx.x; F.vcu = (F.G % 8 == 0) ? (bx % 8) * (F.G / 8) + bx / 8 : bx; }
    unsigned char* ws = args.ws;
    F.ctl = (gu32*)(ws + WS_CTL);
    for (int u = F.tid_(); u < 512 / 4; u += NWAVES * 64) ((LAS unsigned*)(F.lds + LDSCTL_OFF))[u] = 0u;
    __syncthreads();
    XcdBarrier bar; bar.bar = (unsigned*)(F.ctl + CW_BAR); bar.x = 0; bar.st = nullptr; bar.wave = F.wave;
    if (args.use_bar) bar = xcd_barrier_post((unsigned*)(F.ctl + CW_BAR), F.MISC + 8, F.wave);
    const int lo = args.ph_lo, hi = args.ph_hi;
#ifndef PHM
#define PHM 0x3FFF
#endif
#define IN(k) (((PHM >> (k)) & 1) && lo <= (k) && (k) < hi)
#define SEAM(k) do { if (IN(k) && IN((k) + 1)) xcd_barrier(bar); } while (0)

    const float* x = args.in[0]; float* out = args.out;
    LAS unsigned char* escr = F.lds + EPI_OFF + F.wave * pg8::EPI_WAVE_BYTES;
    float* mod = (float*)(ws + WS_MOD); bf16* H = (bf16*)(ws + WS_H); bf16* Y1 = (bf16*)(ws + WS_Y1); bf16* Y2 = (bf16*)(ws + WS_Y2); bf16* Y3 = H; bf16* ACT = (bf16*)(ws + WS_ACT);
    bf16* Qb = (bf16*)(ws + WS_Q); bf16* Kb = (bf16*)(ws + WS_K); bf16* Vb = (bf16*)(ws + WS_V); bf16* Ub = (bf16*)(ws + WS_U); bf16* CA = (bf16*)(ws + WS_CA);
    bf16* AO = (bf16*)(ws + WS_AO); bf16* YA = (bf16*)(ws + WS_YA); bf16* MG = (bf16*)(ws + WS_MG);
    bf16* GA = (bf16*)out; bf16* GC = GA + (size_t)M * DM;

    if (IN(0)) { p0_prologue(F, args); } SEAM(0);
    if (IN(1)) { norm_phase<0, 0, false, false>(F, x, nullptr, nullptr, nullptr, nullptr, nullptr, args.in[4], mod, 0, H, nullptr); } SEAM(1);
#ifdef EXTRA_BARS
    if (args.use_bar) for (int eb_ = 0; eb_ < EXTRA_BARS; ++eb_) xcd_barrier(bar);
#endif
#ifndef STAGGER_TICKS
#define STAGGER_TICKS 0
#endif
#define STAGGER() do { if (STAGGER_TICKS) { const unsigned long long t0_ = __builtin_amdgcn_s_memrealtime(); const unsigned long long dl_ = (unsigned long long)(F.vcu & 3) * STAGGER_TICKS; while (__builtin_amdgcn_s_memrealtime() - t0_ < dl_) __builtin_amdgcn_s_sleep(8); __syncthreads(); } } while (0)
    if (IN(2)) { STAGGER(); pg8::Gemm g{H, (const bf16*)(ws + WS_WGU1), M, 2 * FF, DM, F.wave}; pg8::StaticOrder S; S.init(M, 2 * FF, F.G, (int)blockIdx.x);
        pg8::EpiSwiGLU E{ACT, FF, escr, 0};
        pg8::gemm_phase<pg8::EpiSwiGLU, pg8::StaticOrder, true, true>(F.lds + RING_OFF, g, S, E); } SEAM(2);
    if (IN(3)) { pg8::Gemm g{ACT, (const bf16*)(ws + WS_WD1), M, DM, FF, F.wave}; pg8::StaticOrder S; S.init(M, DM, F.G, (int)blockIdx.x);
        typedef pg8::EpiDelta<NMODW, SEQ / 256, 1> EpiD; EpiD E{Y1, mod + 2 * DM, escr};
        pg8::gemm_phase<EpiD, pg8::StaticOrder, true, true>(F.lds + RING_OFF, g, S, E); } SEAM(3);
    if (IN(4)) { norm_phase<0, 1, false, true>(F, x, nullptr, Y1, nullptr, nullptr,   Y1, args.in[8], mod, 3, H, nullptr); } SEAM(4);
    if (IN(5)) { STAGGER(); pg8::Gemm g{H, (const bf16*)(ws + WS_WIN), M, NIN, DM, F.wave}; pg8::StaticOrder S; S.init(M, NIN, F.G, (int)blockIdx.x);
        pg8::EpiIn E{Qb, Kb, Vb, Ub, GA, GC, escr};
        pg8::gemm_phase<pg8::EpiIn, pg8::StaticOrder, true, true>(F.lds + RING_OFF, g, S, E); } SEAM(5);
    if (IN(6)) {
#ifndef ATTN_REP
#define ATTN_REP 1
#endif
#ifndef CONV_REP
#define CONV_REP 1
#endif
#ifndef NO_ATTN
        if (args.variant != 2) for (int uidx = F.vcu; uidx < BATCH * 16 * 2; uidx += F.G) { const int kvh = uidx & 1, n = (uidx >> 1) & 15, b = uidx >> 5; attn_unit(F, b, n, kvh, Qb, Kb, Vb, args.in[10], AO); }
#endif
#ifndef NO_CONV
        if (args.variant != 1) conv_phase(F, F.vcu, F.G, M / CV_T, Ub, args.in[12], args.in[13], args.in[14], args.in[15], CA);
#endif
    } SEAM(6);
    if (IN(7)) { pg8::Gemm g{AO, (const bf16*)(ws + WS_WAO), M, DM, DM, F.wave}; pg8::StaticOrder S; S.init(M, DM, F.G, (int)blockIdx.x);
        pg8::EpiGate<0> E{GA, nullptr, YA, escr};
        pg8::gemm_phase<pg8::EpiGate<0>, pg8::StaticOrder, true, true>(F.lds + RING_OFF, g, S, E); }
    if (IN(8)) { pg8::Gemm g{CA, (const bf16*)(ws + WS_WCO), M, DM, DM, F.wave}; pg8::StaticOrder S; S.init(M, DM, F.G, (int)blockIdx.x);
        pg8::EpiGate<1> E{GC, YA, MG, escr};
        pg8::gemm_phase<pg8::EpiGate<1>, pg8::StaticOrder, true, true>(F.lds + RING_OFF, g, S, E); } SEAM(8);
    if (IN(9)) { pg8::Gemm g{MG, (const bf16*)(ws + WS_WOUT), M, DM, DM, F.wave}; pg8::StaticOrder S; S.init(M, DM, F.G, (int)blockIdx.x);
        typedef pg8::EpiDelta<NMODW, SEQ / 256, 0> EpiD; EpiD E{Y2, mod + 5 * DM, escr};
        pg8::gemm_phase<EpiD, pg8::StaticOrder, true, true>(F.lds + RING_OFF, g, S, E); } SEAM(9);
    if (IN(10)) { norm_phase<0, 1, true, true>(F, nullptr,   Y1, Y2, nullptr, nullptr,   Y2, args.in[18], mod, 6, H, nullptr); } SEAM(10);
    if (IN(11)) { STAGGER(); pg8::Gemm g{H, (const bf16*)(ws + WS_WGU2), M, 2 * FF, DM, F.wave}; pg8::StaticOrder S; S.init(M, 2 * FF, F.G, (int)blockIdx.x);
        pg8::EpiSwiGLU E{ACT, FF, escr, 0};
        pg8::gemm_phase<pg8::EpiSwiGLU, pg8::StaticOrder, true, true>(F.lds + RING_OFF, g, S, E); } SEAM(11);
    if (IN(12)) { pg8::Gemm g{ACT, (const bf16*)(ws + WS_WD2), M, DM, FF, F.wave}; pg8::StaticOrder S; S.init(M, DM, F.G, (int)blockIdx.x);
        typedef pg8::EpiDelta<NMODW, SEQ / 256, 1> EpiD; EpiD E{Y3, mod + 8 * DM, escr};
        pg8::gemm_phase<EpiD, pg8::StaticOrder, true, true>(F.lds + RING_OFF, g, S, E); } SEAM(12);
    if (IN(13)) { norm_phase<1, 1, true, false>(F, nullptr,   Y2, Y3, nullptr, nullptr, nullptr, args.in[22], nullptr, 0, nullptr, out); }
#undef IN
#undef SEAM
}

#ifndef SPLIT_LAUNCH
#define SPLIT_LAUNCH 0
#endif
#ifndef REPEAT_MASK
#define REPEAT_MASK 0
#endif
#ifndef PROBE_VARIANT
#define PROBE_VARIANT 0
#endif
extern "C" void kernel_launch(void* const* d_in, const int* in_sizes, int n_in, void* d_out, int out_size, void* d_ws, size_t ws_size, hipStream_t stream) {
    static int grid = 0;
    if (grid == 0) {
        if (n_in != 23 || in_sizes[0] != M * DM || out_size != M * DM || ws_size < WS_END + 16 * MiB) {
            fprintf(stderr, "kernel_launch: unexpected shapes n_in %d in0 %d out %d ws %zu\n", n_in, n_in > 0 ? in_sizes[0] : -1, out_size, ws_size); grid = -1; return; }
        int dev = 0, cus = 0, per_cu = 0;
        if (hipGetDevice(&dev) != hipSuccess || hipDeviceGetAttribute(&cus, hipDeviceAttributeMultiprocessorCount, dev) != hipSuccess) { fprintf(stderr, "kernel_launch: device query failed\n"); grid = -1; return; }
        if (hipFuncSetAttribute((const void*)mk_fwd, hipFuncAttributeMaxDynamicSharedMemorySize, LDS_BYTES) != hipSuccess) { fprintf(stderr, "kernel_launch: hipFuncSetAttribute failed\n"); grid = -1; return; }
        if (hipOccupancyMaxActiveBlocksPerMultiprocessor(&per_cu, (const void*)mk_fwd, NWAVES * 64, LDS_BYTES) != hipSuccess || per_cu < 1) { fprintf(stderr, "kernel_launch: occupancy query reports %d workgroups per CU\n", per_cu); }
        (void)hipGetLastError();
        grid = cus;
    }
    if (grid < 0) return;
    (void)hipMemsetAsync((unsigned char*)d_ws + WS_CTL, 0, CTL_ZERO_BYTES, stream);
    Args a{};
    for (int i = 0; i < 23; ++i) a.in[i] = (const float*)d_in[i];
    a.out = (float*)d_out; a.ws = (unsigned char*)d_ws;
    if (!SPLIT_LAUNCH) {
        a.ph_lo = 0; a.ph_hi = NPHASE; a.use_bar = 1; a.variant = 0;
        hipLaunchKernelGGL(mk_fwd, dim3(grid), dim3(NWAVES * 64), LDS_BYTES, stream, a);
        return;
    }
    for (int k = 0; k < NPHASE; ++k) {
        a.ph_lo = k; a.ph_hi = k + 1; a.use_bar = 0;
        for (int rep = 0; rep < 1 + ((REPEAT_MASK >> k) & 1); ++rep) { a.variant = (((REPEAT_MASK >> k) & 1) && rep == 0) ? PROBE_VARIANT : 0; hipLaunchKernelGGL(mk_fwd, dim3(grid), dim3(NWAVES * 64), LDS_BYTES, stream, a); }
    }
}
```

```cpp
#include <hip/hip_runtime.h>
#include <cstdio>
#include <cstdint>

typedef unsigned short bf16_t;
constexpr int BATCH = 16, SEQ = 2048, DM = 1024, M = BATCH * SEQ, FF = 2816, NIN = 5376, NMODW = 9 * DM;
constexpr float EPS = 1e-6f;

__device__ __forceinline__ float bf2f(bf16_t v) { return __uint_as_float(((unsigned)v) << 16); }
__device__ __forceinline__ bf16_t f2bf(float f) { unsigned u = __float_as_uint(f); return (bf16_t)((u + 0x7fffu + ((u >> 16) & 1u)) >> 16); }
__device__ __forceinline__ float sigm(float x) { return 1.f / (1.f + __expf(-x)); }
__device__ __forceinline__ float silu(float x) { return x / (1.f + __expf(-x)); }

constexpr size_t MiB = 1u << 20;
constexpr size_t WS_CTL = 0, WS_MOD = 1 * MiB;
constexpr size_t WS_H = 52 * MiB;
constexpr size_t WS_Y1 = 116 * MiB, WS_Y2 = 180 * MiB;
constexpr size_t WS_ACT = 244 * MiB;
constexpr size_t WS_Q = 244 * MiB;
constexpr size_t WS_K = 308 * MiB;
constexpr size_t WS_V = 316 * MiB;
constexpr size_t WS_U = 324 * MiB;
constexpr size_t WS_CA = 388 * MiB;
constexpr size_t WS_END = 452 * MiB;
constexpr size_t WS_AO = WS_H, WS_YA = WS_Q, WS_MG = WS_U;

namespace pg8 {
#define PG8_LAS __attribute__((address_space(3)))
typedef unsigned short bf16_t;
typedef short bf16x8 __attribute__((ext_vector_type(8)));
typedef float f32x4 __attribute__((ext_vector_type(4)));
typedef unsigned u32x4 __attribute__((ext_vector_type(4)));
constexpr int BM = 256, BK = 64, HALF = 128, HTB = HALF * BK * 2  , STAGE_BYTES = 8 * HTB, NXCD = 8, WGM = 8;

__host__ __device__ __forceinline__ int lds_byte(int r, int c) { const int st = (r >> 4) * 2 + (c >> 5), rr = r & 15, cc = c & 31, ob = rr * 64 + cc * 2; return st * 1024 + (ob ^ (((ob >> 9) & 1) << 5)); }
__host__ __device__ __forceinline__ void stage_rc(int b, int& R, int& C) { const int st = b / 1024, sb = b % 1024, swz = sb ^ (((sb >> 9) & 1) << 5); R = (st >> 1) * 16 + swz / 64; C = (st & 1) * 32 + (swz % 64) / 2; }
__host__ __device__ __forceinline__ int perm32(int rho) { const int n = rho >> 4, i = rho & 15; return 8 * (i >> 2) + 4 * n + (i & 3); }

__device__ __forceinline__ int lane_id() { unsigned z; asm volatile("s_mov_b32 %0, 0" : "=s"(z)); return (int)__builtin_amdgcn_mbcnt_hi(~0u, __builtin_amdgcn_mbcnt_lo(~0u, z)); }
struct Unit { int pm, pn; };
struct Gemm { const bf16_t* A; const bf16_t* Bt; int M, N, K, wave; unsigned* sink; };

struct StaticOrder {
    int nM, nN, nwg, G, c, same = 0;
    __host__ __device__ void init(int M, int N, int G_, int c_) { nM = M / BM; nN = N / BM; nwg = nM * nN; G = G_; c = c_; }
    __host__ __device__ bool next(int i, Unit& u) const {
        const long L = (long)i * G + c; if (L >= nwg) return false;
        int wgid = (int)L; { const int q = nwg / NXCD, r = nwg % NXCD, xcd = wgid % NXCD, off = wgid / NXCD; wgid = (xcd < r ? xcd * (q + 1) : r * (q + 1) + (xcd - r) * q) + off; }
        const int nig = WGM * nN, gid = wgid / nig, fm = gid * WGM, gsz = (nM - fm) < WGM ? (nM - fm) : WGM;
        u.pm = fm + ((wgid % nig) % gsz); u.pn = (wgid % nig) / gsz; if (same) { u.pm = c & 127; u.pn = 0; } return true;
    }
    __device__ __forceinline__ void a_ready(const Unit&) const {}
    __device__ __forceinline__ void done(const Unit&) const {}
};

typedef float f32x2 __attribute__((ext_vector_type(2)));
typedef __bf16 bf16x2_t __attribute__((ext_vector_type(2)));
constexpr int EPI_ROWB = 144, EPI_WAVE_BYTES = 16 * EPI_ROWB;
__device__ __forceinline__ unsigned cvt_pk_bf16(float lo, float hi) { f32x2 v = {lo, hi}; bf16x2_t b = __builtin_convertvector(v, bf16x2_t); return __builtin_bit_cast(unsigned, b); }
__device__ __forceinline__ u32x4 pack8(f32x4 a, f32x4 b) { u32x4 w; w.x = cvt_pk_bf16(a[0], a[1]); w.y = cvt_pk_bf16(a[2], a[3]); w.z = cvt_pk_bf16(b[0], b[1]); w.w = cvt_pk_bf16(b[2], b[3]); return w; }
__device__ __forceinline__ void unpack8(u32x4 w, f32x4& a, f32x4& b) {
    a[0] = __uint_as_float(w.x << 16); a[1] = __uint_as_float(w.x & 0xffff0000u); a[2] = __uint_as_float(w.y << 16); a[3] = __uint_as_float(w.y & 0xffff0000u);
    b[0] = __uint_as_float(w.z << 16); b[1] = __uint_as_float(w.z & 0xffff0000u); b[2] = __uint_as_float(w.w << 16); b[3] = __uint_as_float(w.w & 0xffff0000u); }
__device__ __forceinline__ float sigm1(float x) { return __builtin_amdgcn_rcpf(1.0f + __builtin_amdgcn_exp2f(x * -1.4426950408889634f)); }
__device__ __forceinline__ f32x4 sigm4(f32x4 x) { f32x4 r; r[0] = sigm1(x[0]); r[1] = sigm1(x[1]); r[2] = sigm1(x[2]); r[3] = sigm1(x[3]); return r; }
template <bool PERM> __device__ __forceinline__ void epi_put(PG8_LAS unsigned char* scr, int fr, int fq, f32x4 v0, f32x4 v1) {
    const int c0 = PERM ? 8 * fq : 4 * fq, c1 = PERM ? 8 * fq + 4 : 16 + 4 * fq;
    *(PG8_LAS f32x4*)(scr + fr * EPI_ROWB + c0 * 4) = v0; *(PG8_LAS f32x4*)(scr + fr * EPI_ROWB + c1 * 4) = v1; }
__device__ __forceinline__ void epi_get8(PG8_LAS unsigned char* scr, int lane, f32x4& a, f32x4& b) {
    PG8_LAS unsigned char* p = scr + (lane >> 2) * EPI_ROWB + (lane & 3) * 32; a = *(PG8_LAS f32x4*)p; b = *(PG8_LAS f32x4*)(p + 16); }
__device__ __forceinline__ f32x4 epi_get4(PG8_LAS unsigned char* scr, int lane, int pass) {
    return *(PG8_LAS f32x4*)(scr + ((lane >> 3) + 8 * pass) * EPI_ROWB + (lane & 7) * 16); }

struct EpiSwiGLU {
    static constexpr bool PERM = true, AFTER_DRAIN = false; static constexpr int NST = 8;
    bf16_t* O; int ldc; PG8_LAS unsigned char* scr; int local;
    __device__ __forceinline__ void operator()(const f32x4 (&acc)[2][2][4][2], const Unit& u, int wr, int wc, int fr, int fq) const {
        asm volatile("" : "+v"(fr), "+v"(fq));
        const int lane = fr + 16 * fq;
        bf16_t* base = O + (size_t)((local ? 0 : u.pm * BM) + wr * 64 + (lane >> 2)) * ldc + (local ? 0 : u.pn * HALF) + wc * 32 + 8 * (lane & 3);
#pragma unroll
        for (int ai = 0; ai < 2; ++ai)
#pragma unroll
            for (int m = 0; m < 4; ++m) {
                const f32x4 g0 = acc[ai][0][m][0], g1 = acc[ai][0][m][1];
#ifndef SWIGLU_LDS
                *(u32x4*)(O + (size_t)((local ? 0 : u.pm * BM) + wr * 64 + fr + ai * HALF + m * 16) * ldc + (local ? 0 : u.pn * HALF) + wc * 32 + 8 * fq) = pack8(g0 * sigm4(g0) * acc[ai][1][m][0], g1 * sigm4(g1) * acc[ai][1][m][1]);
#else
                epi_put<true>(scr, fr, fq, g0 * sigm4(g0) * acc[ai][1][m][0], g1 * sigm4(g1) * acc[ai][1][m][1]);
                f32x4 a, b; epi_get8(scr, lane, a, b);
                *(u32x4*)(base + (size_t)(ai * HALF + m * 16) * ldc) = pack8(a, b);
#endif
                }
    }
};
#ifdef EPIDELTA_DIRECT
template <int GLD, int TPB, int HALFCOEF> struct EpiDelta {
    static constexpr bool PERM = true, AFTER_DRAIN = false; static constexpr int NST = 16;
    bf16_t* Y; const float* gate; PG8_LAS unsigned char* scr;
    __device__ __forceinline__ void operator()(const f32x4 (&acc)[2][2][4][2], const Unit& u, int wr, int wc, int fr, int fq) const {
        asm volatile("" : "+v"(fr), "+v"(fq));
        const int b = u.pm / TPB, col0 = u.pn * BM + wc * 32 + 8 * fq; const float coef = HALFCOEF ? 0.5f : 1.0f;
        bf16_t* base = Y + (size_t)(u.pm * BM + wr * 64 + fr) * 1024 + col0;
        const float* gp = gate + (size_t)b * GLD + col0;
        const f32x4 g00 = *(const f32x4*)(gp) * coef, g01 = *(const f32x4*)(gp + 4) * coef, g10 = *(const f32x4*)(gp + HALF) * coef, g11 = *(const f32x4*)(gp + HALF + 4) * coef;
#pragma unroll
        for (int ai = 0; ai < 2; ++ai)
#pragma unroll
            for (int m = 0; m < 4; ++m) {
                *(u32x4*)(base + (size_t)(ai * HALF + m * 16) * 1024) = pack8(acc[ai][0][m][0] * g00, acc[ai][0][m][1] * g01);
                *(u32x4*)(base + (size_t)(ai * HALF + m * 16) * 1024 + HALF) = pack8(acc[ai][1][m][0] * g10, acc[ai][1][m][1] * g11); }
    }
};
#else
template <int GLD, int TPB, int HALFCOEF> struct EpiDelta {
    static constexpr bool PERM = true, AFTER_DRAIN = false; static constexpr int NST = 16;
    bf16_t* Y; const float* gate; PG8_LAS unsigned char* scr;
    __device__ __forceinline__ void operator()(const f32x4 (&acc)[2][2][4][2], const Unit& u, int wr, int wc, int fr, int fq) const {
        asm volatile("" : "+v"(fr), "+v"(fq));
        const int lane = fr + 16 * fq, b = u.pm / TPB, col0 = u.pn * BM + wc * 32 + 8 * (lane & 3); const float coef = HALFCOEF ? 0.5f : 1.0f;
        bf16_t* base = Y + (size_t)(u.pm * BM + wr * 64 + (lane >> 2)) * 1024 + col0;
        const float* gp = gate + (size_t)b * GLD + col0;
        const f32x4 g00 = *(const f32x4*)(gp) * coef, g01 = *(const f32x4*)(gp + 4) * coef, g10 = *(const f32x4*)(gp + HALF) * coef, g11 = *(const f32x4*)(gp + HALF + 4) * coef;
#pragma unroll
        for (int ai = 0; ai < 2; ++ai)
#pragma unroll
            for (int m = 0; m < 4; ++m) {
                { epi_put<true>(scr, fr, fq, acc[ai][0][m][0], acc[ai][0][m][1]); f32x4 a, c; epi_get8(scr, lane, a, c);
                  *(u32x4*)(base + (size_t)(ai * HALF + m * 16) * 1024) = pack8(a * g00, c * g01); }
                { epi_put<true>(scr, fr, fq, acc[ai][1][m][0], acc[ai][1][m][1]); f32x4 a, c; epi_get8(scr, lane, a, c);
                  *(u32x4*)(base + (size_t)(ai * HALF + m * 16) * 1024 + HALF) = pack8(a * g10, c * g11); } }
    }
};
#endif
#ifdef EPIIN_DIRECT
struct EpiIn {
    static constexpr bool PERM = true, AFTER_DRAIN = false; static constexpr int NST = 8;
    bf16_t *Q, *K, *V, *U, *GA, *GC; PG8_LAS unsigned char* scr;
    __device__ __forceinline__ void operator()(const f32x4 (&acc)[2][2][4][2], const Unit& u, int wr, int wc, int fr, int fq) const {
        asm volatile("" : "+v"(fr), "+v"(fq));
        const int pn = u.pn, cw = wc * 32 + 8 * fq;
        const size_t row0 = (size_t)(u.pm * BM + wr * 64 + fr);
        if (pn >= 5 && pn < 13) {
            bf16_t* base = U + row0 * 1024 + (pn - 5) * HALF + cw;
#pragma unroll
            for (int ai = 0; ai < 2; ++ai)
#pragma unroll
                for (int m = 0; m < 4; ++m)
                    *(u32x4*)(base + (size_t)(ai * HALF + m * 16) * 1024) = pack8(acc[ai][0][m][0] * sigm4(acc[ai][1][m][0]), acc[ai][0][m][1] * sigm4(acc[ai][1][m][1]));
        } else if (pn >= 13) {
            bf16_t* base = (pn < 17 ? GA + (pn - 13) * BM : GC + (pn - 17) * BM) + row0 * 1024 + cw;
#pragma unroll
            for (int ai = 0; ai < 2; ++ai)
#pragma unroll
                for (int m = 0; m < 4; ++m)
#pragma unroll
                    for (int bj = 0; bj < 2; ++bj)
                        *(u32x4*)(base + (size_t)(ai * HALF + m * 16) * 1024 + bj * HALF) = pack8(sigm4(acc[ai][bj][m][0]), sigm4(acc[ai][bj][m][1]));
        } else {
            bf16_t* b0; bf16_t* b1; int ld; float sc;
            if (pn < 4) { b0 = Q + row0 * 1024 + pn * BM + cw; b1 = b0 + HALF; ld = 1024; sc = 0.125f; } else { b0 = K + row0 * 128 + cw; b1 = V + row0 * 128 + cw; ld = 128; sc = 1.0f; }
#pragma unroll
            for (int ai = 0; ai < 2; ++ai)
#pragma unroll
                for (int m = 0; m < 4; ++m)
#pragma unroll
                    for (int bj = 0; bj < 2; ++bj)
                        *(u32x4*)((bj ? b1 : b0) + (size_t)(ai * HALF + m * 16) * ld) = pack8(acc[ai][bj][m][0] * sc, acc[ai][bj][m][1] * sc);
        }
    }
};
#else
struct EpiIn {
    static constexpr bool PERM = true, AFTER_DRAIN = false; static constexpr int NST = 8;
    bf16_t *Q, *K, *V, *U, *GA, *GC; PG8_LAS unsigned char* scr;
    __device__ __forceinline__ void operator()(const f32x4 (&acc)[2][2][4][2], const Unit& u, int wr, int wc, int fr, int fq) const {
        asm volatile("" : "+v"(fr), "+v"(fq));
        const int lane = fr + 16 * fq, pn = u.pn, cw = wc * 32 + 8 * (lane & 3);
        const size_t row0 = (size_t)(u.pm * BM + wr * 64 + (lane >> 2));
        if (pn >= 5 && pn < 13) {
            bf16_t* base = U + row0 * 1024 + (pn - 5) * HALF + cw;
#pragma unroll
            for (int ai = 0; ai < 2; ++ai)
#pragma unroll
                for (int m = 0; m < 4; ++m) {
                    epi_put<true>(scr, fr, fq, acc[ai][0][m][0] * sigm4(acc[ai][1][m][0]), acc[ai][0][m][1] * sigm4(acc[ai][1][m][1]));
                    f32x4 a, b; epi_get8(scr, lane, a, b);
                    *(u32x4*)(base + (size_t)(ai * HALF + m * 16) * 1024) = pack8(a, b); }
        } else if (pn >= 13) {
            bf16_t* base = (pn < 17 ? GA + (pn - 13) * BM : GC + (pn - 17) * BM) + row0 * 1024 + cw;
#pragma unroll
            for (int ai = 0; ai < 2; ++ai)
#pragma unroll
                for (int m = 0; m < 4; ++m)
#pragma unroll
                    for (int bj = 0; bj < 2; ++bj) {
                        epi_put<true>(scr, fr, fq, sigm4(acc[ai][bj][m][0]), sigm4(acc[ai][bj][m][1]));
                        f32x4 a, b; epi_get8(scr, lane, a, b);
                        *(u32x4*)(base + (size_t)(ai * HALF + m * 16) * 1024 + bj * HALF) = pack8(a, b); }
        } else {
            bf16_t* b0; bf16_t* b1; int ld; float sc;
            if (pn < 4) { b0 = Q + row0 * 1024 + pn * BM + cw; b1 = b0 + HALF; ld = 1024; sc = 0.125f; } else { b0 = K + row0 * 128 + cw; b1 = V + row0 * 128 + cw; ld = 128; sc = 1.0f; }
#pragma unroll
            for (int ai = 0; ai < 2; ++ai)
#pragma unroll
                for (int m = 0; m < 4; ++m)
#pragma unroll
                    for (int bj = 0; bj < 2; ++bj) {
                        epi_put<true>(scr, fr, fq, acc[ai][bj][m][0] * sc, acc[ai][bj][m][1] * sc);
                        f32x4 a, b; epi_get8(scr, lane, a, b);
                        *(u32x4*)((bj ? b1 : b0) + (size_t)(ai * HALF + m * 16) * ld) = pack8(a, b); }
        }
    }
};
#endif
template <int MODE> struct EpiGate {
    static constexpr bool PERM = true, AFTER_DRAIN = false; static constexpr int NST = 16;
    const bf16_t* G; const bf16_t* Y; bf16_t* O; PG8_LAS unsigned char* scr;
    __device__ __forceinline__ void operator()(const f32x4 (&acc)[2][2][4][2], const Unit& u, int wr, int wc, int fr, int fq) const {
        asm volatile("" : "+v"(fr), "+v"(fq));
        const int lane = fr + 16 * fq;
        const size_t off0 = (size_t)(u.pm * BM + wr * 64 + (lane >> 2)) * 1024 + u.pn * BM + wc * 32 + 8 * (lane & 3);
#pragma unroll
        for (int ai = 0; ai < 2; ++ai) {
            u32x4 gw[4][2], yw[4][2];
#pragma unroll
            for (int m = 0; m < 4; ++m)
#pragma unroll
                for (int bj = 0; bj < 2; ++bj) { const size_t off = off0 + (size_t)(ai * HALF + m * 16) * 1024 + bj * HALF; gw[m][bj] = *(const u32x4*)(G + off); if (MODE == 1) yw[m][bj] = *(const u32x4*)(Y + off); }
            asm volatile("" ::: "memory");
#pragma unroll
            for (int m = 0; m < 4; ++m)
#pragma unroll
                for (int bj = 0; bj < 2; ++bj) { const size_t off = off0 + (size_t)(ai * HALF + m * 16) * 1024 + bj * HALF;
                    epi_put<true>(scr, fr, fq, acc[ai][bj][m][0], acc[ai][bj][m][1]);
                    f32x4 a, b; epi_get8(scr, lane, a, b);
                    f32x4 g0, g1; unpack8(gw[m][bj], g0, g1);
                    f32x4 v0 = g0 * a, v1 = g1 * b;
                    if (MODE == 1) { f32x4 y0, y1; unpack8(yw[m][bj], y0, y1); v0 += y0; v1 += y1; }
                    *(u32x4*)(O + off) = pack8(v0, v1); }
            asm volatile("" ::: "memory");
        }
    }
};
template <class Epi, class Sched, bool ALIGN_EPI = false, bool SP2 = false>
__device__ __forceinline__ void gemm_phase(PG8_LAS unsigned char* lds, const Gemm g, const Sched& S, const Epi& E) {
    int tid = (g.wave << 6) | lane_id(); asm volatile("" : "+v"(tid));
    const int wid = g.wave, wr = wid >> 2, wc = wid & 3;
    int aoff, boff;
    { const int lane = tid & 63, fr = lane & 15, fq = lane >> 4; aoff = lds_byte(wr * 64 + fr, fq * 8); boff = lds_byte(wc * 32 + fr, fq * 8); }
    const int K = g.K, nt = K / BK;
    unsigned voffA[2], voffB[2];
#pragma unroll
    for (int i = 0; i < 2; ++i) { int R, C; stage_rc(tid * 16 + i * 8192, R, C); const int Rb = Epi::PERM ? ((R & ~31) + perm32(R & 31)) : R;
        voffA[i] = (unsigned)(R * K + C) * 2u; voffB[i] = (unsigned)(Rb * K + C) * 2u; }
    const size_t kstep = (size_t)(BK * 2);
    const size_t hstep = (size_t)HALF * K * 2;
    const size_t tstep = 2 * hstep;
    const unsigned ldsw = (unsigned)wid * 1024u;
#define PG8_SA(b, h) (((b) * 2 + (h)) * HTB)
#define PG8_SB(b, h) ((4 + (b) * 2 + (h)) * HTB)
#define PG8_STAGE(bufoff, gbase, voff) do { _Pragma("unroll") for (int _i = 0; _i < 2; ++_i) \
        __builtin_amdgcn_global_load_lds((const unsigned*)((const char*)(gbase) + (voff)[_i]), (PG8_LAS unsigned*)(lds + (bufoff) + ldsw + _i * 8192), 16, 0, 0); } while (0)
#define PG8_LDA(dst, b, h) do { _Pragma("unroll") for (int m = 0; m < 4; ++m) _Pragma("unroll") for (int k = 0; k < 2; ++k) dst[m][k] = *(const PG8_LAS bf16x8*)(lds + PG8_SA(b, h) + aoff + m * 2048 + k * 1024); } while (0)
#define PG8_LDB(dst, b, h) do { _Pragma("unroll") for (int n = 0; n < 2; ++n) _Pragma("unroll") for (int k = 0; k < 2; ++k) dst[n][k] = *(const PG8_LAS bf16x8*)(lds + PG8_SB(b, h) + boff + n * 2048 + k * 1024); } while (0)
#define PG8_MMA(ai, bj, At, Bt) do { __builtin_amdgcn_s_setprio(1); _Pragma("unroll") for (int m = 0; m < 4; ++m) _Pragma("unroll") for (int n = 0; n < 2; ++n) _Pragma("unroll") for (int k = 0; k < 2; ++k) \
        acc[ai][bj][m][n] = __builtin_amdgcn_mfma_f32_16x16x32_bf16(Bt[n][k], At[m][k], acc[ai][bj][m][n], 0, 0, 0); __builtin_amdgcn_s_setprio(0); } while (0)
#define PG8_WAIT_V(n) asm volatile("s_waitcnt vmcnt(" #n ")" ::: "memory")
#define PG8_WAIT_L(n) asm volatile("s_waitcnt lgkmcnt(" #n ")" ::: "memory")
#define PG8_BAR __builtin_amdgcn_s_barrier()
#define PG8_SCHED __builtin_amdgcn_sched_barrier(0)
    Unit cur, nxt; int ui = 0;
    if (!S.next(0, cur)) return;
    f32x4 acc[2][2][4][2];
#pragma unroll
    for (int a = 0; a < 2; ++a)
#pragma unroll
        for (int b = 0; b < 2; ++b)
#pragma unroll
            for (int m = 0; m < 4; ++m)
#pragma unroll
                for (int n = 0; n < 2; ++n) acc[a][b][m][n] = (f32x4){0.f, 0.f, 0.f, 0.f};
    bf16x8 At[4][2], B0[2][2], B1[2][2];
    const char* cA = (const char*)g.A + (size_t)cur.pm * tstep; const char* cB = (const char*)g.Bt + (size_t)cur.pn * tstep;
    S.a_ready(cur);
    if constexpr (SP2) {
        PG8_STAGE(PG8_SB(0, 0), cB, voffB); PG8_STAGE(PG8_SB(0, 1), cB + hstep, voffB); PG8_STAGE(PG8_SA(0, 0), cA, voffA); PG8_STAGE(PG8_SA(0, 1), cA + hstep, voffA);
        if (wr == 1) PG8_BAR;
        PG8_WAIT_V(2); PG8_BAR;
        PG8_STAGE(PG8_SB(1, 0), cB + kstep, voffB); PG8_STAGE(PG8_SA(1, 0), cA + kstep, voffA); PG8_STAGE(PG8_SB(1, 1), cB + hstep + kstep, voffB);
#ifdef UNIFIED_TRIP
        PG8_STAGE(PG8_SA(1, 1), cA + kstep + hstep, voffA);
        PG8_WAIT_V(8); PG8_BAR;
#pragma unroll
        for (int k = 0; k < Epi::NST; ++k) ((__attribute__((address_space(1))) unsigned*)g.sink)[(size_t)k * 131072 + (size_t)blockIdx.x * 512 + tid] = 0u;
#else
        PG8_WAIT_V(6); PG8_BAR;
#endif
    } else {
        PG8_STAGE(PG8_SB(0, 0), cB, voffB); PG8_STAGE(PG8_SA(0, 0), cA, voffA); PG8_STAGE(PG8_SB(0, 1), cB + hstep, voffB); PG8_STAGE(PG8_SA(0, 1), cA + hstep, voffA);
        if (wr == 1) PG8_BAR;
        PG8_WAIT_V(4); PG8_BAR;
        PG8_STAGE(PG8_SB(1, 0), cB + kstep, voffB); PG8_STAGE(PG8_SA(1, 0), cA + kstep, voffA); PG8_STAGE(PG8_SB(1, 1), cB + hstep + kstep, voffB);
        PG8_WAIT_V(6); PG8_BAR;
    }
    static_assert(SP2 && ALIGN_EPI && !Epi::AFTER_DRAIN && Epi::NST > 0, "this copy of the body keeps only the SP2 + ALIGN_EPI + store-overlap form");
#define PG8_WAIT_VI(n) asm volatile("s_waitcnt vmcnt(%0)" :: "i"(n) : "memory")
#define PG8_TRIP(STG, WV) do { asm volatile("" : "+v"(voffA[0]), "+v"(voffA[1]), "+v"(voffB[0]), "+v"(voffB[1]));     \
            PG8_LDB(B0, 0, 0); PG8_LDB(B1, 0, 1); PG8_SCHED; PG8_LDA(At, 0, 0); if (STG) { PG8_STAGE(PG8_SA(1, 1), a1 + hstep, voffA); } \
            PG8_WAIT_VI(WV); PG8_WAIT_L(0); PG8_BAR; PG8_MMA(0, 0, At, B0); PG8_MMA(0, 1, At, B1); PG8_BAR; PG8_SCHED; \
            PG8_LDA(At, 0, 1); PG8_STAGE(PG8_SB(0, 0), b2, voffB); PG8_STAGE(PG8_SB(0, 1), b2 + hstep, voffB); PG8_STAGE(PG8_SA(0, 0), a2, voffA); \
            PG8_WAIT_VI(WV); PG8_WAIT_L(0); PG8_BAR; PG8_MMA(1, 0, At, B0); PG8_MMA(1, 1, At, B1); PG8_BAR; PG8_SCHED; \
            PG8_LDB(B0, 1, 0); PG8_LDB(B1, 1, 1); PG8_SCHED; PG8_LDA(At, 1, 0); PG8_STAGE(PG8_SA(0, 1), a2 + hstep, voffA); \
            PG8_WAIT_VI(WV); PG8_WAIT_L(0); PG8_BAR; PG8_MMA(0, 0, At, B0); PG8_MMA(0, 1, At, B1); PG8_BAR; PG8_SCHED; \
            PG8_LDA(At, 1, 1); PG8_STAGE(PG8_SB(1, 0), b3, voffB); PG8_STAGE(PG8_SB(1, 1), b3 + hstep, voffB); PG8_STAGE(PG8_SA(1, 0), a3, voffA); \
            PG8_WAIT_V(8); PG8_WAIT_L(0); PG8_BAR; PG8_MMA(1, 0, At, B0); PG8_MMA(1, 1, At, B1); PG8_BAR; PG8_SCHED; } while (0)
#ifndef UNIFIED_TRIP
    {
        const char* a1 = cA + kstep; const char* a2 = cA + 2 * kstep; const char* b2 = cB + 2 * kstep; const char* a3 = a2 + kstep; const char* b3 = b2 + kstep;
        PG8_TRIP(true, 8);
    }
#endif
    for (;;) {
        const bool has_next = S.next(ui + 1, nxt);
        const char* nA = has_next ? (const char*)g.A + (size_t)nxt.pm * tstep : cA; const char* nB = has_next ? (const char*)g.Bt + (size_t)nxt.pn * tstep : cB;
#ifdef UNIFIED_TRIP
        {
            const char* a1 = cA + kstep; const char* a2 = cA + 2 * kstep; const char* b2 = cB + 2 * kstep; const char* a3 = a2 + kstep; const char* b3 = b2 + kstep; (void)a1;
            PG8_TRIP(false, 8 + Epi::NST);
        }
#endif
        for (int t = 2; t < nt; t += 2) {
            const bool last = (t == nt - 2);
            const char* a1 = cA + (size_t)(t + 1) * kstep;
            const char* a2 = last ? nA : cA + (size_t)(t + 2) * kstep; const char* b2 = last ? nB : cB + (size_t)(t + 2) * kstep;
            const char* a3 = a2 + kstep; const char* b3 = b2 + kstep;
            if (last && has_next) S.a_ready(nxt);
            PG8_TRIP(true, 8);
            if (last) { PG8_STAGE(PG8_SA(1, 1), a3 + hstep, voffA); }
        }
        if (wr == 0) PG8_BAR;
#ifdef EPI_NOSCHED
        { const int l_ = lane_id(); E(acc, cur, wr, wc, l_ & 15, l_ >> 4); }
#else
        PG8_SCHED; { const int l_ = lane_id(); E(acc, cur, wr, wc, l_ & 15, l_ >> 4); } PG8_SCHED;
#endif
        S.done(cur);
        if (!has_next) break;
#pragma unroll
        for (int a = 0; a < 2; ++a)
#pragma unroll
            for (int b = 0; b < 2; ++b)
#pragma unroll
                for (int m = 0; m < 4; ++m)
#pragma unroll
                    for (int n = 0; n < 2; ++n) acc[a][b][m][n] = (f32x4){0.f, 0.f, 0.f, 0.f};
        cur = nxt; cA = nA; cB = nB; ++ui;
        if (wr == 1) PG8_BAR;
#ifndef EPI_NOSCHED
        PG8_SCHED;
#endif
#ifndef UNIFIED_TRIP
        {
            const char* a1 = cA + kstep; const char* a2 = cA + 2 * kstep; const char* b2 = cB + 2 * kstep; const char* a3 = a2 + kstep; const char* b3 = b2 + kstep; (void)a1;
            PG8_TRIP(false, 8 + Epi::NST);
        }
#endif
    }
#undef PG8_TRIP
#undef PG8_WAIT_VI
    PG8_WAIT_V(0);
    if constexpr (!ALIGN_EPI) { if (wr == 0) PG8_BAR; }
    PG8_BAR;
#undef PG8_SA
#undef PG8_SB
#undef PG8_STAGE
#undef PG8_LDA
#undef PG8_LDB
#undef PG8_MMA
#undef PG8_WAIT_V
#undef PG8_WAIT_L
#undef PG8_BAR
#undef PG8_SCHED
}
}
#define GAS __attribute__((address_space(1)))
#define LAS __attribute__((address_space(3)))
typedef unsigned short bf16;
typedef unsigned v4u __attribute__((ext_vector_type(4)));
typedef float f32x4 __attribute__((ext_vector_type(4)));
typedef short bf16x8 __attribute__((ext_vector_type(8)));
typedef GAS unsigned gu32;
typedef GAS unsigned long long gu64;
#define RLX_AGENT __ATOMIC_RELAXED, __HIP_MEMORY_SCOPE_AGENT
#define LDS_WAIT() asm volatile("s_waitcnt lgkmcnt(0)" ::: "memory")
#define VM_WAIT() asm volatile("s_waitcnt vmcnt(0)" ::: "memory")
__device__ __forceinline__ unsigned long long rt() { return __builtin_amdgcn_s_memrealtime(); }
__device__ __forceinline__ unsigned pk2(float lo, float hi) { return (unsigned)f2bf(lo) | ((unsigned)f2bf(hi) << 16); }

#define XB_TMO      128
#define XB_XCNT(j)  (256  + 64 * (j))
#define XB_XSUB(j)  (1280 + 64 * (j))
#define XB_XGEN(j)  (2304 + 64 * (j))
#define XB_TOP      3328
#define XB_TOPGEN   3392
#define XCD_BAR_WORDS 3456
#define XB_SPIN_CAP (1u << 18)

__device__ __forceinline__ unsigned xb_ld(unsigned* p)              { return __hip_atomic_load(p, __ATOMIC_RELAXED, __HIP_MEMORY_SCOPE_AGENT); }
__device__ __forceinline__ unsigned xb_add(unsigned* p, unsigned v) { return __hip_atomic_fetch_add(p, v, __ATOMIC_RELAXED, __HIP_MEMORY_SCOPE_AGENT); }
__device__ __forceinline__ unsigned xb_xcc_id() { return (unsigned)__builtin_amdgcn_s_getreg((3 << 11) | 20) & 0xFu; }
#define XB_SPIN(cond, bar) do { unsigned _sp = 0; while (cond) { __builtin_amdgcn_s_sleep(1); \
    if ((++_sp & 255u) == 0u) { if (xb_ld(&(bar)[XB_TMO])) break; if (_sp > XB_SPIN_CAP) { atomicAdd(&(bar)[XB_TMO], 1u); break; } } } } while (0)

struct XcdBarrier {
    unsigned* bar; unsigned x; int wave;
    volatile LAS unsigned* st;
};

__device__ __forceinline__ XcdBarrier xcd_barrier_post(unsigned* bar, volatile LAS unsigned* st, int wave) {
    XcdBarrier b; b.bar = bar; b.x = xb_xcc_id(); b.st = st; b.wave = wave;
    if (wave == 0 && pg8::lane_id() == 0) (void)xb_add(&bar[XB_XCNT(b.x)], 1u);
    return b;
}
__device__ __forceinline__ void xcd_barrier_complete(unsigned* bar, unsigned x, unsigned& nloc, unsigned& nx) {
    const unsigned G = gridDim.x * gridDim.y * gridDim.z;
    unsigned sum, cnt, mine, sp = 0u;
    for (;;) {
        sum = 0u; cnt = 0u; mine = 0u;
#pragma unroll
        for (unsigned j = 0; j < 16; ++j) { const unsigned c = xb_ld(&bar[XB_XCNT(j)]); sum += c; cnt += (c > 0u) ? 1u : 0u; mine = (j == x) ? c : mine; }
        if (sum == G) break;
        __builtin_amdgcn_s_sleep(1);
        if ((++sp & 255u) == 0u) { if (xb_ld(&bar[XB_TMO])) break; if (sp > XB_SPIN_CAP) { atomicAdd(&bar[XB_TMO], 1u); break; } }
    }
    nloc = mine > 0u ? mine : 1u; nx = cnt > 0u ? cnt : 1u;
}

__device__ __forceinline__ void xcd_barrier(const XcdBarrier& b) {
    asm volatile("s_waitcnt vmcnt(0)" ::: "memory");
    __syncthreads();
    if (b.wave == 0 && pg8::lane_id() == 0) {
        unsigned* bar = b.bar;
        __builtin_amdgcn_s_waitcnt(0);
        unsigned nloc = b.st[0], nx = b.st[1];
        if (nloc == 0u) { xcd_barrier_complete(bar, b.x, nloc, nx); b.st[0] = nloc; b.st[1] = nx; }
        const unsigned old = xb_add(&bar[XB_XSUB(b.x)], 1u);
        const unsigned gen = old / nloc;
        if (old + 1u == (gen + 1u) * nloc) {
            __builtin_amdgcn_fence(__ATOMIC_RELEASE, "agent");
            asm volatile("s_waitcnt vmcnt(0)" ::: "memory");
            const unsigned og = xb_add(&bar[XB_TOP], 1u);
            const unsigned tg = og / nx;
            if (og + 1u == (tg + 1u) * nx) xb_add(&bar[XB_TOPGEN], 1u);
            else XB_SPIN(xb_ld(&bar[XB_TOPGEN]) == tg, bar);
            __builtin_amdgcn_fence(__ATOMIC_ACQUIRE, "agent");
            xb_add(&bar[XB_XGEN(b.x)], 1u);
            asm volatile("s_waitcnt vmcnt(0)" ::: "memory");
        } else {
            XB_SPIN(xb_ld(&bar[XB_XGEN(b.x)]) == gen, bar);
            __builtin_amdgcn_fence(__ATOMIC_ACQUIRE, "agent");
            asm volatile("s_waitcnt vmcnt(0)" ::: "memory");
        }
    }
    __syncthreads();
}

constexpr int NWAVES = 8;
constexpr int NPHASE = 14;
constexpr size_t WS_WGU1 = 2 * MiB, WS_WD1 = 13 * MiB, WS_WIN = 18 * MiB + 512 * 1024, WS_WAO = 29 * MiB, WS_WCO = 31 * MiB, WS_WOUT = 33 * MiB, WS_WGU2 = 35 * MiB, WS_WD2 = 46 * MiB;
static_assert(WS_WD2 + (size_t)DM * FF * 2 <= WS_H, "weight copies end before H");
constexpr size_t CTL_ZERO_BYTES = 64 * 1024;
constexpr int CW_BAR = 4096;
constexpr int RING_OFF = 0, RING_BYTES = 131072, LDSCTL_OFF = RING_BYTES, MISC_OFF = LDSCTL_OFF + 320, EPI_OFF = RING_BYTES + 512, LDS_BYTES = 151552;
static_assert(EPI_OFF + NWAVES * pg8::EPI_WAVE_BYTES <= LDS_BYTES, "LDS map");

typedef pg8::u32x4 u32x4;
typedef float f32x16 __attribute__((ext_vector_type(16)));
typedef short s16x4 __attribute__((ext_vector_type(4)));
typedef unsigned u32x2 __attribute__((ext_vector_type(2)));
typedef float f32x2v __attribute__((ext_vector_type(2)));

template <int CTRL> __device__ __forceinline__ float dpp_mov(float v) { return __builtin_bit_cast(float, __builtin_amdgcn_update_dpp(0, __builtin_bit_cast(int, v), CTRL, 0xf, 0xf, true)); }
__device__ __forceinline__ float wave_allsum(float v) {
    v += dpp_mov<0xB1>(v); v += dpp_mov<0x4E>(v); v += dpp_mov<0x124>(v); v += dpp_mov<0x128>(v);
    { auto r = __builtin_amdgcn_permlane16_swap(__float_as_uint(v), __float_as_uint(v), false, false); v = __uint_as_float(r[0]) + __uint_as_float(r[1]); }
    { auto r = __builtin_amdgcn_permlane32_swap(__float_as_uint(v), __float_as_uint(v), false, false); v = __uint_as_float(r[0]) + __uint_as_float(r[1]); }
    return v;
}
__device__ __forceinline__ float xhalf_max(float v) { auto r = __builtin_amdgcn_permlane32_swap(__float_as_uint(v), __float_as_uint(v), false, false); return fmaxf(__uint_as_float(r[0]), __uint_as_float(r[1])); }
__device__ __forceinline__ float xhalf_sum(float v) { auto r = __builtin_amdgcn_permlane32_swap(__float_as_uint(v), __float_as_uint(v), false, false); return __uint_as_float(r[0]) + __uint_as_float(r[1]); }

struct Frame {
    LAS unsigned char* lds;
    volatile LAS unsigned* MISC;
    gu32* ctl;
    int wave, vcu, G;
    __device__ __forceinline__ int lane_() const { return pg8::lane_id(); }
    __device__ __forceinline__ int tid_() const { return (wave << 6) | pg8::lane_id(); }
};
struct Args { const float* in[23]; float* out; unsigned char* ws; int ph_lo, ph_hi, use_bar, variant; };

__device__ __forceinline__ void p0_transpose_item(const float* W, int K, int N, bf16* WT, int kind, LAS float* scr, int item, int lane) {
    const int nblk = N / 32, kb = item / nblk, nb = item % nblk, k0 = 64 * kb, n0 = 32 * nb;
    int drow = n0;
    if (kind == 1 || kind == 2) drow = 256 * (n0 >> 7) + 128 * (kind - 1) + (n0 & 127);
    else if (kind == 3) { if (n0 >= 1280 && n0 < 2304) { const int r = n0 - 1280; drow = 1280 + 256 * (r >> 7) + (r & 127); } else if (n0 >= 2304 && n0 < 3328) { const int r = n0 - 2304; drow = 1280 + 256 * (r >> 7) + 128 + (r & 127); } }
#pragma unroll 8
    for (int i = 0; i < 32; ++i) { const int kk = 2 * i + (lane >> 5); scr[kk * 33 + (lane & 31)] = W[(size_t)(k0 + kk) * N + n0 + (lane & 31)]; }
    LDS_WAIT(); asm volatile("" ::: "memory");
    const int c = lane & 7;
#pragma unroll
    for (int j = 0; j < 4; ++j) { const int n = (lane >> 3) + 8 * j; const LAS float* s = scr + (8 * c) * 33 + n;
        v4u o; o.x = pk2(s[0 * 33], s[1 * 33]); o.y = pk2(s[2 * 33], s[3 * 33]); o.z = pk2(s[4 * 33], s[5 * 33]); o.w = pk2(s[6 * 33], s[7 * 33]);
        *(GAS v4u*)(WT + (size_t)(drow + n) * K + k0 + 8 * c) = o; }
    LDS_WAIT(); asm volatile("" ::: "memory");
}
__device__ __forceinline__ void p0_prologue(Frame& F, const Args& a) {
    unsigned char* ws = a.ws;
    if (F.vcu < NMODW / 64) {
        LAS float* cact = (LAS float*)(F.lds);
        LAS float* red = (LAS float*)(F.lds + 65536);
        const float* c = a.in[1];
        for (int e = F.tid_(); e < BATCH * DM; e += NWAVES * 64) { const int b = e >> 10, k = e & 1023; const float v = c[e]; cact[k * 16 + b] = v / (1.f + __expf(-v)); }
        __syncthreads();
        const int col = F.vcu * 64 + F.lane_(); const float* w = a.in[2] + col;
        float acc[16];
#pragma unroll
        for (int b = 0; b < 16; ++b) acc[b] = 0.f;
        const int kbeg = F.wave * 128;
#pragma unroll 4
        for (int k = kbeg; k < kbeg + 128; ++k) { const float wv = w[(size_t)k * NMODW];
            const LAS f32x4* cp = (const LAS f32x4*)(cact + k * 16);
#pragma unroll
            for (int q = 0; q < 4; ++q) { const f32x4 cv = cp[q]; acc[4 * q] += cv[0] * wv; acc[4 * q + 1] += cv[1] * wv; acc[4 * q + 2] += cv[2] * wv; acc[4 * q + 3] += cv[3] * wv; } }
#pragma unroll
        for (int b = 0; b < 16; ++b) red[(F.wave * 16 + b) * 64 + F.lane_()] = acc[b];
        __syncthreads();
        float* mod = (float*)(ws + WS_MOD);
        for (int e = F.tid_(); e < 16 * 64; e += NWAVES * 64) { const int b = e >> 6, cl = e & 63; float s = a.in[3][F.vcu * 64 + cl];
#pragma unroll
            for (int wv = 0; wv < 8; ++wv) s += red[(wv * 16 + b) * 64 + cl];
            mod[(size_t)b * NMODW + F.vcu * 64 + cl] = s; }
        __syncthreads();
    }
    LAS float* scr = (LAS float*)(F.lds + RING_OFF + F.wave * 16384);
    const int gw = F.vcu * NWAVES + F.wave, NGW = F.G * NWAVES;
    constexpr int I_GU = (DM / 64) * (FF / 32), I_D = (FF / 64) * (DM / 32), I_IN = (DM / 64) * (NIN / 32), I_SQ = (DM / 64) * (DM / 32);
    constexpr int NITEMS = 4 * I_GU + 2 * I_D + I_IN + 3 * I_SQ;
    for (int it = gw; it < NITEMS; it += NGW) {
        int r = it;
        if (r < I_GU) { p0_transpose_item(a.in[5], DM, FF, (bf16*)(ws + WS_WGU1), 1, scr, r, F.lane_()); continue; } r -= I_GU;
        if (r < I_GU) { p0_transpose_item(a.in[6], DM, FF, (bf16*)(ws + WS_WGU1), 2, scr, r, F.lane_()); continue; } r -= I_GU;
        if (r < I_D) { p0_transpose_item(a.in[7], FF, DM, (bf16*)(ws + WS_WD1), 0, scr, r, F.lane_()); continue; } r -= I_D;
        if (r < I_IN) { p0_transpose_item(a.in[9], DM, NIN, (bf16*)(ws + WS_WIN), 3, scr, r, F.lane_()); continue; } r -= I_IN;
        if (r < I_SQ) { p0_transpose_item(a.in[11], DM, DM, (bf16*)(ws + WS_WAO), 0, scr, r, F.lane_()); continue; } r -= I_SQ;
        if (r < I_SQ) { p0_transpose_item(a.in[16], DM, DM, (bf16*)(ws + WS_WCO), 0, scr, r, F.lane_()); continue; } r -= I_SQ;
        if (r < I_SQ) { p0_transpose_item(a.in[17], DM, DM, (bf16*)(ws + WS_WOUT), 0, scr, r, F.lane_()); continue; } r -= I_SQ;
        if (r < I_GU) { p0_transpose_item(a.in[19], DM, FF, (bf16*)(ws + WS_WGU2), 1, scr, r, F.lane_()); continue; } r -= I_GU;
        if (r < I_GU) { p0_transpose_item(a.in[20], DM, FF, (bf16*)(ws + WS_WGU2), 2, scr, r, F.lane_()); continue; } r -= I_GU;
        p0_transpose_item(a.in[21], FF, DM, (bf16*)(ws + WS_WD2), 0, scr, r, F.lane_());
    }
}

__device__ __forceinline__ void add_bf16x4(f32x4& v, u32x2 w) { v[0] += __uint_as_float(w.x << 16); v[1] += __uint_as_float(w.x & 0xffff0000u); v[2] += __uint_as_float(w.y << 16); v[3] += __uint_as_float(w.y & 0xffff0000u); }
template <int MODE, int NY, bool XBF, bool SNAP>
__device__ __forceinline__ void norm_phase(Frame& F, const float* xin, const bf16* xb, const bf16* y1, const bf16* y2, const bf16* y3, bf16* snap, const float* g, const float* mod, int shift_idx, bf16* H, float* out) {
    const int gw = F.vcu * NWAVES + F.wave, NGW = F.G * NWAVES, lane = F.lane_();
    for (int ch = gw; ch < M / 16; ch += NGW) {
        const int b = (ch * 16) / SEQ;
        f32x4 A[4], Bv[4];
#pragma unroll
        for (int j = 0; j < 4; ++j) { const int c = 4 * lane + 256 * j; A[j] = *(const f32x4*)(g + c);
            if (MODE == 0) { const float* sh = mod + (size_t)b * NMODW + shift_idx * DM + c; A[j] = A[j] * (*(const f32x4*)(sh + DM) + 1.0f); Bv[j] = *(const f32x4*)sh; } }
#pragma unroll 2
        for (int r = 0; r < 16; ++r) {
            const size_t row = (size_t)ch * 16 + r;
            f32x4 v[4]; u32x2 d0[4], d1[4], d2[4], d3[4];
#pragma unroll
            for (int j = 0; j < 4; ++j) {
                if (XBF) d0[j] = ((const GAS u32x2*)(xb + row * DM) + lane)[64 * j]; else v[j] = ((const GAS f32x4*)(xin + row * DM) + lane)[64 * j];
                if (NY >= 1) d1[j] = ((const GAS u32x2*)(y1 + row * DM) + lane)[64 * j];
                if (NY >= 2) d2[j] = ((const GAS u32x2*)(y2 + row * DM) + lane)[64 * j];
                if (NY >= 3) d3[j] = ((const GAS u32x2*)(y3 + row * DM) + lane)[64 * j]; }
            float s = 0.f;
#pragma unroll
            for (int j = 0; j < 4; ++j) { if (XBF) { v[j] = (f32x4){0.f, 0.f, 0.f, 0.f}; add_bf16x4(v[j], d0[j]); }
                if (NY >= 1) add_bf16x4(v[j], d1[j]); if (NY >= 2) add_bf16x4(v[j], d2[j]); if (NY >= 3) add_bf16x4(v[j], d3[j]);
                s += (v[j][0] * v[j][0] + v[j][1] * v[j][1]) + (v[j][2] * v[j][2] + v[j][3] * v[j][3]); }
            const float rs = rsqrtf(wave_allsum(s) * (1.f / DM) + EPS);
            if (SNAP) { GAS u32x2* o8 = (GAS u32x2*)(snap + row * DM) + lane;
#pragma unroll
                for (int j = 0; j < 4; ++j) { u32x2 w; w.x = pg8::cvt_pk_bf16(v[j][0], v[j][1]); w.y = pg8::cvt_pk_bf16(v[j][2], v[j][3]); o8[64 * j] = w; } }
            if (MODE == 0) {
                GAS u32x2* o8 = (GAS u32x2*)(H + row * DM) + lane;
#pragma unroll
                for (int j = 0; j < 4; ++j) { const f32x4 hv = v[j] * rs * A[j] + Bv[j]; u32x2 w; w.x = pg8::cvt_pk_bf16(hv[0], hv[1]); w.y = pg8::cvt_pk_bf16(hv[2], hv[3]); o8[64 * j] = w; }
            } else {
                GAS f32x4* o = (GAS f32x4*)(out + row * DM) + lane;
#pragma unroll
                for (int j = 0; j < 4; ++j) o[64 * j] = v[j] * rs * A[j];
            }
        }
    }
}

constexpr int AT_KROW = 144, AT_VT_OFF = 256 * AT_KROW, AT_VROW = 520;
__device__ __forceinline__ int crow(int r, int h) { return (r & 3) + 8 * (r >> 2) + 4 * h; }
__device__ __forceinline__ void attn_unit(Frame& F, int b, int n, int kvh, const bf16* Q, const bf16* Kb, const bf16* Vb, const float* sinks, bf16* AO) {
    LAS unsigned char* lds = F.lds;
    const int tid = F.tid_(), lane = F.lane_(), r32 = lane & 31, h = lane >> 5;
    const long band0 = (long)b * SEQ + (long)(n - 1) * 128;
    const int hq = kvh * 8 + F.wave;
    const bf16* qbase = Q + ((size_t)b * SEQ + n * 128 + r32) * 1024 + hq * 64 + 8 * h;
    bf16x8 qr[4];
#pragma unroll
    for (int ks = 0; ks < 4; ++ks) qr[ks] = *(const GAS bf16x8*)(qbase + 16 * ks);
#pragma unroll
    for (int i = 0; i < 4; ++i) {
        const int e = tid + 512 * i, sj = e >> 3, c8 = e & 7;
        u32x4 kv = {0u, 0u, 0u, 0u}, vv = {0u, 0u, 0u, 0u};
        if (n > 0 || sj >= 128) { const size_t off = (size_t)(band0 + sj) * 128 + kvh * 64 + c8 * 8; kv = *(const GAS u32x4*)(Kb + off); vv = *(const GAS u32x4*)(Vb + off); }
        *(LAS u32x4*)(lds + sj * AT_KROW + c8 * 16) = kv;
#pragma unroll
        for (int i2 = 0; i2 < 8; ++i2) *(LAS unsigned short*)(lds + AT_VT_OFF + (c8 * 8 + i2) * AT_VROW + sj * 2) = (unsigned short)(vv[i2 >> 1] >> (16 * (i2 & 1)));
    }
    __syncthreads();
    const float L2E = 1.4426950408889634f;
    const float sink = sinks[hq] * L2E;
    const float NEG = -1.0e30f;
#pragma unroll 1
    for (int j = 0; j < 4; ++j) {
        const size_t token = (size_t)b * SEQ + n * 128 + 32 * j + r32;
        bf16x8 qn[4];
        { const bf16* qp = qbase + (size_t)(j < 3 ? j + 1 : j) * 32 * 1024;
#pragma unroll
          for (int ks = 0; ks < 4; ++ks) qn[ks] = *(const GAS bf16x8*)(qp + 16 * ks); }
        f32x16 S[5];
#pragma unroll
        for (int kbi = 0; kbi < 5; ++kbi) {
            f32x16 acc = {0.f, 0.f, 0.f, 0.f, 0.f, 0.f, 0.f, 0.f, 0.f, 0.f, 0.f, 0.f, 0.f, 0.f, 0.f, 0.f};
            const LAS unsigned char* kp = lds + (32 * (j + kbi) + r32) * AT_KROW + 16 * h;
#pragma unroll
            for (int ks = 0; ks < 4; ++ks) { const bf16x8 kf = *(const LAS bf16x8*)(kp + 32 * ks); acc = __builtin_amdgcn_mfma_f32_32x32x16_bf16(kf, qr[ks], acc, 0, 0, 0); }
            S[kbi] = acc;
        }
        float mx = sink;
#pragma unroll
        for (int kbi = 0; kbi < 5; ++kbi) {
            const bool blk_ok = (n > 0) || (j + kbi >= 4);
#pragma unroll
            for (int r = 0; r < 16; ++r) {
                const int cr = crow(r, h);
                bool ok = blk_ok;
                if (kbi == 0) ok = ok && (cr > r32);
                if (kbi == 4) ok = ok && (cr <= r32);
                const float s = ok ? S[kbi][r] * L2E : NEG;
                S[kbi][r] = s; mx = fmaxf(mx, s);
            }
        }
        mx = xhalf_max(mx);
        float l = 0.f;
#pragma unroll
        for (int kbi = 0; kbi < 5; ++kbi)
#pragma unroll
            for (int r = 0; r < 16; ++r) { const float p = __builtin_amdgcn_exp2f(S[kbi][r] - mx); S[kbi][r] = p; l += p; }
        l = xhalf_sum(l) + __builtin_amdgcn_exp2f(sink - mx);
        const float inv = 1.0f / l;
        f32x16 o0 = {0.f, 0.f, 0.f, 0.f, 0.f, 0.f, 0.f, 0.f, 0.f, 0.f, 0.f, 0.f, 0.f, 0.f, 0.f, 0.f}, o1 = o0;
#pragma unroll
        for (int kbi = 0; kbi < 5; ++kbi)
#pragma unroll
            for (int s2 = 0; s2 < 2; ++s2) {
                u32x4 pw; pw.x = pg8::cvt_pk_bf16(S[kbi][8 * s2 + 0], S[kbi][8 * s2 + 1]); pw.y = pg8::cvt_pk_bf16(S[kbi][8 * s2 + 2], S[kbi][8 * s2 + 3]);
                pw.z = pg8::cvt_pk_bf16(S[kbi][8 * s2 + 4], S[kbi][8 * s2 + 5]); pw.w = pg8::cvt_pk_bf16(S[kbi][8 * s2 + 6], S[kbi][8 * s2 + 7]);
                const bf16x8 pf = __builtin_bit_cast(bf16x8, pw);
                const int key0 = 32 * (j + kbi) + 16 * s2 + 4 * h;
                const LAS unsigned char* vp = lds + AT_VT_OFF + r32 * AT_VROW + key0 * 2;
                const s16x4 a0 = *(const LAS s16x4*)(vp), a1 = *(const LAS s16x4*)(vp + 16);
                const s16x4 c0 = *(const LAS s16x4*)(vp + 32 * AT_VROW), c1 = *(const LAS s16x4*)(vp + 32 * AT_VROW + 16);
                const bf16x8 vf0 = __builtin_shufflevector(a0, a1, 0, 1, 2, 3, 4, 5, 6, 7), vf1 = __builtin_shufflevector(c0, c1, 0, 1, 2, 3, 4, 5, 6, 7);
                o0 = __builtin_amdgcn_mfma_f32_32x32x16_bf16(vf0, pf, o0, 0, 0, 0);
                o1 = __builtin_amdgcn_mfma_f32_32x32x16_bf16(vf1, pf, o1, 0, 0, 0);
            }
        bf16* orow = AO + token * 1024 + hq * 64 + 4 * h;
#pragma unroll
        for (int g4 = 0; g4 < 4; ++g4) {
            u32x2 w0, w1;
            w0.x = pg8::cvt_pk_bf16(o0[4 * g4] * inv, o0[4 * g4 + 1] * inv); w0.y = pg8::cvt_pk_bf16(o0[4 * g4 + 2] * inv, o0[4 * g4 + 3] * inv);
            w1.x = pg8::cvt_pk_bf16(o1[4 * g4] * inv, o1[4 * g4 + 1] * inv); w1.y = pg8::cvt_pk_bf16(o1[4 * g4 + 2] * inv, o1[4 * g4 + 3] * inv);
            *(GAS u32x2*)(orow + 8 * g4) = w0; *(GAS u32x2*)(orow + 32 + 8 * g4) = w1;
        }
#pragma unroll
        for (int ks = 0; ks < 4; ++ks) qr[ks] = qn[ks];
    }
    __syncthreads();
}

constexpr int CV_T = 32, CV_ROWS = CV_T + 30;
__device__ __forceinline__ void conv_phase(Frame& F, int first, int stride, int nunits, const bf16* U, const float* wdw, const float* bdw, const float* lng, const float* lnb, bf16* CA) {
    LAS unsigned char* lds = F.lds;
    const int tid = F.tid_();
    if (first >= nunits) return;
    float w0[31], w1[31];
#pragma unroll
    for (int k = 0; k < 31; ++k) { const f32x2v wv = *(const GAS f32x2v*)(wdw + k * 1024 + 2 * tid); w0[k] = wv[0]; w1[k] = wv[1]; }
    const f32x2v bv = *(const GAS f32x2v*)(bdw + 2 * tid);
    const f32x2v gv = *(const GAS f32x2v*)(lng + 2 * tid), bv2 = *(const GAS f32x2v*)(lnb + 2 * tid);
    LAS float* red = (LAS float*)(lds + CV_ROWS * 2048);
    LAS float* stat = (LAS float*)(lds + CV_ROWS * 2048 + 1024);
    u32x4 R[16];
    const int r0 = tid >> 7;
    int tbase = r0 * 2048 + (tid & 127) * 16;
#define CV_LOAD(cu_) do { const long m0_ = (long)(cu_) * CV_T; const int t0_ = (int)(m0_ % SEQ); asm volatile("" : "+v"(tbase)); \
        const unsigned char* gb_ = (const unsigned char*)U + (m0_ - 30) * 2048 + tbase; \
        _Pragma("unroll") for (int i = 0; i < 16; ++i) { R[i] = (u32x4){0u, 0u, 0u, 0u}; \
            if ((i < 15 || r0 < 2) && t0_ - 30 + r0 + 4 * i >= 0) R[i] = *(const GAS u32x4*)(gb_ + i * 8192); } } while (0)
#define CV_WRITE() do { asm volatile("" : "+v"(tbase)); _Pragma("unroll") for (int i = 0; i < 16; ++i) { if (i < 15 || r0 < 2) *(LAS u32x4*)(lds + tbase + i * 8192) = R[i]; } } while (0)
    CV_LOAD(first); CV_WRITE();
    __syncthreads();
    for (int cu = first; cu < nunits; cu += stride) {
        const long m0 = (long)cu * CV_T;
        const bool more = cu + stride < nunits;
        if (more) CV_LOAD(cu + stride);
#pragma unroll 1
        for (int gq = 0; gq < CV_T / 8; ++gq) {
            float y0[8], y1[8];
#pragma unroll
            for (int t = 0; t < 8; ++t) { y0[t] = bv[0]; y1[t] = bv[1]; }
            const LAS unsigned char* wp = lds + gq * 8 * 2048 + tid * 4;
#pragma unroll
            for (int i = 0; i < 38; ++i) {
                const unsigned uu = *(const LAS unsigned*)(wp + i * 2048);
                const float u0 = __uint_as_float(uu << 16), u1 = __uint_as_float(uu & 0xffff0000u);
#pragma unroll
                for (int t = 0; t < 8; ++t) { const int k = i - t; if (k >= 0 && k < 31) { y0[t] += w0[k] * u0; y1[t] += w1[k] * u1; } }
                if ((i & 7) == 7) asm volatile("" ::: "memory");
            }
            {
                float sv[16];
#pragma unroll
                for (int t = 0; t < 8; ++t) { sv[2 * t] = y0[t] + y1[t]; sv[2 * t + 1] = y0[t] * y0[t] + y1[t] * y1[t]; }
#pragma unroll
                for (int k = 0; k < 16; ++k) sv[k] += dpp_mov<0xB1>(sv[k]);
#pragma unroll
                for (int k = 0; k < 16; ++k) sv[k] += dpp_mov<0x4E>(sv[k]);
#pragma unroll
                for (int k = 0; k < 16; ++k) sv[k] += dpp_mov<0x124>(sv[k]);
#pragma unroll
                for (int k = 0; k < 16; ++k) sv[k] += dpp_mov<0x128>(sv[k]);
#pragma unroll
                for (int k = 0; k < 16; ++k) { auto r = __builtin_amdgcn_permlane16_swap(__float_as_uint(sv[k]), __float_as_uint(sv[k]), false, false); sv[k] = __uint_as_float(r[0]) + __uint_as_float(r[1]); }
#pragma unroll
                for (int k = 0; k < 16; ++k) { auto r = __builtin_amdgcn_permlane32_swap(__float_as_uint(sv[k]), __float_as_uint(sv[k]), false, false); sv[k] = __uint_as_float(r[0]) + __uint_as_float(r[1]); }
                if (F.lane_() == 0) {
#pragma unroll
                    for (int t = 0; t < 8; ++t) *(LAS f32x2v*)(red + (t * 8 + F.wave) * 2) = (f32x2v){sv[2 * t], sv[2 * t + 1]}; }
            }
            __syncthreads();
            if (tid < 8) { float s = 0.f, q = 0.f;
#pragma unroll
                for (int w = 0; w < 8; ++w) { s += red[(tid * 8 + w) * 2]; q += red[(tid * 8 + w) * 2 + 1]; }
                const float mean = s * (1.f / DM), var = fmaxf(q * (1.f / DM) - mean * mean, 0.f);
                stat[tid * 2] = mean; stat[tid * 2 + 1] = rsqrtf(var + EPS); }
            __syncthreads();
#pragma unroll
            for (int t = 0; t < 8; ++t) {
                const float mean = stat[t * 2], rs = stat[t * 2 + 1];
                const float a = (y0[t] - mean) * rs * gv[0] + bv2[0], c = (y1[t] - mean) * rs * gv[1] + bv2[1];
                const float sa = a * pg8::sigm1(a), sc = c * pg8::sigm1(c);
                *(GAS unsigned*)(CA + (size_t)(m0 + gq * 8 + t) * 1024 + 2 * tid) = pg8::cvt_pk_bf16(sa, sc);
            }
        }
        __syncthreads();
        if (more) { CV_WRITE(); __syncthreads(); }
    }
#undef CV_LOAD
#undef CV_WRITE
}

__global__ void __launch_bounds__(NWAVES * 64, 2) mk_fwd(Args args) {
    extern __shared__ __attribute__((aligned(16))) unsigned char lds[];
    Frame F;
    F.lds = (LAS unsigned char*)lds;
    F.MISC = (volatile LAS unsigned*)(F.lds + MISC_OFF);
    F.wave = __builtin_amdgcn_readfirstlane((int)threadIdx.x >> 6);
    F.G = gridDim.x; { const int bx = blockIdx.x; F.vcu = (F.G % 8 == 0) ? (bx % 8) * (F.G / 8) + bx / 8 : bx; }
    unsigned char* ws = args.ws;
    F.ctl = (gu32*)(ws + WS_CTL);
    for (int u = F.tid_(); u < 512 / 4; u += NWAVES * 64) ((LAS unsigned*)(F.lds + LDSCTL_OFF))[u] = 0u;
    __syncthreads();
    XcdBarrier bar; bar.bar = (unsigned*)(F.ctl + CW_BAR); bar.x = 0; bar.st = nullptr; bar.wave = F.wave;
    if (args.use_bar) bar = xcd_barrier_post((unsigned*)(F.ctl + CW_BAR), F.MISC + 8, F.wave);
    const int lo = args.ph_lo, hi = args.ph_hi;
#ifndef PHM
#define PHM 0x3FFF
#endif
#define IN(k) (((PHM >> (k)) & 1) && lo <= (k) && (k) < hi)
#define SEAM(k) do { if (IN(k) && IN((k) + 1)) xcd_barrier(bar); } while (0)

    const float* x = args.in[0]; float* out = args.out;
    LAS unsigned char* escr = F.lds + EPI_OFF + F.wave * pg8::EPI_WAVE_BYTES;
    float* mod = (float*)(ws + WS_MOD); bf16* H = (bf16*)(ws + WS_H); bf16* Y1 = (bf16*)(ws + WS_Y1); bf16* Y2 = (bf16*)(ws + WS_Y2); bf16* Y3 = H; bf16* ACT = (bf16*)(ws + WS_ACT);
    bf16* Qb = (bf16*)(ws + WS_Q); bf16* Kb = (bf16*)(ws + WS_K); bf16* Vb = (bf16*)(ws + WS_V); bf16* Ub = (bf16*)(ws + WS_U); bf16* CA = (bf16*)(ws + WS_CA);
    bf16* AO = (bf16*)(ws + WS_AO); bf16* YA = (bf16*)(ws + WS_YA); bf16* MG = (bf16*)(ws + WS_MG);
    bf16* GA = (bf16*)out; bf16* GC = GA + (size_t)M * DM;

    if (IN(0)) { p0_prologue(F, args); } SEAM(0);
    if (IN(1)) { norm_phase<0, 0, false, false>(F, x, nullptr, nullptr, nullptr, nullptr, nullptr, args.in[4], mod, 0, H, nullptr); } SEAM(1);
#ifdef EXTRA_BARS
    if (args.use_bar) for (int eb_ = 0; eb_ < EXTRA_BARS; ++eb_) xcd_barrier(bar);
#endif
#ifndef STAGGER_TICKS
#define STAGGER_TICKS 0
#endif
#define STAGGER() do { if (STAGGER_TICKS) { const unsigned long long t0_ = __builtin_amdgcn_s_memrealtime(); const unsigned long long dl_ = (unsigned long long)(F.vcu & 3) * STAGGER_TICKS; while (__builtin_amdgcn_s_memrealtime() - t0_ < dl_) __builtin_amdgcn_s_sleep(8); __syncthreads(); } } while (0)
    if (IN(2)) { STAGGER(); pg8::Gemm g{H, (const bf16*)(ws + WS_WGU1), M, 2 * FF, DM, F.wave, (unsigned*)(ws + WS_END)}; pg8::StaticOrder S; S.init(M, 2 * FF, F.G, (int)blockIdx.x); S.same = (args.variant == 3);
        pg8::EpiSwiGLU E{ACT, FF, escr, 0};
        pg8::gemm_phase<pg8::EpiSwiGLU, pg8::StaticOrder, true, true>(F.lds + RING_OFF, g, S, E); } SEAM(2);
    if (IN(3)) { pg8::Gemm g{ACT, (const bf16*)(ws + WS_WD1), M, DM, FF, F.wave, (unsigned*)(ws + WS_END)}; pg8::StaticOrder S; S.init(M, DM, F.G, (int)blockIdx.x);
        typedef pg8::EpiDelta<NMODW, SEQ / 256, 1> EpiD; EpiD E{Y1, mod + 2 * DM, escr};
        pg8::gemm_phase<EpiD, pg8::StaticOrder, true, true>(F.lds + RING_OFF, g, S, E); } SEAM(3);
    if (IN(4)) { norm_phase<0, 1, false, true>(F, x, nullptr, Y1, nullptr, nullptr,   Y1, args.in[8], mod, 3, H, nullptr); } SEAM(4);
    if (IN(5)) { STAGGER(); pg8::Gemm g{H, (const bf16*)(ws + WS_WIN), M, NIN, DM, F.wave, (unsigned*)(ws + WS_END)}; pg8::StaticOrder S; S.init(M, NIN, F.G, (int)blockIdx.x);
        pg8::EpiIn E{Qb, Kb, Vb, Ub, GA, GC, escr};
        pg8::gemm_phase<pg8::EpiIn, pg8::StaticOrder, true, true>(F.lds + RING_OFF, g, S, E); } SEAM(5);
    if (IN(6)) {
#ifndef ATTN_REP
#define ATTN_REP 1
#endif
#ifndef CONV_REP
#define CONV_REP 1
#endif
#ifndef NO_ATTN
        if (args.variant != 2) for (int uidx = F.vcu; uidx < BATCH * 16 * 2; uidx += F.G) { const int kvh = uidx & 1, n = (uidx >> 1) & 15, b = uidx >> 5; attn_unit(F, b, n, kvh, Qb, Kb, Vb, args.in[10], AO); }
#endif
#ifndef NO_CONV
        if (args.variant != 1) conv_phase(F, F.vcu, F.G, M / CV_T, Ub, args.in[12], args.in[13], args.in[14], args.in[15], CA);
#endif
    } SEAM(6);
    if (IN(7)) { pg8::Gemm g{AO, (const bf16*)(ws + WS_WAO), M, DM, DM, F.wave, (unsigned*)(ws + WS_END)}; pg8::StaticOrder S; S.init(M, DM, F.G, (int)blockIdx.x);
        pg8::EpiGate<0> E{GA, nullptr, YA, escr};
        pg8::gemm_phase<pg8::EpiGate<0>, pg8::StaticOrder, true, true>(F.lds + RING_OFF, g, S, E); }
    if (IN(8)) { pg8::Gemm g{CA, (const bf16*)(ws + WS_WCO), M, DM, DM, F.wave, (unsigned*)(ws + WS_END)}; pg8::StaticOrder S; S.init(M, DM, F.G, (int)blockIdx.x);
        pg8::EpiGate<1> E{GC, YA, MG, escr};
        pg8::gemm_phase<pg8::EpiGate<1>, pg8::StaticOrder, true, true>(F.lds + RING_OFF, g, S, E); } SEAM(8);
    if (IN(9)) { pg8::Gemm g{MG, (const bf16*)(ws + WS_WOUT), M, DM, DM, F.wave, (unsigned*)(ws + WS_END)}; pg8::StaticOrder S; S.init(M, DM, F.G, (int)blockIdx.x);
        typedef pg8::EpiDelta<NMODW, SEQ / 256, 0> EpiD; EpiD E{Y2, mod + 5 * DM, escr};
        pg8::gemm_phase<EpiD, pg8::StaticOrder, true, true>(F.lds + RING_OFF, g, S, E); } SEAM(9);
    if (IN(10)) { norm_phase<0, 1, true, true>(F, nullptr,   Y1, Y2, nullptr, nullptr,   Y2, args.in[18], mod, 6, H, nullptr); } SEAM(10);
    if (IN(11)) { STAGGER(); pg8::Gemm g{H, (const bf16*)(ws + WS_WGU2), M, 2 * FF, DM, F.wave, (unsigned*)(ws + WS_END)}; pg8::StaticOrder S; S.init(M, 2 * FF, F.G, (int)blockIdx.x);
        pg8::EpiSwiGLU E{ACT, FF, escr, 0};
        pg8::gemm_phase<pg8::EpiSwiGLU, pg8::StaticOrder, true, true>(F.lds + RING_OFF, g, S, E); } SEAM(11);
    if (IN(12)) { pg8::Gemm g{ACT, (const bf16*)(ws + WS_WD2), M, DM, FF, F.wave, (unsigned*)(ws + WS_END)}; pg8::StaticOrder S; S.init(M, DM, F.G, (int)blockIdx.x);
        typedef pg8::EpiDelta<NMODW, SEQ / 256, 1> EpiD; EpiD E{Y3, mod + 8 * DM, escr};
        pg8::gemm_phase<EpiD, pg8::StaticOrder, true, true>(F.lds + RING_OFF, g, S, E); } SEAM(12);
    if (IN(13)) { norm_phase<1, 1, true, false>(F, nullptr,   Y2, Y3, nullptr, nullptr, nullptr, args.in[22], nullptr, 0, nullptr, out); }
#undef IN
#undef SEAM
}

#ifndef SPLIT_LAUNCH
#define SPLIT_LAUNCH 0
#endif
#ifndef REPEAT_MASK
#define REPEAT_MASK 0
#endif
#ifndef PROBE_VARIANT
#define PROBE_VARIANT 0
#endif
extern "C" void kernel_launch(void* const* d_in, const int* in_sizes, int n_in, void* d_out, int out_size, void* d_ws, size_t ws_size, hipStream_t stream) {
    static int grid = 0;
    if (grid == 0) {
        if (n_in != 23 || in_sizes[0] != M * DM || out_size != M * DM || ws_size < WS_END + 16 * MiB) {
            fprintf(stderr, "kernel_launch: unexpected shapes n_in %d in0 %d out %d ws %zu\n", n_in, n_in > 0 ? in_sizes[0] : -1, out_size, ws_size); grid = -1; return; }
        int dev = 0, cus = 0, per_cu = 0;
        if (hipGetDevice(&dev) != hipSuccess || hipDeviceGetAttribute(&cus, hipDeviceAttributeMultiprocessorCount, dev) != hipSuccess) { fprintf(stderr, "kernel_launch: device query failed\n"); grid = -1; return; }
        if (hipFuncSetAttribute((const void*)mk_fwd, hipFuncAttributeMaxDynamicSharedMemorySize, LDS_BYTES) != hipSuccess) { fprintf(stderr, "kernel_launch: hipFuncSetAttribute failed\n"); grid = -1; return; }
        if (hipOccupancyMaxActiveBlocksPerMultiprocessor(&per_cu, (const void*)mk_fwd, NWAVES * 64, LDS_BYTES) != hipSuccess || per_cu < 1) { fprintf(stderr, "kernel_launch: occupancy query reports %d workgroups per CU\n", per_cu); }
        (void)hipGetLastError();
        grid = cus;
    }
    if (grid < 0) return;
    (void)hipMemsetAsync((unsigned char*)d_ws + WS_CTL, 0, CTL_ZERO_BYTES, stream);
    Args a{};
    for (int i = 0; i < 23; ++i) a.in[i] = (const float*)d_in[i];
    a.out = (float*)d_out; a.ws = (unsigned char*)d_ws;
    if (!SPLIT_LAUNCH) {
        a.ph_lo = 0; a.ph_hi = NPHASE; a.use_bar = 1; a.variant = 0;
        hipLaunchKernelGGL(mk_fwd, dim3(grid), dim3(NWAVES * 64), LDS_BYTES, stream, a);
        return;
    }
    for (int k = 0; k < NPHASE; ++k) {
        a.ph_lo = k; a.ph_hi = k + 1; a.use_bar = 0;
        for (int rep = 0; rep < 1 + ((REPEAT_MASK >> k) & 1); ++rep) { a.variant = (((REPEAT_MASK >> k) & 1) && rep == 0) ? PROBE_VARIANT : 0; hipLaunchKernelGGL(mk_fwd, dim3(grid), dim3(NWAVES * 64), LDS_BYTES, stream, a); }
    }
}
```

```cpp
#include <hip/hip_runtime.h>
#include <cstdio>
#include <cstdint>

typedef unsigned short bf16_t;
constexpr int BATCH = 16, SEQ = 2048, DM = 1024, M = BATCH * SEQ, FF = 2816, NIN = 5376, NMODW = 9 * DM;
constexpr float EPS = 1e-6f;

__device__ __forceinline__ float bf2f(bf16_t v) { return __uint_as_float(((unsigned)v) << 16); }
__device__ __forceinline__ bf16_t f2bf(float f) { unsigned u = __float_as_uint(f); return (bf16_t)((u + 0x7fffu + ((u >> 16) & 1u)) >> 16); }
__device__ __forceinline__ float sigm(float x) { return 1.f / (1.f + __expf(-x)); }
__device__ __forceinline__ float silu(float x) { return x / (1.f + __expf(-x)); }

constexpr size_t MiB = 1u << 20;
constexpr size_t WS_CTL = 0, WS_MOD = 1 * MiB;
constexpr size_t WS_H = 52 * MiB;
constexpr size_t WS_Y1 = 116 * MiB, WS_Y2 = 180 * MiB;
constexpr size_t WS_ACT = 244 * MiB;
constexpr size_t WS_Q = 244 * MiB;
constexpr size_t WS_K = 308 * MiB;
constexpr size_t WS_V = 316 * MiB;
constexpr size_t WS_U = 324 * MiB;
constexpr size_t WS_CA = 388 * MiB;
constexpr size_t WS_END = 452 * MiB;
constexpr size_t WS_AO = WS_H, WS_YA = WS_Q, WS_MG = WS_U;

namespace pg8 {
#define PG8_LAS __attribute__((address_space(3)))
typedef unsigned short bf16_t;
typedef short bf16x8 __attribute__((ext_vector_type(8)));
typedef float f32x4 __attribute__((ext_vector_type(4)));
typedef unsigned u32x4 __attribute__((ext_vector_type(4)));
constexpr int BM = 256, BK = 64, HALF = 128, HTB = HALF * BK * 2  , STAGE_BYTES = 8 * HTB, NXCD = 8, WGM = 8;

__host__ __device__ __forceinline__ int lds_byte(int r, int c) { const int st = (r >> 4) * 2 + (c >> 5), rr = r & 15, cc = c & 31, ob = rr * 64 + cc * 2; return st * 1024 + (ob ^ (((ob >> 9) & 1) << 5)); }
__host__ __device__ __forceinline__ void stage_rc(int b, int& R, int& C) { const int st = b / 1024, sb = b % 1024, swz = sb ^ (((sb >> 9) & 1) << 5); R = (st >> 1) * 16 + swz / 64; C = (st & 1) * 32 + (swz % 64) / 2; }
__host__ __device__ __forceinline__ int perm32(int rho) { const int n = rho >> 4, i = rho & 15; return 8 * (i >> 2) + 4 * n + (i & 3); }

__device__ __forceinline__ int lane_id() { unsigned z; asm volatile("s_mov_b32 %0, 0" : "=s"(z)); return (int)__builtin_amdgcn_mbcnt_hi(~0u, __builtin_amdgcn_mbcnt_lo(~0u, z)); }
struct Unit { int pm, pn; };
struct Gemm { const bf16_t* A; const bf16_t* Bt; int M, N, K, wave; };

struct StaticOrder {
    int nM, nN, nwg, G, c;
    __host__ __device__ void init(int M, int N, int G_, int c_) { nM = M / BM; nN = N / BM; nwg = nM * nN; G = G_; c = c_; }
    __host__ __device__ bool next(int i, Unit& u) const {
        const long L = (long)i * G + c; if (L >= nwg) return false;
        int wgid = (int)L; { const int q = nwg / NXCD, r = nwg % NXCD, xcd = wgid % NXCD, off = wgid / NXCD; wgid = (xcd < r ? xcd * (q + 1) : r * (q + 1) + (xcd - r) * q) + off; }
        const int nig = WGM * nN, gid = wgid / nig, fm = gid * WGM, gsz = (nM - fm) < WGM ? (nM - fm) : WGM;
        u.pm = fm + ((wgid % nig) % gsz); u.pn = (wgid % nig) / gsz; return true;
    }
    __device__ __forceinline__ void a_ready(const Unit&) const {}
    __device__ __forceinline__ void done(const Unit&) const {}
};

typedef float f32x2 __attribute__((ext_vector_type(2)));
typedef __bf16 bf16x2_t __attribute__((ext_vector_type(2)));
constexpr int EPI_ROWB = 144, EPI_WAVE_BYTES = 16 * EPI_ROWB;
__device__ __forceinline__ unsigned cvt_pk_bf16(float lo, float hi) { f32x2 v = {lo, hi}; bf16x2_t b = __builtin_convertvector(v, bf16x2_t); return __builtin_bit_cast(unsigned, b); }
__device__ __forceinline__ u32x4 pack8(f32x4 a, f32x4 b) { u32x4 w; w.x = cvt_pk_bf16(a[0], a[1]); w.y = cvt_pk_bf16(a[2], a[3]); w.z = cvt_pk_bf16(b[0], b[1]); w.w = cvt_pk_bf16(b[2], b[3]); return w; }
__device__ __forceinline__ void unpack8(u32x4 w, f32x4& a, f32x4& b) {
    a[0] = __uint_as_float(w.x << 16); a[1] = __uint_as_float(w.x & 0xffff0000u); a[2] = __uint_as_float(w.y << 16); a[3] = __uint_as_float(w.y & 0xffff0000u);
    b[0] = __uint_as_float(w.z << 16); b[1] = __uint_as_float(w.z & 0xffff0000u); b[2] = __uint_as_float(w.w << 16); b[3] = __uint_as_float(w.w & 0xffff0000u); }
__device__ __forceinline__ float sigm1(float x) { return __builtin_amdgcn_rcpf(1.0f + __builtin_amdgcn_exp2f(x * -1.4426950408889634f)); }
__device__ __forceinline__ f32x4 sigm4(f32x4 x) { f32x4 r; r[0] = sigm1(x[0]); r[1] = sigm1(x[1]); r[2] = sigm1(x[2]); r[3] = sigm1(x[3]); return r; }
template <bool PERM> __device__ __forceinline__ void epi_put(PG8_LAS unsigned char* scr, int fr, int fq, f32x4 v0, f32x4 v1) {
    const int c0 = PERM ? 8 * fq : 4 * fq, c1 = PERM ? 8 * fq + 4 : 16 + 4 * fq;
    *(PG8_LAS f32x4*)(scr + fr * EPI_ROWB + c0 * 4) = v0; *(PG8_LAS f32x4*)(scr + fr * EPI_ROWB + c1 * 4) = v1; }
__device__ __forceinline__ void epi_get8(PG8_LAS unsigned char* scr, int lane, f32x4& a, f32x4& b) {
    PG8_LAS unsigned char* p = scr + (lane >> 2) * EPI_ROWB + (lane & 3) * 32; a = *(PG8_LAS f32x4*)p; b = *(PG8_LAS f32x4*)(p + 16); }
__device__ __forceinline__ f32x4 epi_get4(PG8_LAS unsigned char* scr, int lane, int pass) {
    return *(PG8_LAS f32x4*)(scr + ((lane >> 3) + 8 * pass) * EPI_ROWB + (lane & 7) * 16); }

struct EpiSwiGLU {
    static constexpr bool PERM = true, AFTER_DRAIN = false; static constexpr int NST = 8;
    bf16_t* O; int ldc;
    __device__ __forceinline__ void operator()(const f32x4 (&acc)[2][2][4][2], const Unit& u, int wr, int wc, int fr, int fq) const {
        asm volatile("" : "+v"(fr), "+v"(fq));
        bf16_t* base = O + (size_t)(u.pm * BM + wr * 64 + fr) * ldc + u.pn * HALF + wc * 32 + 8 * fq;
#pragma unroll
        for (int ai = 0; ai < 2; ++ai)
#pragma unroll
            for (int m = 0; m < 4; ++m) {
                const f32x4 g0 = acc[ai][0][m][0], g1 = acc[ai][0][m][1];
                *(u32x4*)(base + (size_t)(ai * HALF + m * 16) * ldc) = pack8(g0 * sigm4(g0) * acc[ai][1][m][0], g1 * sigm4(g1) * acc[ai][1][m][1]); }
    }
};
template <int GLD, int TPB, int HALFCOEF> struct EpiDelta {
    static constexpr bool PERM = true, AFTER_DRAIN = false; static constexpr int NST = 16;
    bf16_t* Y; const float* gate; PG8_LAS unsigned char* scr;
    __device__ __forceinline__ void operator()(const f32x4 (&acc)[2][2][4][2], const Unit& u, int wr, int wc, int fr, int fq) const {
        asm volatile("" : "+v"(fr), "+v"(fq));
        const int lane = fr + 16 * fq, b = u.pm / TPB, col0 = u.pn * BM + wc * 32 + 8 * (lane & 3); const float coef = HALFCOEF ? 0.5f : 1.0f;
        bf16_t* base = Y + (size_t)(u.pm * BM + wr * 64 + (lane >> 2)) * 1024 + col0;
        const float* gp = gate + (size_t)b * GLD + col0;
        const f32x4 g00 = *(const f32x4*)(gp) * coef, g01 = *(const f32x4*)(gp + 4) * coef, g10 = *(const f32x4*)(gp + HALF) * coef, g11 = *(const f32x4*)(gp + HALF + 4) * coef;
#pragma unroll
        for (int ai = 0; ai < 2; ++ai)
#pragma unroll
            for (int m = 0; m < 4; ++m) {
                { epi_put<true>(scr, fr, fq, acc[ai][0][m][0], acc[ai][0][m][1]); f32x4 a, c; epi_get8(scr, lane, a, c);
                  *(u32x4*)(base + (size_t)(ai * HALF + m * 16) * 1024) = pack8(a * g00, c * g01); }
                { epi_put<true>(scr, fr, fq, acc[ai][1][m][0], acc[ai][1][m][1]); f32x4 a, c; epi_get8(scr, lane, a, c);
                  *(u32x4*)(base + (size_t)(ai * HALF + m * 16) * 1024 + HALF) = pack8(a * g10, c * g11); } }
    }
};
struct EpiIn {
    static constexpr bool PERM = true, AFTER_DRAIN = false; static constexpr int NST = 8;
    bf16_t *Q, *K, *V, *U, *GA, *GC; PG8_LAS unsigned char* scr;
    __device__ __forceinline__ void operator()(const f32x4 (&acc)[2][2][4][2], const Unit& u, int wr, int wc, int fr, int fq) const {
        asm volatile("" : "+v"(fr), "+v"(fq));
        const int lane = fr + 16 * fq, pn = u.pn, cw = wc * 32 + 8 * (lane & 3);
        const size_t row0 = (size_t)(u.pm * BM + wr * 64 + (lane >> 2));
        if (pn >= 5 && pn < 13) {
            bf16_t* base = U + row0 * 1024 + (pn - 5) * HALF + cw;
#pragma unroll
            for (int ai = 0; ai < 2; ++ai)
#pragma unroll
                for (int m = 0; m < 4; ++m) {
                    epi_put<true>(scr, fr, fq, acc[ai][0][m][0] * sigm4(acc[ai][1][m][0]), acc[ai][0][m][1] * sigm4(acc[ai][1][m][1]));
                    f32x4 a, b; epi_get8(scr, lane, a, b);
                    *(u32x4*)(base + (size_t)(ai * HALF + m * 16) * 1024) = pack8(a, b); }
        } else if (pn >= 13) {
            bf16_t* base = (pn < 17 ? GA + (pn - 13) * BM : GC + (pn - 17) * BM) + row0 * 1024 + cw;
#pragma unroll
            for (int ai = 0; ai < 2; ++ai)
#pragma unroll
                for (int m = 0; m < 4; ++m)
#pragma unroll
                    for (int bj = 0; bj < 2; ++bj) {
                        epi_put<true>(scr, fr, fq, sigm4(acc[ai][bj][m][0]), sigm4(acc[ai][bj][m][1]));
                        f32x4 a, b; epi_get8(scr, lane, a, b);
                        *(u32x4*)(base + (size_t)(ai * HALF + m * 16) * 1024 + bj * HALF) = pack8(a, b); }
        } else {
            bf16_t* b0; bf16_t* b1; int ld; float sc;
            if (pn < 4) { b0 = Q + row0 * 1024 + pn * BM + cw; b1 = b0 + HALF; ld = 1024; sc = 0.125f; } else { b0 = K + row0 * 128 + cw; b1 = V + row0 * 128 + cw; ld = 128; sc = 1.0f; }
#pragma unroll
            for (int ai = 0; ai < 2; ++ai)
#pragma unroll
                for (int m = 0; m < 4; ++m)
#pragma unroll
                    for (int bj = 0; bj < 2; ++bj) {
                        epi_put<true>(scr, fr, fq, acc[ai][bj][m][0] * sc, acc[ai][bj][m][1] * sc);
                        f32x4 a, b; epi_get8(scr, lane, a, b);
                        *(u32x4*)((bj ? b1 : b0) + (size_t)(ai * HALF + m * 16) * ld) = pack8(a, b); }
        }
    }
};
template <int MODE> struct EpiGate {
    static constexpr bool PERM = true, AFTER_DRAIN = false; static constexpr int NST = 16;
    const bf16_t* G; const bf16_t* Y; bf16_t* O; PG8_LAS unsigned char* scr;
    __device__ __forceinline__ void operator()(const f32x4 (&acc)[2][2][4][2], const Unit& u, int wr, int wc, int fr, int fq) const {
        asm volatile("" : "+v"(fr), "+v"(fq));
        const int lane = fr + 16 * fq;
        const size_t off0 = (size_t)(u.pm * BM + wr * 64 + (lane >> 2)) * 1024 + u.pn * BM + wc * 32 + 8 * (lane & 3);
#pragma unroll
        for (int ai = 0; ai < 2; ++ai) {
            u32x4 gw[4][2], yw[4][2];
#pragma unroll
            for (int m = 0; m < 4; ++m)
#pragma unroll
                for (int bj = 0; bj < 2; ++bj) { const size_t off = off0 + (size_t)(ai * HALF + m * 16) * 1024 + bj * HALF; gw[m][bj] = *(const u32x4*)(G + off); if (MODE == 1) yw[m][bj] = *(const u32x4*)(Y + off); }
            asm volatile("" ::: "memory");
#pragma unroll
            for (int m = 0; m < 4; ++m)
#pragma unroll
                for (int bj = 0; bj < 2; ++bj) { const size_t off = off0 + (size_t)(ai * HALF + m * 16) * 1024 + bj * HALF;
                    epi_put<true>(scr, fr, fq, acc[ai][bj][m][0], acc[ai][bj][m][1]);
                    f32x4 a, b; epi_get8(scr, lane, a, b);
                    f32x4 g0, g1; unpack8(gw[m][bj], g0, g1);
                    f32x4 v0 = g0 * a, v1 = g1 * b;
                    if (MODE == 1) { f32x4 y0, y1; unpack8(yw[m][bj], y0, y1); v0 += y0; v1 += y1; }
                    *(u32x4*)(O + off) = pack8(v0, v1); }
            asm volatile("" ::: "memory");
        }
    }
};
template <class Epi, class Sched, bool ALIGN_EPI = false, bool SP2 = false>
__device__ __forceinline__ void gemm_phase(PG8_LAS unsigned char* lds, const Gemm g, const Sched& S, const Epi& E) {
    int tid = (g.wave << 6) | lane_id(); asm volatile("" : "+v"(tid));
    const int wid = g.wave, wr = wid >> 2, wc = wid & 3;
    int aoff, boff;
    { const int lane = tid & 63, fr = lane & 15, fq = lane >> 4; aoff = lds_byte(wr * 64 + fr, fq * 8); boff = lds_byte(wc * 32 + fr, fq * 8); }
    const int K = g.K, nt = K / BK;
    unsigned voffA[2], voffB[2];
#pragma unroll
    for (int i = 0; i < 2; ++i) { int R, C; stage_rc(tid * 16 + i * 8192, R, C); const int Rb = Epi::PERM ? ((R & ~31) + perm32(R & 31)) : R;
        voffA[i] = (unsigned)(R * K + C) * 2u; voffB[i] = (unsigned)(Rb * K + C) * 2u; }
    const size_t kstep = (size_t)(BK * 2);
    const size_t hstep = (size_t)HALF * K * 2;
    const size_t tstep = 2 * hstep;
    const unsigned ldsw = (unsigned)wid * 1024u;
#define PG8_SA(b, h) (((b) * 2 + (h)) * HTB)
#define PG8_SB(b, h) ((4 + (b) * 2 + (h)) * HTB)
#define PG8_STAGE(bufoff, gbase, voff) do { _Pragma("unroll") for (int _i = 0; _i < 2; ++_i) \
        __builtin_amdgcn_global_load_lds((const unsigned*)((const char*)(gbase) + (voff)[_i]), (PG8_LAS unsigned*)(lds + (bufoff) + ldsw + _i * 8192), 16, 0, 0); } while (0)
#define PG8_LDA(dst, b, h) do { _Pragma("unroll") for (int m = 0; m < 4; ++m) _Pragma("unroll") for (int k = 0; k < 2; ++k) dst[m][k] = *(const PG8_LAS bf16x8*)(lds + PG8_SA(b, h) + aoff + m * 2048 + k * 1024); } while (0)
#define PG8_LDB(dst, b, h) do { _Pragma("unroll") for (int n = 0; n < 2; ++n) _Pragma("unroll") for (int k = 0; k < 2; ++k) dst[n][k] = *(const PG8_LAS bf16x8*)(lds + PG8_SB(b, h) + boff + n * 2048 + k * 1024); } while (0)
#define PG8_MMA(ai, bj, At, Bt) do { __builtin_amdgcn_s_setprio(1); _Pragma("unroll") for (int m = 0; m < 4; ++m) _Pragma("unroll") for (int n = 0; n < 2; ++n) _Pragma("unroll") for (int k = 0; k < 2; ++k) \
        acc[ai][bj][m][n] = __builtin_amdgcn_mfma_f32_16x16x32_bf16(Bt[n][k], At[m][k], acc[ai][bj][m][n], 0, 0, 0); __builtin_amdgcn_s_setprio(0); } while (0)
#define PG8_WAIT_V(n) asm volatile("s_waitcnt vmcnt(" #n ")" ::: "memory")
#define PG8_WAIT_L(n) asm volatile("s_waitcnt lgkmcnt(" #n ")" ::: "memory")
#define PG8_BAR __builtin_amdgcn_s_barrier()
#define PG8_SCHED __builtin_amdgcn_sched_barrier(0)
    Unit cur, nxt; int ui = 0;
    if (!S.next(0, cur)) return;
    f32x4 acc[2][2][4][2];
#pragma unroll
    for (int a = 0; a < 2; ++a)
#pragma unroll
        for (int b = 0; b < 2; ++b)
#pragma unroll
            for (int m = 0; m < 4; ++m)
#pragma unroll
                for (int n = 0; n < 2; ++n) acc[a][b][m][n] = (f32x4){0.f, 0.f, 0.f, 0.f};
    bf16x8 At[4][2], B0[2][2], B1[2][2];
    const char* cA = (const char*)g.A + (size_t)cur.pm * tstep; const char* cB = (const char*)g.Bt + (size_t)cur.pn * tstep;
    S.a_ready(cur);
    {
        PG8_STAGE(PG8_SB(0, 0), cB, voffB); PG8_STAGE(PG8_SB(0, 1), cB + hstep, voffB); PG8_STAGE(PG8_SA(0, 0), cA, voffA); PG8_STAGE(PG8_SA(0, 1), cA + hstep, voffA);
        if (wr == 1) PG8_BAR;
        PG8_WAIT_V(2); PG8_BAR;
        PG8_STAGE(PG8_SB(1, 0), cB + kstep, voffB); PG8_STAGE(PG8_SA(1, 0), cA + kstep, voffA); PG8_STAGE(PG8_SB(1, 1), cB + hstep + kstep, voffB);
        PG8_WAIT_V(6); PG8_BAR;
    }
    static_assert(SP2 && ALIGN_EPI && !Epi::AFTER_DRAIN && Epi::NST > 0, "this copy of the body keeps only the SP2 + ALIGN_EPI + store-overlap form");
#define PG8_WAIT_VI(n) asm volatile("s_waitcnt vmcnt(%0)" :: "i"(n) : "memory")
#define PG8_TRIP(STG, WV) do { asm volatile("" : "+v"(voffA[0]), "+v"(voffA[1]), "+v"(voffB[0]), "+v"(voffB[1]));     \
            PG8_LDB(B0, 0, 0); PG8_LDB(B1, 0, 1); PG8_SCHED; PG8_LDA(At, 0, 0); if (STG) { PG8_STAGE(PG8_SA(1, 1), a1 + hstep, voffA); } \
            PG8_WAIT_VI(WV); PG8_WAIT_L(0); PG8_BAR; PG8_MMA(0, 0, At, B0); PG8_MMA(0, 1, At, B1); PG8_BAR; PG8_SCHED; \
            PG8_LDA(At, 0, 1); PG8_STAGE(PG8_SB(0, 0), b2, voffB); PG8_STAGE(PG8_SB(0, 1), b2 + hstep, voffB); PG8_STAGE(PG8_SA(0, 0), a2, voffA); \
            PG8_WAIT_VI(WV); PG8_WAIT_L(0); PG8_BAR; PG8_MMA(1, 0, At, B0); PG8_MMA(1, 1, At, B1); PG8_BAR; PG8_SCHED; \
            PG8_LDB(B0, 1, 0); PG8_LDB(B1, 1, 1); PG8_SCHED; PG8_LDA(At, 1, 0); PG8_STAGE(PG8_SA(0, 1), a2 + hstep, voffA); \
            PG8_WAIT_VI(WV); PG8_WAIT_L(0); PG8_BAR; PG8_MMA(0, 0, At, B0); PG8_MMA(0, 1, At, B1); PG8_BAR; PG8_SCHED; \
            PG8_LDA(At, 1, 1); PG8_STAGE(PG8_SB(1, 0), b3, voffB); PG8_STAGE(PG8_SB(1, 1), b3 + hstep, voffB); PG8_STAGE(PG8_SA(1, 0), a3, voffA); \
            PG8_WAIT_V(8); PG8_WAIT_L(0); PG8_BAR; PG8_MMA(1, 0, At, B0); PG8_MMA(1, 1, At, B1); PG8_BAR; PG8_SCHED; } while (0)
    {
        const char* a1 = cA + kstep; const char* a2 = cA + 2 * kstep; const char* b2 = cB + 2 * kstep; const char* a3 = a2 + kstep; const char* b3 = b2 + kstep;
        PG8_TRIP(true, 8);
    }
    for (;;) {
        const bool has_next = S.next(ui + 1, nxt);
        const char* nA = has_next ? (const char*)g.A + (size_t)nxt.pm * tstep : cA; const char* nB = has_next ? (const char*)g.Bt + (size_t)nxt.pn * tstep : cB;
        for (int t = 2; t < nt; t += 2) {
            const bool last = (t == nt - 2);
            const char* a1 = cA + (size_t)(t + 1) * kstep;
            const char* a2 = last ? nA : cA + (size_t)(t + 2) * kstep; const char* b2 = last ? nB : cB + (size_t)(t + 2) * kstep;
            const char* a3 = a2 + kstep; const char* b3 = b2 + kstep;
            if (last && has_next) S.a_ready(nxt);
            PG8_TRIP(true, 8);
            if (last) { PG8_STAGE(PG8_SA(1, 1), a3 + hstep, voffA); }
        }
        if (wr == 0) PG8_BAR;
        PG8_SCHED; { const int l_ = lane_id(); E(acc, cur, wr, wc, l_ & 15, l_ >> 4); } PG8_SCHED;
        S.done(cur);
        if (!has_next) break;
#pragma unroll
        for (int a = 0; a < 2; ++a)
#pragma unroll
            for (int b = 0; b < 2; ++b)
#pragma unroll
                for (int m = 0; m < 4; ++m)
#pragma unroll
                    for (int n = 0; n < 2; ++n) acc[a][b][m][n] = (f32x4){0.f, 0.f, 0.f, 0.f};
        cur = nxt; cA = nA; cB = nB; ++ui;
        if (wr == 1) PG8_BAR;
        PG8_SCHED;
        {
            const char* a1 = cA + kstep; const char* a2 = cA + 2 * kstep; const char* b2 = cB + 2 * kstep; const char* a3 = a2 + kstep; const char* b3 = b2 + kstep; (void)a1;
            PG8_TRIP(false, 8 + Epi::NST);
        }
    }
#undef PG8_TRIP
#undef PG8_WAIT_VI
    PG8_WAIT_V(0);
    PG8_BAR;
#undef PG8_SA
#undef PG8_SB
#undef PG8_STAGE
#undef PG8_LDA
#undef PG8_LDB
#undef PG8_MMA
#undef PG8_WAIT_V
#undef PG8_WAIT_L
#undef PG8_BAR
#undef PG8_SCHED
}
}
#define GAS __attribute__((address_space(1)))
#define LAS __attribute__((address_space(3)))
typedef unsigned short bf16;
typedef unsigned v4u __attribute__((ext_vector_type(4)));
typedef float f32x4 __attribute__((ext_vector_type(4)));
typedef short bf16x8 __attribute__((ext_vector_type(8)));
typedef GAS unsigned gu32;
typedef GAS unsigned long long gu64;
#define RLX_AGENT __ATOMIC_RELAXED, __HIP_MEMORY_SCOPE_AGENT
#define LDS_WAIT() asm volatile("s_waitcnt lgkmcnt(0)" ::: "memory")
#define VM_WAIT() asm volatile("s_waitcnt vmcnt(0)" ::: "memory")
__device__ __forceinline__ unsigned long long rt() { return __builtin_amdgcn_s_memrealtime(); }
__device__ __forceinline__ unsigned pk2(float lo, float hi) { return (unsigned)f2bf(lo) | ((unsigned)f2bf(hi) << 16); }

#define XB_TMO      128
#define XB_XCNT(j)  (256  + 64 * (j))
#define XB_XSUB(j)  (1280 + 64 * (j))
#define XB_XGEN(j)  (2304 + 64 * (j))
#define XB_TOP      3328
#define XB_TOPGEN   3392
#define XCD_BAR_WORDS 3456
#define XB_SPIN_CAP (1u << 18)

__device__ __forceinline__ unsigned xb_ld(unsigned* p)              { return __hip_atomic_load(p, __ATOMIC_RELAXED, __HIP_MEMORY_SCOPE_AGENT); }
__device__ __forceinline__ unsigned xb_add(unsigned* p, unsigned v) { return __hip_atomic_fetch_add(p, v, __ATOMIC_RELAXED, __HIP_MEMORY_SCOPE_AGENT); }
__device__ __forceinline__ unsigned xb_xcc_id() { return (unsigned)__builtin_amdgcn_s_getreg((3 << 11) | 20) & 0xFu; }
#define XB_SPIN(cond, bar) do { unsigned _sp = 0; while (cond) { __builtin_amdgcn_s_sleep(1); \
    if ((++_sp & 255u) == 0u) { if (xb_ld(&(bar)[XB_TMO])) break; if (_sp > XB_SPIN_CAP) { atomicAdd(&(bar)[XB_TMO], 1u); break; } } } } while (0)

struct XcdBarrier {
    unsigned* bar; unsigned x; int wave;
    volatile LAS unsigned* st;
};

__device__ __forceinline__ XcdBarrier xcd_barrier_post(unsigned* bar, volatile LAS unsigned* st, int wave) {
    XcdBarrier b; b.bar = bar; b.x = xb_xcc_id(); b.st = st; b.wave = wave;
    if (wave == 0 && pg8::lane_id() == 0) st[2] = xb_add(&bar[XB_XCNT(b.x)], 1u) + 1u;
    return b;
}
__device__ __forceinline__ void xcd_barrier_complete(unsigned* bar, unsigned x, unsigned& nloc, unsigned& nx) {
    const unsigned G = gridDim.x * gridDim.y * gridDim.z;
    unsigned sum, cnt, mine, sp = 0u;
    for (;;) {
        sum = 0u; cnt = 0u; mine = 0u;
#pragma unroll
        for (unsigned j = 0; j < 16; ++j) { const unsigned c = xb_ld(&bar[XB_XCNT(j)]); sum += c; cnt += (c > 0u) ? 1u : 0u; mine = (j == x) ? c : mine; }
        if (sum == G) break;
        __builtin_amdgcn_s_sleep(1);
        if ((++sp & 255u) == 0u) { if (xb_ld(&bar[XB_TMO])) break; if (sp > XB_SPIN_CAP) { atomicAdd(&bar[XB_TMO], 1u); break; } }
    }
    nloc = mine > 0u ? mine : 1u; nx = cnt > 0u ? cnt : 1u;
}

__device__ __forceinline__ void xcd_barrier(const XcdBarrier& b) {
    asm volatile("s_waitcnt vmcnt(0)" ::: "memory");
    __syncthreads();
    if (b.wave == 0 && pg8::lane_id() == 0) {
        unsigned* bar = b.bar;
        __builtin_amdgcn_s_waitcnt(0);
        unsigned nloc = b.st[0], nx = b.st[1];
        if (nloc == 0u) { xcd_barrier_complete(bar, b.x, nloc, nx); b.st[0] = nloc; b.st[1] = nx; }
        const unsigned old = xb_add(&bar[XB_XSUB(b.x)], 1u);
        const unsigned gen = old / nloc;
        if (old + 1u == (gen + 1u) * nloc) {
            __builtin_amdgcn_fence(__ATOMIC_RELEASE, "agent");
            asm volatile("s_waitcnt vmcnt(0)" ::: "memory");
            const unsigned og = xb_add(&bar[XB_TOP], 1u);
            const unsigned tg = og / nx;
            __builtin_amdgcn_fence(__ATOMIC_ACQUIRE, "agent");
            if (og + 1u == (tg + 1u) * nx) xb_add(&bar[XB_TOPGEN], 1u);
            else XB_SPIN(xb_ld(&bar[XB_TOPGEN]) == tg, bar);
            xb_add(&bar[XB_XGEN(b.x)], 1u);
            asm volatile("s_waitcnt vmcnt(0)" ::: "memory");
        } else {
            __builtin_amdgcn_fence(__ATOMIC_ACQUIRE, "agent");
            XB_SPIN(xb_ld(&bar[XB_XGEN(b.x)]) == gen, bar);
            asm volatile("s_waitcnt vmcnt(0)" ::: "memory");
        }
    }
    __syncthreads();
}

#define XB_LSUB(j)  (3520 + 64 * (j))
#define XB_LGEN(j)  (4544 + 64 * (j))
#define XB_WORDS_END 5568
__device__ __forceinline__ void xcc_local_barrier(const XcdBarrier& b) {
    asm volatile("s_waitcnt vmcnt(0)" ::: "memory");
    __syncthreads();
    if (b.wave == 0 && pg8::lane_id() == 0) {
        unsigned* bar = b.bar;
        __builtin_amdgcn_s_waitcnt(0);
        const unsigned nloc = b.st[0];
        const unsigned old = xb_add(&bar[XB_LSUB(b.x)], 1u), gen = old / nloc;
        __builtin_amdgcn_fence(__ATOMIC_ACQUIRE, "agent");
        if (old + 1u == (gen + 1u) * nloc) xb_add(&bar[XB_LGEN(b.x)], 1u);
        else XB_SPIN(xb_ld(&bar[XB_LGEN(b.x)]) == gen, bar);
        asm volatile("s_waitcnt vmcnt(0)" ::: "memory");
    }
    __syncthreads();
}
__device__ __forceinline__ unsigned xcc_regular(unsigned* bar) {
    unsigned ok = (gridDim.x == 256u) ? 1u : 0u;
#pragma unroll
    for (unsigned j = 0; j < 16; ++j) { const unsigned c = xb_ld(&bar[XB_XCNT(j)]); ok &= (c == (j < 8u ? 32u : 0u)) ? 1u : 0u; }
    return ok;
}

constexpr int NWAVES = 8;
constexpr int NPHASE = 14;
constexpr size_t WS_WGU1 = 2 * MiB, WS_WD1 = 13 * MiB, WS_WIN = 18 * MiB + 512 * 1024, WS_WAO = 29 * MiB, WS_WCO = 31 * MiB, WS_WOUT = 33 * MiB, WS_WGU2 = 35 * MiB, WS_WD2 = 46 * MiB;
static_assert(WS_WD2 + (size_t)DM * FF * 2 <= WS_H && WS_H + 8 * 50 * MiB <= WS_END && WS_AO == WS_H && WS_YA == WS_Q && WS_MG == WS_U, "workspace map");
constexpr size_t CTL_ZERO_BYTES = 64 * 1024;
constexpr int CW_BAR = 4096;
constexpr int RING_OFF = 0, RING_BYTES = 131072, LDSCTL_OFF = RING_BYTES, MISC_OFF = LDSCTL_OFF + 320, EPI_OFF = RING_BYTES + 512, LDS_BYTES = 151552;
static_assert(EPI_OFF + NWAVES * pg8::EPI_WAVE_BYTES <= LDS_BYTES && (CW_BAR + XB_WORDS_END) * 4 <= (int)CTL_ZERO_BYTES, "LDS / control-word map");

typedef pg8::u32x4 u32x4;
typedef float f32x16 __attribute__((ext_vector_type(16)));
typedef short s16x4 __attribute__((ext_vector_type(4)));
typedef unsigned u32x2 __attribute__((ext_vector_type(2)));
typedef float f32x2v __attribute__((ext_vector_type(2)));

template <int CTRL> __device__ __forceinline__ float dpp_mov(float v) { return __builtin_bit_cast(float, __builtin_amdgcn_update_dpp(0, __builtin_bit_cast(int, v), CTRL, 0xf, 0xf, true)); }
__device__ __forceinline__ float wave_allsum(float v) {
    v += dpp_mov<0xB1>(v); v += dpp_mov<0x4E>(v); v += dpp_mov<0x124>(v); v += dpp_mov<0x128>(v);
    { auto r = __builtin_amdgcn_permlane16_swap(__float_as_uint(v), __float_as_uint(v), false, false); v = __uint_as_float(r[0]) + __uint_as_float(r[1]); }
    { auto r = __builtin_amdgcn_permlane32_swap(__float_as_uint(v), __float_as_uint(v), false, false); v = __uint_as_float(r[0]) + __uint_as_float(r[1]); }
    return v;
}
__device__ __forceinline__ float xhalf_max(float v) { auto r = __builtin_amdgcn_permlane32_swap(__float_as_uint(v), __float_as_uint(v), false, false); return fmaxf(__uint_as_float(r[0]), __uint_as_float(r[1])); }
__device__ __forceinline__ float xhalf_sum(float v) { auto r = __builtin_amdgcn_permlane32_swap(__float_as_uint(v), __float_as_uint(v), false, false); return __uint_as_float(r[0]) + __uint_as_float(r[1]); }

struct Frame {
    LAS unsigned char* lds;
    volatile LAS unsigned* MISC;
    gu32* ctl;
    int wave, vcu, G;
    __device__ __forceinline__ int lane_() const { return pg8::lane_id(); }
    __device__ __forceinline__ int tid_() const { return (wave << 6) | pg8::lane_id(); }
};
struct Args { const float* in[23]; float* out; unsigned char* ws; int ph_lo, ph_hi, use_bar, pad; };

__device__ __forceinline__ void p0_transpose_item(const float* W, int K, int N, bf16* WT, int kind, LAS float* scr, int item, int lane) {
    const int nblk = N / 32, kb = item / nblk, nb = item % nblk, k0 = 64 * kb, n0 = 32 * nb;
    int drow = n0;
    if (kind == 1 || kind == 2) drow = 256 * (n0 >> 7) + 128 * (kind - 1) + (n0 & 127);
    else if (kind == 3) { if (n0 >= 1280 && n0 < 2304) { const int r = n0 - 1280; drow = 1280 + 256 * (r >> 7) + (r & 127); } else if (n0 >= 2304 && n0 < 3328) { const int r = n0 - 2304; drow = 1280 + 256 * (r >> 7) + 128 + (r & 127); } }
    float v[32];
#pragma unroll
    for (int i = 0; i < 32; ++i) v[i] = W[(size_t)(k0 + 2 * i + (lane >> 5)) * N + n0 + (lane & 31)];
#pragma unroll
    for (int i = 0; i < 32; ++i) scr[(2 * i + (lane >> 5)) * 33 + (lane & 31)] = v[i];
    LDS_WAIT(); asm volatile("" ::: "memory");
    const int c = lane & 7;
#pragma unroll
    for (int j = 0; j < 4; ++j) { const int n = (lane >> 3) + 8 * j; const LAS float* s = scr + (8 * c) * 33 + n;
        v4u o; o.x = pk2(s[0 * 33], s[1 * 33]); o.y = pk2(s[2 * 33], s[3 * 33]); o.z = pk2(s[4 * 33], s[5 * 33]); o.w = pk2(s[6 * 33], s[7 * 33]);
        *(GAS v4u*)(WT + (size_t)(drow + n) * K + k0 + 8 * c) = o; }
    LDS_WAIT(); asm volatile("" ::: "memory");
}
__device__ __forceinline__ void p0_prologue(Frame& F, const Args& a) {
    unsigned char* ws = a.ws;
    if (F.vcu < NMODW / 64) {
        LAS float* cact = (LAS float*)(F.lds);
        LAS float* red = (LAS float*)(F.lds + 65536);
        const float* c = a.in[1];
        for (int e = F.tid_(); e < BATCH * DM; e += NWAVES * 64) { const int b = e >> 10, k = e & 1023; const float v = c[e]; cact[k * 16 + b] = v / (1.f + __expf(-v)); }
        __syncthreads();
        const int col = F.vcu * 64 + F.lane_(); const float* w = a.in[2] + col;
        float acc[16];
#pragma unroll
        for (int b = 0; b < 16; ++b) acc[b] = 0.f;
        const int kbeg = F.wave * 128;
#pragma unroll 1
        for (int k = kbeg; k < kbeg + 128; k += 32) {
            float wv[32];
#pragma unroll
            for (int j = 0; j < 32; ++j) wv[j] = w[(size_t)(k + j) * NMODW];
#pragma unroll
            for (int j = 0; j < 32; ++j) { const LAS f32x4* cp = (const LAS f32x4*)(cact + (k + j) * 16);
#pragma unroll
                for (int q = 0; q < 4; ++q) { const f32x4 cv = cp[q]; acc[4 * q] += cv[0] * wv[j]; acc[4 * q + 1] += cv[1] * wv[j]; acc[4 * q + 2] += cv[2] * wv[j]; acc[4 * q + 3] += cv[3] * wv[j]; } } }
#pragma unroll
        for (int b = 0; b < 16; ++b) red[(F.wave * 16 + b) * 64 + F.lane_()] = acc[b];
        __syncthreads();
        float* mod = (float*)(ws + WS_MOD);
        for (int e = F.tid_(); e < 16 * 64; e += NWAVES * 64) { const int b = e >> 6, cl = e & 63; float s = a.in[3][F.vcu * 64 + cl];
#pragma unroll
            for (int wv = 0; wv < 8; ++wv) s += red[(wv * 16 + b) * 64 + cl];
            mod[(size_t)b * NMODW + F.vcu * 64 + cl] = s; }
        __syncthreads();
    }
    LAS float* scr = (LAS float*)(F.lds + RING_OFF + F.wave * 16384);
    const int gw = F.vcu * NWAVES + F.wave, NGW = F.G * NWAVES;
    constexpr int I_GU = (DM / 64) * (FF / 32), I_D = (FF / 64) * (DM / 32), I_IN = (DM / 64) * (NIN / 32), I_SQ = (DM / 64) * (DM / 32);
    constexpr int NITEMS = 4 * I_GU + 2 * I_D + I_IN + 3 * I_SQ;
    static_assert(NITEMS == (256 - NMODW / 64) * NWAVES * 9 + (NMODW / 64) * NWAVES * 4, "item split");
    const bool split = (F.G == 256), late = F.vcu < NMODW / 64;
    const int n_early = (256 - NMODW / 64) * NWAVES, n_late = (NMODW / 64) * NWAVES;
    const int it0 = !split ? gw : (late ? n_early * 9 + gw : gw - n_late), its = !split ? NGW : (late ? n_late : n_early), itend = !split ? NITEMS : (late ? NITEMS : n_early * 9);
    for (int it = it0; it < itend; it += its) {
        int r = it;
        if (r < I_GU) { p0_transpose_item(a.in[5], DM, FF, (bf16*)(ws + WS_WGU1), 1, scr, r, F.lane_()); continue; } r -= I_GU;
        if (r < I_GU) { p0_transpose_item(a.in[6], DM, FF, (bf16*)(ws + WS_WGU1), 2, scr, r, F.lane_()); continue; } r -= I_GU;
        if (r < I_D) { p0_transpose_item(a.in[7], FF, DM, (bf16*)(ws + WS_WD1), 0, scr, r, F.lane_()); continue; } r -= I_D;
        if (r < I_IN) { p0_transpose_item(a.in[9], DM, NIN, (bf16*)(ws + WS_WIN), 3, scr, r, F.lane_()); continue; } r -= I_IN;
        if (r < I_SQ) { p0_transpose_item(a.in[11], DM, DM, (bf16*)(ws + WS_WAO), 0, scr, r, F.lane_()); continue; } r -= I_SQ;
        if (r < I_SQ) { p0_transpose_item(a.in[16], DM, DM, (bf16*)(ws + WS_WCO), 0, scr, r, F.lane_()); continue; } r -= I_SQ;
        if (r < I_SQ) { p0_transpose_item(a.in[17], DM, DM, (bf16*)(ws + WS_WOUT), 0, scr, r, F.lane_()); continue; } r -= I_SQ;
        if (r < I_GU) { p0_transpose_item(a.in[19], DM, FF, (bf16*)(ws + WS_WGU2), 1, scr, r, F.lane_()); continue; } r -= I_GU;
        if (r < I_GU) { p0_transpose_item(a.in[20], DM, FF, (bf16*)(ws + WS_WGU2), 2, scr, r, F.lane_()); continue; } r -= I_GU;
        p0_transpose_item(a.in[21], FF, DM, (bf16*)(ws + WS_WD2), 0, scr, r, F.lane_());
    }
}

__device__ __forceinline__ void add_bf16x4(f32x4& v, u32x2 w) { v[0] += __uint_as_float(w.x << 16); v[1] += __uint_as_float(w.x & 0xffff0000u); v[2] += __uint_as_float(w.y << 16); v[3] += __uint_as_float(w.y & 0xffff0000u); }
template <int MODE, int NY, bool XBF, bool SNAP>
__device__ __forceinline__ void norm_phase(Frame& F, const float* xin, const bf16* xb, const bf16* y1, const bf16* y2, const bf16* y3, bf16* snap, const float* g, const float* mod, int shift_idx, bf16* H, float* out) {
    const int gw = F.vcu * NWAVES + F.wave, NGW = F.G * NWAVES, lane = F.lane_();
    for (int ch = gw; ch < M / 16; ch += NGW) {
        const int b = (ch * 16) / SEQ;
        f32x4 A[4], Bv[4];
#pragma unroll
        for (int j = 0; j < 4; ++j) { const int c = 4 * lane + 256 * j; A[j] = *(const f32x4*)(g + c);
            if (MODE == 0) { const float* sh = mod + (size_t)b * NMODW + shift_idx * DM + c; A[j] = A[j] * (*(const f32x4*)(sh + DM) + 1.0f); Bv[j] = *(const f32x4*)sh; } }
#pragma unroll 2
        for (int r = 0; r < 16; ++r) {
            const size_t row = (size_t)ch * 16 + r;
            f32x4 v[4]; u32x2 d0[4], d1[4], d2[4], d3[4];
#pragma unroll
            for (int j = 0; j < 4; ++j) {
                if (XBF) d0[j] = ((const GAS u32x2*)(xb + row * DM) + lane)[64 * j]; else v[j] = ((const GAS f32x4*)(xin + row * DM) + lane)[64 * j];
                if (NY >= 1) d1[j] = ((const GAS u32x2*)(y1 + row * DM) + lane)[64 * j];
                if (NY >= 2) d2[j] = ((const GAS u32x2*)(y2 + row * DM) + lane)[64 * j];
                if (NY >= 3) d3[j] = ((const GAS u32x2*)(y3 + row * DM) + lane)[64 * j]; }
            float s = 0.f;
#pragma unroll
            for (int j = 0; j < 4; ++j) { if (XBF) { v[j] = (f32x4){0.f, 0.f, 0.f, 0.f}; add_bf16x4(v[j], d0[j]); }
                if (NY >= 1) add_bf16x4(v[j], d1[j]); if (NY >= 2) add_bf16x4(v[j], d2[j]); if (NY >= 3) add_bf16x4(v[j], d3[j]);
                s += (v[j][0] * v[j][0] + v[j][1] * v[j][1]) + (v[j][2] * v[j][2] + v[j][3] * v[j][3]); }
            const float rs = rsqrtf(wave_allsum(s) * (1.f / DM) + EPS);
            if (SNAP) { GAS u32x2* o8 = (GAS u32x2*)(snap + row * DM) + lane;
#pragma unroll
                for (int j = 0; j < 4; ++j) { u32x2 w; w.x = pg8::cvt_pk_bf16(v[j][0], v[j][1]); w.y = pg8::cvt_pk_bf16(v[j][2], v[j][3]); o8[64 * j] = w; } }
            if (MODE == 0) {
                GAS u32x2* o8 = (GAS u32x2*)(H + row * DM) + lane;
#pragma unroll
                for (int j = 0; j < 4; ++j) { const f32x4 hv = v[j] * rs * A[j] + Bv[j]; u32x2 w; w.x = pg8::cvt_pk_bf16(hv[0], hv[1]); w.y = pg8::cvt_pk_bf16(hv[2], hv[3]); o8[64 * j] = w; }
            } else {
                GAS f32x4* o = (GAS f32x4*)(out + row * DM) + lane;
#pragma unroll
                for (int j = 0; j < 4; ++j) o[64 * j] = v[j] * rs * A[j];
            }
        }
    }
}

constexpr int AT_KROW = 144, AT_VT_OFF = 256 * AT_KROW, AT_VROW = 520;
__device__ __forceinline__ int crow(int r, int h) { return (r & 3) + 8 * (r >> 2) + 4 * h; }
__device__ __forceinline__ void attn_unit(Frame& F, int b, int n, int kvh, const bf16* Q, const bf16* Kb, const bf16* Vb, const float* sinks, bf16* AO) {
    LAS unsigned char* lds = F.lds;
    const int tid = F.tid_(), lane = F.lane_(), r32 = lane & 31, h = lane >> 5;
    const long band0 = (long)b * SEQ + (long)(n - 1) * 128;
    const int hq = kvh * 8 + F.wave;
    const bf16* qbase = Q + ((size_t)b * SEQ + n * 128 + r32) * 1024 + hq * 64 + 8 * h;
    bf16x8 qr[4];
#pragma unroll
    for (int ks = 0; ks < 4; ++ks) qr[ks] = *(const GAS bf16x8*)(qbase + 16 * ks);
#pragma unroll
    for (int i = 0; i < 4; ++i) {
        const int e = tid + 512 * i, sj = e >> 3, c8 = e & 7;
        u32x4 kv = {0u, 0u, 0u, 0u}, vv = {0u, 0u, 0u, 0u};
        if (n > 0 || sj >= 128) { const size_t off = (size_t)(band0 + sj) * 128 + kvh * 64 + c8 * 8; kv = *(const GAS u32x4*)(Kb + off); vv = *(const GAS u32x4*)(Vb + off); }
        *(LAS u32x4*)(lds + sj * AT_KROW + c8 * 16) = kv;
#pragma unroll
        for (int i2 = 0; i2 < 8; ++i2) *(LAS unsigned short*)(lds + AT_VT_OFF + (c8 * 8 + i2) * AT_VROW + sj * 2) = (unsigned short)(vv[i2 >> 1] >> (16 * (i2 & 1)));
    }
    __syncthreads();
    const float L2E = 1.4426950408889634f;
    const float sink = sinks[hq] * L2E;
    const float NEG = -1.0e30f;
#pragma unroll 1
    for (int j = 0; j < 4; ++j) {
        const size_t token = (size_t)b * SEQ + n * 128 + 32 * j + r32;
        bf16x8 qn[4];
        { const bf16* qp = qbase + (size_t)(j < 3 ? j + 1 : j) * 32 * 1024;
#pragma unroll
          for (int ks = 0; ks < 4; ++ks) qn[ks] = *(const GAS bf16x8*)(qp + 16 * ks); }
        f32x16 S[5];
#pragma unroll
        for (int kbi = 0; kbi < 5; ++kbi) {
            f32x16 acc = {0.f, 0.f, 0.f, 0.f, 0.f, 0.f, 0.f, 0.f, 0.f, 0.f, 0.f, 0.f, 0.f, 0.f, 0.f, 0.f};
            const LAS unsigned char* kp = lds + (32 * (j + kbi) + r32) * AT_KROW + 16 * h;
#pragma unroll
            for (int ks = 0; ks < 4; ++ks) { const bf16x8 kf = *(const LAS bf16x8*)(kp + 32 * ks); acc = __builtin_amdgcn_mfma_f32_32x32x16_bf16(kf, qr[ks], acc, 0, 0, 0); }
            S[kbi] = acc;
        }
        float mx = sink;
#pragma unroll
        for (int kbi = 0; kbi < 5; ++kbi) {
            const bool blk_ok = (n > 0) || (j + kbi >= 4);
#pragma unroll
            for (int r = 0; r < 16; ++r) {
                const int cr = crow(r, h);
                bool ok = blk_ok;
                if (kbi == 0) ok = ok && (cr > r32);
                if (kbi == 4) ok = ok && (cr <= r32);
                const float s = ok ? S[kbi][r] * L2E : NEG;
                S[kbi][r] = s; mx = fmaxf(mx, s);
            }
        }
        mx = xhalf_max(mx);
        float l = 0.f;
#pragma unroll
        for (int kbi = 0; kbi < 5; ++kbi)
#pragma unroll
            for (int r = 0; r < 16; ++r) { const float p = __builtin_amdgcn_exp2f(S[kbi][r] - mx); S[kbi][r] = p; l += p; }
        l = xhalf_sum(l) + __builtin_amdgcn_exp2f(sink - mx);
        const float inv = 1.0f / l;
        f32x16 o0 = {0.f, 0.f, 0.f, 0.f, 0.f, 0.f, 0.f, 0.f, 0.f, 0.f, 0.f, 0.f, 0.f, 0.f, 0.f, 0.f}, o1 = o0;
#pragma unroll
        for (int kbi = 0; kbi < 5; ++kbi)
#pragma unroll
            for (int s2 = 0; s2 < 2; ++s2) {
                u32x4 pw; pw.x = pg8::cvt_pk_bf16(S[kbi][8 * s2 + 0], S[kbi][8 * s2 + 1]); pw.y = pg8::cvt_pk_bf16(S[kbi][8 * s2 + 2], S[kbi][8 * s2 + 3]);
                pw.z = pg8::cvt_pk_bf16(S[kbi][8 * s2 + 4], S[kbi][8 * s2 + 5]); pw.w = pg8::cvt_pk_bf16(S[kbi][8 * s2 + 6], S[kbi][8 * s2 + 7]);
                const bf16x8 pf = __builtin_bit_cast(bf16x8, pw);
                const int key0 = 32 * (j + kbi) + 16 * s2 + 4 * h;
                const LAS unsigned char* vp = lds + AT_VT_OFF + r32 * AT_VROW + key0 * 2;
                const s16x4 a0 = *(const LAS s16x4*)(vp), a1 = *(const LAS s16x4*)(vp + 16);
                const s16x4 c0 = *(const LAS s16x4*)(vp + 32 * AT_VROW), c1 = *(const LAS s16x4*)(vp + 32 * AT_VROW + 16);
                const bf16x8 vf0 = __builtin_shufflevector(a0, a1, 0, 1, 2, 3, 4, 5, 6, 7), vf1 = __builtin_shufflevector(c0, c1, 0, 1, 2, 3, 4, 5, 6, 7);
                o0 = __builtin_amdgcn_mfma_f32_32x32x16_bf16(vf0, pf, o0, 0, 0, 0);
                o1 = __builtin_amdgcn_mfma_f32_32x32x16_bf16(vf1, pf, o1, 0, 0, 0);
            }
        bf16* orow = AO + token * 1024 + hq * 64 + 4 * h;
#pragma unroll
        for (int g4 = 0; g4 < 4; ++g4) {
            u32x2 w0, w1;
            w0.x = pg8::cvt_pk_bf16(o0[4 * g4] * inv, o0[4 * g4 + 1] * inv); w0.y = pg8::cvt_pk_bf16(o0[4 * g4 + 2] * inv, o0[4 * g4 + 3] * inv);
            w1.x = pg8::cvt_pk_bf16(o1[4 * g4] * inv, o1[4 * g4 + 1] * inv); w1.y = pg8::cvt_pk_bf16(o1[4 * g4 + 2] * inv, o1[4 * g4 + 3] * inv);
            *(GAS u32x2*)(orow + 8 * g4) = w0; *(GAS u32x2*)(orow + 32 + 8 * g4) = w1;
        }
#pragma unroll
        for (int ks = 0; ks < 4; ++ks) qr[ks] = qn[ks];
    }
    __syncthreads();
}

#ifndef CVG_TOK
#define CVG_TOK 8
#endif
constexpr int CV_T = 32, CV_ROWS = CV_T + 30, CVG = CVG_TOK;
__device__ __forceinline__ void conv_phase(Frame& F, int first, int stride, int nunits, const bf16* U, const float* wdw, const float* bdw, const float* lng, const float* lnb, bf16* CA) {
    LAS unsigned char* lds = F.lds;
    const int tid = F.tid_();
    if (first >= nunits) return;
    float w0[31], w1[31];
#pragma unroll
    for (int k = 0; k < 31; ++k) { const f32x2v wv = *(const GAS f32x2v*)(wdw + k * 1024 + 2 * tid); w0[k] = wv[0]; w1[k] = wv[1]; }
    const f32x2v bv = *(const GAS f32x2v*)(bdw + 2 * tid);
    const f32x2v gv = *(const GAS f32x2v*)(lng + 2 * tid), bv2 = *(const GAS f32x2v*)(lnb + 2 * tid);
    LAS float* red = (LAS float*)(lds + CV_ROWS * 2048);
    LAS float* stat = (LAS float*)(lds + CV_ROWS * 2048 + 2048);
    u32x4 R[16];
    const int r0 = tid >> 7;
    int tbase = r0 * 2048 + (tid & 127) * 16;
#define CV_LOAD(cu_) do { const long m0_ = (long)(cu_) * CV_T; const int t0_ = (int)(m0_ % SEQ); asm volatile("" : "+v"(tbase)); \
        const unsigned char* gb_ = (const unsigned char*)U + (m0_ - 30) * 2048 + tbase; \
        _Pragma("unroll") for (int i = 0; i < 16; ++i) { R[i] = (u32x4){0u, 0u, 0u, 0u}; \
            if ((i < 15 || r0 < 2) && t0_ - 30 + r0 + 4 * i >= 0) R[i] = *(const GAS u32x4*)(gb_ + i * 8192); } } while (0)
#define CV_WRITE() do { asm volatile("" : "+v"(tbase)); _Pragma("unroll") for (int i = 0; i < 16; ++i) { if (i < 15 || r0 < 2) *(LAS u32x4*)(lds + tbase + i * 8192) = R[i]; } } while (0)
    CV_LOAD(first); CV_WRITE();
    __syncthreads();
    for (int cu = first; cu < nunits; cu += stride) {
        const long m0 = (long)cu * CV_T;
        const bool more = cu + stride < nunits;
        if (more) CV_LOAD(cu + stride);
#pragma unroll 1
        for (int gq = 0; gq < CV_T / CVG; ++gq) {
            float y0[CVG], y1[CVG];
#pragma unroll
            for (int t = 0; t < CVG; ++t) { y0[t] = bv[0]; y1[t] = bv[1]; }
            const LAS unsigned char* wp = lds + gq * CVG * 2048 + tid * 4;
#pragma unroll
            for (int i = 0; i < CVG + 30; ++i) {
                const unsigned uu = *(const LAS unsigned*)(wp + i * 2048);
                const float u0 = __uint_as_float(uu << 16), u1 = __uint_as_float(uu & 0xffff0000u);
#pragma unroll
                for (int t = 0; t < CVG; ++t) { const int k = i - t; if (k >= 0 && k < 31) { y0[t] += w0[k] * u0; y1[t] += w1[k] * u1; } }
                if ((i & 7) == 7) asm volatile("" ::: "memory");
            }
            {
                float sv[2 * CVG];
#pragma unroll
                for (int t = 0; t < CVG; ++t) { sv[2 * t] = y0[t] + y1[t]; sv[2 * t + 1] = y0[t] * y0[t] + y1[t] * y1[t]; }
#pragma unroll
                for (int k = 0; k < 2 * CVG; ++k) sv[k] += dpp_mov<0xB1>(sv[k]);
#pragma unroll
                for (int k = 0; k < 2 * CVG; ++k) sv[k] += dpp_mov<0x4E>(sv[k]);
#pragma unroll
                for (int k = 0; k < 2 * CVG; ++k) sv[k] += dpp_mov<0x124>(sv[k]);
#pragma unroll
                for (int k = 0; k < 2 * CVG; ++k) sv[k] += dpp_mov<0x128>(sv[k]);
#pragma unroll
                for (int k = 0; k < 2 * CVG; ++k) { auto r = __builtin_amdgcn_permlane16_swap(__float_as_uint(sv[k]), __float_as_uint(sv[k]), false, false); sv[k] = __uint_as_float(r[0]) + __uint_as_float(r[1]); }
#pragma unroll
                for (int k = 0; k < 2 * CVG; ++k) { auto r = __builtin_amdgcn_permlane32_swap(__float_as_uint(sv[k]), __float_as_uint(sv[k]), false, false); sv[k] = __uint_as_float(r[0]) + __uint_as_float(r[1]); }
                if (F.lane_() == 0) {
#pragma unroll
                    for (int t = 0; t < CVG; ++t) *(LAS f32x2v*)(red + (t * 8 + F.wave) * 2) = (f32x2v){sv[2 * t], sv[2 * t + 1]}; }
            }
            __syncthreads();
            if (tid < CVG) { float s = 0.f, q = 0.f;
#pragma unroll
                for (int w = 0; w < 8; ++w) { s += red[(tid * 8 + w) * 2]; q += red[(tid * 8 + w) * 2 + 1]; }
                const float mean = s * (1.f / DM), var = fmaxf(q * (1.f / DM) - mean * mean, 0.f);
                stat[tid * 2] = mean; stat[tid * 2 + 1] = rsqrtf(var + EPS); }
            __syncthreads();
#pragma unroll
            for (int t = 0; t < CVG; ++t) {
                const float mean = stat[t * 2], rs = stat[t * 2 + 1];
                const float a = (y0[t] - mean) * rs * gv[0] + bv2[0], c = (y1[t] - mean) * rs * gv[1] + bv2[1];
                const float sa = a * pg8::sigm1(a), sc = c * pg8::sigm1(c);
                *(GAS unsigned*)(CA + (size_t)(m0 + gq * CVG + t) * 1024 + 2 * tid) = pg8::cvt_pk_bf16(sa, sc);
            }
        }
        __syncthreads();
        if (more) { CV_WRITE(); __syncthreads(); }
    }
#undef CV_LOAD
#undef CV_WRITE
}

__global__ void __launch_bounds__(NWAVES * 64, 2) mk_fwd(Args args) {
    extern __shared__ __attribute__((aligned(16))) unsigned char lds[];
    Frame F;
    F.lds = (LAS unsigned char*)lds;
    F.MISC = (volatile LAS unsigned*)(F.lds + MISC_OFF);
    F.wave = __builtin_amdgcn_readfirstlane((int)threadIdx.x >> 6);
    F.G = gridDim.x; { const int bx = blockIdx.x; F.vcu = (F.G % 8 == 0) ? (bx % 8) * (F.G / 8) + bx / 8 : bx; }
    unsigned char* ws = args.ws;
    F.ctl = (gu32*)(ws + WS_CTL);
    for (int u = F.tid_(); u < 512 / 4; u += NWAVES * 64) ((LAS unsigned*)(F.lds + LDSCTL_OFF))[u] = 0u;
    __syncthreads();
    XcdBarrier bar; bar.bar = (unsigned*)(F.ctl + CW_BAR); bar.x = 0; bar.st = nullptr; bar.wave = F.wave;
    if (args.use_bar) bar = xcd_barrier_post((unsigned*)(F.ctl + CW_BAR), F.MISC + 8, F.wave);
    const int lo = args.ph_lo, hi = args.ph_hi;
#ifndef PHM
#define PHM 0x3FFF
#endif
#define IN(k) (((PHM >> (k)) & 1) && lo <= (k) && (k) < hi)
#define SEAM(k) do { if (IN(k) && IN((k) + 1)) { if (local_mode) xcc_local_barrier(bar); else xcd_barrier(bar); } } while (0)
    int local_mode = 0, vbx = (int)blockIdx.x;

    const float* x = args.in[0]; float* out = args.out;
    LAS unsigned char* escr = F.lds + EPI_OFF + F.wave * pg8::EPI_WAVE_BYTES;
    float* mod = (float*)(ws + WS_MOD);
    int grp = -1;
#define BUF(name, flat_off, slab_off, pitch) bf16* name = (gq < 0) ? (bf16*)(ws + (flat_off)) : (bf16*)(ws + WS_H + (size_t)gq * (50 * MiB) + (slab_off)) - (size_t)gq * 4096 * (pitch)
#define GATES() bf16* GA = (gq < 0) ? (bf16*)out : (bf16*)((unsigned char*)out + (size_t)gq * (16 * MiB)) - (size_t)gq * 4096 * 1024; bf16* GC = (gq < 0) ? GA + (size_t)M * DM : GA + 4096 * 1024
#define GRP() int gq = grp; asm volatile("" : "+s"(gq))
#define B_H()   BUF(H,   WS_H,   0 * MiB,  1024)
#define B_Y1()  BUF(Y1,  WS_Y1,  8 * MiB,  1024)
#define B_Y2()  BUF(Y2,  WS_Y2,  16 * MiB, 1024)
#define B_ACT() BUF(ACT, WS_ACT, 24 * MiB, FF)
#define B_Q()   BUF(Qb,  WS_Q,   24 * MiB, 1024)
#define B_K()   BUF(Kb,  WS_K,   32 * MiB, 128)
#define B_V()   BUF(Vb,  WS_V,   33 * MiB, 128)
#define B_U()   BUF(Ub,  WS_U,   34 * MiB, 1024)
#define B_CA()  BUF(CA,  WS_CA,  42 * MiB, 1024)

    if (IN(0)) { p0_prologue(F, args); } SEAM(0);
    if (args.use_bar && IN(0) && IN(1)) {
#ifdef FORCE_GLOBAL_SEAMS
        if (F.wave == 0 && pg8::lane_id() == 0) F.MISC[11] = 0u;
#else
        if (F.wave == 0 && pg8::lane_id() == 0) F.MISC[11] = xcc_regular(bar.bar);
#endif
        __syncthreads();
        local_mode = __builtin_amdgcn_readfirstlane((int)F.MISC[11]);
        if (local_mode) { const int rank = __builtin_amdgcn_readfirstlane((int)F.MISC[10]) - 1; vbx = 8 * rank + (int)bar.x; F.vcu = 32 * (int)bar.x + rank; grp = (int)bar.x; }
    }
    if (IN(1)) { GRP(); B_H(); norm_phase<0, 0, false, false>(F, x, nullptr, nullptr, nullptr, nullptr, nullptr, args.in[4], mod, 0, H, nullptr); } SEAM(1);
    if (IN(2)) { GRP(); B_H(); B_ACT(); pg8::Gemm g{H, (const bf16*)(ws + WS_WGU1), M, 2 * FF, DM, F.wave}; pg8::StaticOrder S; S.init(M, 2 * FF, F.G, vbx);
        pg8::EpiSwiGLU E{ACT, FF};
        pg8::gemm_phase<pg8::EpiSwiGLU, pg8::StaticOrder, true, true>(F.lds + RING_OFF, g, S, E); } SEAM(2);
    if (IN(3)) { GRP(); B_ACT(); B_Y1(); pg8::Gemm g{ACT, (const bf16*)(ws + WS_WD1), M, DM, FF, F.wave}; pg8::StaticOrder S; S.init(M, DM, F.G, vbx);
        typedef pg8::EpiDelta<NMODW, SEQ / 256, 1> EpiD; EpiD E{Y1, mod + 2 * DM, escr};
        pg8::gemm_phase<EpiD, pg8::StaticOrder, true, true>(F.lds + RING_OFF, g, S, E); } SEAM(3);
    if (IN(4)) { GRP(); B_H(); B_Y1(); norm_phase<0, 1, false, true>(F, x, nullptr, Y1, nullptr, nullptr,   Y1, args.in[8], mod, 3, H, nullptr); } SEAM(4);
    if (IN(5)) { GRP(); B_H(); B_Q(); B_K(); B_V(); B_U(); GATES(); pg8::Gemm g{H, (const bf16*)(ws + WS_WIN), M, NIN, DM, F.wave}; pg8::StaticOrder S; S.init(M, NIN, F.G, vbx);
        pg8::EpiIn E{Qb, Kb, Vb, Ub, GA, GC, escr};
        pg8::gemm_phase<pg8::EpiIn, pg8::StaticOrder, true, true>(F.lds + RING_OFF, g, S, E); } SEAM(5);
    if (IN(6)) { GRP(); B_Q(); B_K(); B_V(); B_U(); B_CA(); BUF(AO, WS_AO, 0 * MiB, 1024);
        if (local_mode) { for (int li = F.vcu & 31; li < 64; li += 32) { const int kvh = li & 1, n = (li >> 1) & 15, b = 2 * (F.vcu >> 5) + (li >> 5); attn_unit(F, b, n, kvh, Qb, Kb, Vb, args.in[10], AO); } }
        else for (int uidx = F.vcu; uidx < BATCH * 16 * 2; uidx += F.G) { const int kvh = uidx & 1, n = (uidx >> 1) & 15, b = uidx >> 5; attn_unit(F, b, n, kvh, Qb, Kb, Vb, args.in[10], AO); }
        if (local_mode) conv_phase(F, 128 * (F.vcu >> 5) + (F.vcu & 31), 32, 128 * (F.vcu >> 5) + 128, Ub, args.in[12], args.in[13], args.in[14], args.in[15], CA);
        else conv_phase(F, F.vcu, F.G, M / CV_T, Ub, args.in[12], args.in[13], args.in[14], args.in[15], CA);
    } SEAM(6);
    if (IN(7)) { GRP(); BUF(AO, WS_AO, 0 * MiB, 1024); BUF(YA, WS_YA, 24 * MiB, 1024); GATES(); (void)GC; pg8::Gemm g{AO, (const bf16*)(ws + WS_WAO), M, DM, DM, F.wave}; pg8::StaticOrder S; S.init(M, DM, F.G, vbx);
        pg8::EpiGate<0> E{GA, nullptr, YA, escr};
        pg8::gemm_phase<pg8::EpiGate<0>, pg8::StaticOrder, true, true>(F.lds + RING_OFF, g, S, E); }
    if (IN(8)) { GRP(); B_CA(); BUF(YA, WS_YA, 24 * MiB, 1024); BUF(MG, WS_MG, 34 * MiB, 1024); GATES(); (void)GA; pg8::Gemm g{CA, (const bf16*)(ws + WS_WCO), M, DM, DM, F.wave}; pg8::StaticOrder S; S.init(M, DM, F.G, vbx);
        pg8::EpiGate<1> E{GC, YA, MG, escr};
        pg8::gemm_phase<pg8::EpiGate<1>, pg8::StaticOrder, true, true>(F.lds + RING_OFF, g, S, E); } SEAM(8);
    if (IN(9)) { GRP(); BUF(MG, WS_MG, 34 * MiB, 1024); B_Y2(); pg8::Gemm g{MG, (const bf16*)(ws + WS_WOUT), M, DM, DM, F.wave}; pg8::StaticOrder S; S.init(M, DM, F.G, vbx);
        typedef pg8::EpiDelta<NMODW, SEQ / 256, 0> EpiD; EpiD E{Y2, mod + 5 * DM, escr};
        pg8::gemm_phase<EpiD, pg8::StaticOrder, true, true>(F.lds + RING_OFF, g, S, E); } SEAM(9);
    if (IN(10)) { GRP(); B_H(); B_Y1(); B_Y2(); norm_phase<0, 1, true, true>(F, nullptr,   Y1, Y2, nullptr, nullptr,   Y2, args.in[18], mod, 6, H, nullptr); } SEAM(10);
    if (IN(11)) { GRP(); B_H(); B_ACT(); pg8::Gemm g{H, (const bf16*)(ws + WS_WGU2), M, 2 * FF, DM, F.wave}; pg8::StaticOrder S; S.init(M, 2 * FF, F.G, vbx);
        pg8::EpiSwiGLU E{ACT, FF};
        pg8::gemm_phase<pg8::EpiSwiGLU, pg8::StaticOrder, true, true>(F.lds + RING_OFF, g, S, E); } SEAM(11);
    if (IN(12)) { GRP(); B_ACT(); BUF(Y3, WS_H, 0 * MiB, 1024); pg8::Gemm g{ACT, (const bf16*)(ws + WS_WD2), M, DM, FF, F.wave}; pg8::StaticOrder S; S.init(M, DM, F.G, vbx);
        typedef pg8::EpiDelta<NMODW, SEQ / 256, 1> EpiD; EpiD E{Y3, mod + 8 * DM, escr};
        pg8::gemm_phase<EpiD, pg8::StaticOrder, true, true>(F.lds + RING_OFF, g, S, E); } SEAM(12);
    if (IN(13)) { GRP(); B_Y2(); BUF(Y3, WS_H, 0 * MiB, 1024); norm_phase<1, 1, true, false>(F, nullptr,   Y2, Y3, nullptr, nullptr, nullptr, args.in[22], nullptr, 0, nullptr, out); }
#undef IN
#undef SEAM
}

#ifndef SPLIT_LAUNCH
#define SPLIT_LAUNCH 0
#endif
extern "C" void kernel_launch(void* const* d_in, const int* in_sizes, int n_in, void* d_out, int out_size, void* d_ws, size_t ws_size, hipStream_t stream) {
    static int grid = 0;
    if (grid == 0) {
        if (n_in != 23 || in_sizes[0] != M * DM || out_size != M * DM || ws_size < WS_END) {
            fprintf(stderr, "kernel_launch: unexpected shapes n_in %d in0 %d out %d ws %zu\n", n_in, n_in > 0 ? in_sizes[0] : -1, out_size, ws_size); grid = -1; return; }
        int dev = 0, cus = 0, per_cu = 0;
        if (hipGetDevice(&dev) != hipSuccess || hipDeviceGetAttribute(&cus, hipDeviceAttributeMultiprocessorCount, dev) != hipSuccess) { fprintf(stderr, "kernel_launch: device query failed\n"); grid = -1; return; }
        if (hipFuncSetAttribute((const void*)mk_fwd, hipFuncAttributeMaxDynamicSharedMemorySize, LDS_BYTES) != hipSuccess) { fprintf(stderr, "kernel_launch: hipFuncSetAttribute failed\n"); grid = -1; return; }
        if (hipOccupancyMaxActiveBlocksPerMultiprocessor(&per_cu, (const void*)mk_fwd, NWAVES * 64, LDS_BYTES) != hipSuccess || per_cu < 1) { fprintf(stderr, "kernel_launch: the occupancy query admits %d workgroups per CU for this kernel and LDS size; nothing launched\n", per_cu); (void)hipGetLastError(); grid = -1; return; }
        (void)hipGetLastError();
        grid = cus;
    }
    if (grid < 0) return;
    (void)hipMemsetAsync((unsigned char*)d_ws + WS_CTL, 0, CTL_ZERO_BYTES, stream);
    Args a{};
    for (int i = 0; i < 23; ++i) a.in[i] = (const float*)d_in[i];
    a.out = (float*)d_out; a.ws = (unsigned char*)d_ws;
    if (!SPLIT_LAUNCH) {
        a.ph_lo = 0; a.ph_hi = NPHASE; a.use_bar = 1;
        hipLaunchKernelGGL(mk_fwd, dim3(grid), dim3(NWAVES * 64), LDS_BYTES, stream, a);
        return;
    }
    for (int k = 0; k < NPHASE; ++k) { a.ph_lo = k; a.ph_hi = k + 1; a.use_bar = 0; hipLaunchKernelGGL(mk_fwd, dim3(grid), dim3(NWAVES * 64), LDS_BYTES, stream, a); }
}
```

```cpp
#include <hip/hip_runtime.h>
#include <cstdio>
#include <cstdint>

typedef unsigned short bf16_t;
constexpr int BATCH = 16, SEQ = 2048, DM = 1024, M = BATCH * SEQ, FF = 2816, NIN = 5376, NMODW = 9 * DM;
constexpr float EPS = 1e-6f;

__device__ __forceinline__ float bf2f(bf16_t v) { return __uint_as_float(((unsigned)v) << 16); }
__device__ __forceinline__ bf16_t f2bf(float f) { unsigned u = __float_as_uint(f); return (bf16_t)((u + 0x7fffu + ((u >> 16) & 1u)) >> 16); }
__device__ __forceinline__ float sigm(float x) { return 1.f / (1.f + __expf(-x)); }
__device__ __forceinline__ float silu(float x) { return x / (1.f + __expf(-x)); }

constexpr size_t MiB = 1u << 20;
constexpr size_t WS_CTL = 0, WS_MOD = 1 * MiB;
constexpr size_t WS_H = 52 * MiB;
constexpr size_t WS_Y1 = 116 * MiB, WS_Y2 = 180 * MiB;
constexpr size_t WS_ACT = 244 * MiB;
constexpr size_t WS_Q = 244 * MiB;
constexpr size_t WS_K = 308 * MiB;
constexpr size_t WS_V = 316 * MiB;
constexpr size_t WS_U = 324 * MiB;
constexpr size_t WS_CA = 388 * MiB;
constexpr size_t WS_END = 452 * MiB;
constexpr size_t WS_AO = WS_H, WS_YA = WS_Q, WS_MG = WS_U;

namespace pg8 {
#define PG8_LAS __attribute__((address_space(3)))
typedef unsigned short bf16_t;
typedef short bf16x8 __attribute__((ext_vector_type(8)));
typedef float f32x4 __attribute__((ext_vector_type(4)));
typedef unsigned u32x4 __attribute__((ext_vector_type(4)));
constexpr int BM = 256, BK = 64, HALF = 128, HTB = HALF * BK * 2  , STAGE_BYTES = 8 * HTB, NXCD = 8, WGM = 8;

__host__ __device__ __forceinline__ int lds_byte(int r, int c) { const int st = (r >> 4) * 2 + (c >> 5), rr = r & 15, cc = c & 31, ob = rr * 64 + cc * 2; return st * 1024 + (ob ^ (((ob >> 9) & 1) << 5)); }
__host__ __device__ __forceinline__ void stage_rc(int b, int& R, int& C) { const int st = b / 1024, sb = b % 1024, swz = sb ^ (((sb >> 9) & 1) << 5); R = (st >> 1) * 16 + swz / 64; C = (st & 1) * 32 + (swz % 64) / 2; }
__host__ __device__ __forceinline__ int perm32(int rho) { const int n = rho >> 4, i = rho & 15; return 8 * (i >> 2) + 4 * n + (i & 3); }

__device__ __forceinline__ int lane_id() { unsigned z; asm volatile("s_mov_b32 %0, 0" : "=s"(z)); return (int)__builtin_amdgcn_mbcnt_hi(~0u, __builtin_amdgcn_mbcnt_lo(~0u, z)); }
struct Unit { int pm, pn; };
struct Gemm { const bf16_t* A; const bf16_t* Bt; int M, N, K, wave; };

struct StaticOrder {
    int nM, nN, nwg, G, c;
    __host__ __device__ void init(int M, int N, int G_, int c_) { nM = M / BM; nN = N / BM; nwg = nM * nN; G = G_; c = c_; }
    __host__ __device__ bool next(int i, Unit& u) const {
        const long L = (long)i * G + c; if (L >= nwg) return false;
        int wgid = (int)L; { const int q = nwg / NXCD, r = nwg % NXCD, xcd = wgid % NXCD, off = wgid / NXCD; wgid = (xcd < r ? xcd * (q + 1) : r * (q + 1) + (xcd - r) * q) + off; }
        const int nig = WGM * nN, gid = wgid / nig, fm = gid * WGM, gsz = (nM - fm) < WGM ? (nM - fm) : WGM;
        u.pm = fm + ((wgid % nig) % gsz); u.pn = (wgid % nig) / gsz; return true;
    }
    __device__ __forceinline__ void a_ready(const Unit&) const {}
    __device__ __forceinline__ void done(const Unit&) const {}
};

typedef float f32x2 __attribute__((ext_vector_type(2)));
typedef __bf16 bf16x2_t __attribute__((ext_vector_type(2)));
constexpr int EPI_ROWB = 144, EPI_WAVE_BYTES = 16 * EPI_ROWB;
__device__ __forceinline__ unsigned cvt_pk_bf16(float lo, float hi) { f32x2 v = {lo, hi}; bf16x2_t b = __builtin_convertvector(v, bf16x2_t); return __builtin_bit_cast(unsigned, b); }
__device__ __forceinline__ u32x4 pack8(f32x4 a, f32x4 b) { u32x4 w; w.x = cvt_pk_bf16(a[0], a[1]); w.y = cvt_pk_bf16(a[2], a[3]); w.z = cvt_pk_bf16(b[0], b[1]); w.w = cvt_pk_bf16(b[2], b[3]); return w; }
__device__ __forceinline__ void unpack8(u32x4 w, f32x4& a, f32x4& b) {
    a[0] = __uint_as_float(w.x << 16); a[1] = __uint_as_float(w.x & 0xffff0000u); a[2] = __uint_as_float(w.y << 16); a[3] = __uint_as_float(w.y & 0xffff0000u);
    b[0] = __uint_as_float(w.z << 16); b[1] = __uint_as_float(w.z & 0xffff0000u); b[2] = __uint_as_float(w.w << 16); b[3] = __uint_as_float(w.w & 0xffff0000u); }
__device__ __forceinline__ float sigm1(float x) { return __builtin_amdgcn_rcpf(1.0f + __builtin_amdgcn_exp2f(x * -1.4426950408889634f)); }
__device__ __forceinline__ f32x4 sigm4(f32x4 x) { f32x4 r; r[0] = sigm1(x[0]); r[1] = sigm1(x[1]); r[2] = sigm1(x[2]); r[3] = sigm1(x[3]); return r; }
template <bool PERM> __device__ __forceinline__ void epi_put(PG8_LAS unsigned char* scr, int fr, int fq, f32x4 v0, f32x4 v1) {
    const int c0 = PERM ? 8 * fq : 4 * fq, c1 = PERM ? 8 * fq + 4 : 16 + 4 * fq;
    *(PG8_LAS f32x4*)(scr + fr * EPI_ROWB + c0 * 4) = v0; *(PG8_LAS f32x4*)(scr + fr * EPI_ROWB + c1 * 4) = v1; }
__device__ __forceinline__ void epi_get8(PG8_LAS unsigned char* scr, int lane, f32x4& a, f32x4& b) {
    PG8_LAS unsigned char* p = scr + (lane >> 2) * EPI_ROWB + (lane & 3) * 32; a = *(PG8_LAS f32x4*)p; b = *(PG8_LAS f32x4*)(p + 16); }
__device__ __forceinline__ f32x4 epi_get4(PG8_LAS unsigned char* scr, int lane, int pass) {
    return *(PG8_LAS f32x4*)(scr + ((lane >> 3) + 8 * pass) * EPI_ROWB + (lane & 7) * 16); }

struct EpiSwiGLU {
    static constexpr bool PERM = true, AFTER_DRAIN = false; static constexpr int NST = 8;
    bf16_t* O; int ldc;
    __device__ __forceinline__ void operator()(const f32x4 (&acc)[2][2][4][2], const Unit& u, int wr, int wc, int fr, int fq) const {
        asm volatile("" : "+v"(fr), "+v"(fq));
        bf16_t* base = O + (size_t)(u.pm * BM + wr * 64 + fr) * ldc + u.pn * HALF + wc * 32 + 8 * fq;
#pragma unroll
        for (int ai = 0; ai < 2; ++ai)
#pragma unroll
            for (int m = 0; m < 4; ++m) {
                const f32x4 g0 = acc[ai][0][m][0], g1 = acc[ai][0][m][1];
                *(u32x4*)(base + (size_t)(ai * HALF + m * 16) * ldc) = pack8(g0 * sigm4(g0) * acc[ai][1][m][0], g1 * sigm4(g1) * acc[ai][1][m][1]); }
    }
};
template <int GLD, int TPB, int HALFCOEF> struct EpiDelta {
    static constexpr bool PERM = true, AFTER_DRAIN = false; static constexpr int NST = 16;
    bf16_t* Y; const float* gate; PG8_LAS unsigned char* scr;
    __device__ __forceinline__ void operator()(const f32x4 (&acc)[2][2][4][2], const Unit& u, int wr, int wc, int fr, int fq) const {
        asm volatile("" : "+v"(fr), "+v"(fq));
        const int lane = fr + 16 * fq, b = u.pm / TPB, col0 = u.pn * BM + wc * 32 + 8 * (lane & 3); const float coef = HALFCOEF ? 0.5f : 1.0f;
        bf16_t* base = Y + (size_t)(u.pm * BM + wr * 64 + (lane >> 2)) * 1024 + col0;
        const float* gp = gate + (size_t)b * GLD + col0;
        const f32x4 g00 = *(const f32x4*)(gp) * coef, g01 = *(const f32x4*)(gp + 4) * coef, g10 = *(const f32x4*)(gp + HALF) * coef, g11 = *(const f32x4*)(gp + HALF + 4) * coef;
#pragma unroll
        for (int ai = 0; ai < 2; ++ai)
#pragma unroll
            for (int m = 0; m < 4; ++m) {
                { epi_put<true>(scr, fr, fq, acc[ai][0][m][0], acc[ai][0][m][1]); f32x4 a, c; epi_get8(scr, lane, a, c);
                  *(u32x4*)(base + (size_t)(ai * HALF + m * 16) * 1024) = pack8(a * g00, c * g01); }
                { epi_put<true>(scr, fr, fq, acc[ai][1][m][0], acc[ai][1][m][1]); f32x4 a, c; epi_get8(scr, lane, a, c);
                  *(u32x4*)(base + (size_t)(ai * HALF + m * 16) * 1024 + HALF) = pack8(a * g10, c * g11); } }
    }
};
struct EpiIn {
    static constexpr bool PERM = true, AFTER_DRAIN = false; static constexpr int NST = 8;
    bf16_t *Q, *K, *V, *U, *GA, *GC; PG8_LAS unsigned char* scr;
    __device__ __forceinline__ void operator()(const f32x4 (&acc)[2][2][4][2], const Unit& u, int wr, int wc, int fr, int fq) const {
        asm volatile("" : "+v"(fr), "+v"(fq));
        const int lane = fr + 16 * fq, pn = u.pn, cw = wc * 32 + 8 * (lane & 3);
        const size_t row0 = (size_t)(u.pm * BM + wr * 64 + (lane >> 2));
        if (pn >= 5 && pn < 13) {
            bf16_t* base = U + row0 * 1024 + (pn - 5) * HALF + cw;
#pragma unroll
            for (int ai = 0; ai < 2; ++ai)
#pragma unroll
                for (int m = 0; m < 4; ++m) {
                    epi_put<true>(scr, fr, fq, acc[ai][0][m][0] * sigm4(acc[ai][1][m][0]), acc[ai][0][m][1] * sigm4(acc[ai][1][m][1]));
                    f32x4 a, b; epi_get8(scr, lane, a, b);
                    *(u32x4*)(base + (size_t)(ai * HALF + m * 16) * 1024) = pack8(a, b); }
        } else if (pn >= 13) {
            bf16_t* base = (pn < 17 ? GA + (pn - 13) * BM : GC + (pn - 17) * BM) + row0 * 1024 + cw;
#pragma unroll
            for (int ai = 0; ai < 2; ++ai)
#pragma unroll
                for (int m = 0; m < 4; ++m)
#pragma unroll
                    for (int bj = 0; bj < 2; ++bj) {
                        epi_put<true>(scr, fr, fq, sigm4(acc[ai][bj][m][0]), sigm4(acc[ai][bj][m][1]));
                        f32x4 a, b; epi_get8(scr, lane, a, b);
                        *(u32x4*)(base + (size_t)(ai * HALF + m * 16) * 1024 + bj * HALF) = pack8(a, b); }
        } else {
            bf16_t* b0; bf16_t* b1; int ld; float sc;
            if (pn < 4) { b0 = Q + row0 * 1024 + pn * BM + cw; b1 = b0 + HALF; ld = 1024; sc = 0.125f * 1.4426950408889634f;     } else { b0 = K + row0 * 128 + cw; b1 = V + row0 * 128 + cw; ld = 128; sc = 1.0f; }
#pragma unroll
            for (int ai = 0; ai < 2; ++ai)
#pragma unroll
                for (int m = 0; m < 4; ++m)
#pragma unroll
                    for (int bj = 0; bj < 2; ++bj) {
                        epi_put<true>(scr, fr, fq, acc[ai][bj][m][0] * sc, acc[ai][bj][m][1] * sc);
                        f32x4 a, b; epi_get8(scr, lane, a, b);
                        *(u32x4*)((bj ? b1 : b0) + (size_t)(ai * HALF + m * 16) * ld) = pack8(a, b); }
        }
    }
};
template <int MODE> struct EpiGate {
    static constexpr bool PERM = true, AFTER_DRAIN = false; static constexpr int NST = 16;
    const bf16_t* G; const bf16_t* Y; bf16_t* O; PG8_LAS unsigned char* scr;
    __device__ __forceinline__ void operator()(const f32x4 (&acc)[2][2][4][2], const Unit& u, int wr, int wc, int fr, int fq) const {
        asm volatile("" : "+v"(fr), "+v"(fq));
        const int lane = fr + 16 * fq;
        const size_t off0 = (size_t)(u.pm * BM + wr * 64 + (lane >> 2)) * 1024 + u.pn * BM + wc * 32 + 8 * (lane & 3);
#pragma unroll
        for (int ai = 0; ai < 2; ++ai) {
            u32x4 gw[4][2], yw[4][2];
#pragma unroll
            for (int m = 0; m < 4; ++m)
#pragma unroll
                for (int bj = 0; bj < 2; ++bj) { const size_t off = off0 + (size_t)(ai * HALF + m * 16) * 1024 + bj * HALF; gw[m][bj] = *(const u32x4*)(G + off); if (MODE == 1) yw[m][bj] = *(const u32x4*)(Y + off); }
            asm volatile("" ::: "memory");
#pragma unroll
            for (int m = 0; m < 4; ++m)
#pragma unroll
                for (int bj = 0; bj < 2; ++bj) { const size_t off = off0 + (size_t)(ai * HALF + m * 16) * 1024 + bj * HALF;
                    epi_put<true>(scr, fr, fq, acc[ai][bj][m][0], acc[ai][bj][m][1]);
                    f32x4 a, b; epi_get8(scr, lane, a, b);
                    f32x4 g0, g1; unpack8(gw[m][bj], g0, g1);
                    f32x4 v0 = g0 * a, v1 = g1 * b;
                    if (MODE == 1) { f32x4 y0, y1; unpack8(yw[m][bj], y0, y1); v0 += y0; v1 += y1; }
                    *(u32x4*)(O + off) = pack8(v0, v1); }
            asm volatile("" ::: "memory");
        }
    }
};
template <class Epi, class Sched, bool ALIGN_EPI = false, bool SP2 = false>
__device__ __forceinline__ void gemm_phase(PG8_LAS unsigned char* lds, const Gemm g, const Sched& S, const Epi& E) {
    int tid = (g.wave << 6) | lane_id(); asm volatile("" : "+v"(tid));
    const int wid = g.wave, wr = wid >> 2, wc = wid & 3;
    int aoff, boff;
    { const int lane = tid & 63, fr = lane & 15, fq = lane >> 4; aoff = lds_byte(wr * 64 + fr, fq * 8); boff = lds_byte(wc * 32 + fr, fq * 8); }
    const int K = g.K, nt = K / BK;
    unsigned voffA[2], voffB[2];
#pragma unroll
    for (int i = 0; i < 2; ++i) { int R, C; stage_rc(tid * 16 + i * 8192, R, C); const int Rb = Epi::PERM ? ((R & ~31) + perm32(R & 31)) : R;
        voffA[i] = (unsigned)(R * K + C) * 2u; voffB[i] = (unsigned)(Rb * K + C) * 2u; }
    const size_t kstep = (size_t)(BK * 2);
    const size_t hstep = (size_t)HALF * K * 2;
    const size_t tstep = 2 * hstep;
    const unsigned ldsw = (unsigned)wid * 1024u;
#define PG8_SA(b, h) (((b) * 2 + (h)) * HTB)
#define PG8_SB(b, h) ((4 + (b) * 2 + (h)) * HTB)
#define PG8_STAGE(bufoff, gbase, voff) do { _Pragma("unroll") for (int _i = 0; _i < 2; ++_i) \
        __builtin_amdgcn_global_load_lds((const unsigned*)((const char*)(gbase) + (voff)[_i]), (PG8_LAS unsigned*)(lds + (bufoff) + ldsw + _i * 8192), 16, 0, 0); } while (0)
#define PG8_LDA(dst, b, h) do { _Pragma("unroll") for (int m = 0; m < 4; ++m) _Pragma("unroll") for (int k = 0; k < 2; ++k) dst[m][k] = *(const PG8_LAS bf16x8*)(lds + PG8_SA(b, h) + aoff + m * 2048 + k * 1024); } while (0)
#define PG8_LDB(dst, b, h) do { _Pragma("unroll") for (int n = 0; n < 2; ++n) _Pragma("unroll") for (int k = 0; k < 2; ++k) dst[n][k] = *(const PG8_LAS bf16x8*)(lds + PG8_SB(b, h) + boff + n * 2048 + k * 1024); } while (0)
#define PG8_MMA(ai, bj, At, Bt) do { __builtin_amdgcn_s_setprio(1); _Pragma("unroll") for (int m = 0; m < 4; ++m) _Pragma("unroll") for (int n = 0; n < 2; ++n) _Pragma("unroll") for (int k = 0; k < 2; ++k) \
        acc[ai][bj][m][n] = __builtin_amdgcn_mfma_f32_16x16x32_bf16(Bt[n][k], At[m][k], acc[ai][bj][m][n], 0, 0, 0); __builtin_amdgcn_s_setprio(0); } while (0)
#define PG8_WAIT_V(n) asm volatile("s_waitcnt vmcnt(" #n ")" ::: "memory")
#define PG8_WAIT_L(n) asm volatile("s_waitcnt lgkmcnt(" #n ")" ::: "memory")
#define PG8_BAR __builtin_amdgcn_s_barrier()
#define PG8_SCHED __builtin_amdgcn_sched_barrier(0)
    Unit cur, nxt; int ui = 0;
    if (!S.next(0, cur)) return;
    f32x4 acc[2][2][4][2];
#pragma unroll
    for (int a = 0; a < 2; ++a)
#pragma unroll
        for (int b = 0; b < 2; ++b)
#pragma unroll
            for (int m = 0; m < 4; ++m)
#pragma unroll
                for (int n = 0; n < 2; ++n) acc[a][b][m][n] = (f32x4){0.f, 0.f, 0.f, 0.f};
    bf16x8 At[4][2], B0[2][2], B1[2][2];
    const char* cA = (const char*)g.A + (size_t)cur.pm * tstep; const char* cB = (const char*)g.Bt + (size_t)cur.pn * tstep;
    S.a_ready(cur);
    {
        PG8_STAGE(PG8_SB(0, 0), cB, voffB); PG8_STAGE(PG8_SB(0, 1), cB + hstep, voffB); PG8_STAGE(PG8_SA(0, 0), cA, voffA); PG8_STAGE(PG8_SA(0, 1), cA + hstep, voffA);
        if (wr == 1) PG8_BAR;
        PG8_WAIT_V(2); PG8_BAR;
        PG8_STAGE(PG8_SB(1, 0), cB + kstep, voffB); PG8_STAGE(PG8_SA(1, 0), cA + kstep, voffA); PG8_STAGE(PG8_SB(1, 1), cB + hstep + kstep, voffB);
        PG8_WAIT_V(6); PG8_BAR;
    }
    static_assert(SP2 && ALIGN_EPI && !Epi::AFTER_DRAIN && Epi::NST > 0, "this copy of the body keeps only the SP2 + ALIGN_EPI + store-overlap form");
#define PG8_WAIT_VI(n) asm volatile("s_waitcnt vmcnt(%0)" :: "i"(n) : "memory")
#define PG8_TRIP(STG, WV) do { asm volatile("" : "+v"(voffA[0]), "+v"(voffA[1]), "+v"(voffB[0]), "+v"(voffB[1]));     \
            PG8_LDB(B0, 0, 0); PG8_LDB(B1, 0, 1); PG8_SCHED; PG8_LDA(At, 0, 0); if (STG) { PG8_STAGE(PG8_SA(1, 1), a1 + hstep, voffA); } \
            PG8_WAIT_VI(WV); PG8_WAIT_L(0); PG8_BAR; PG8_MMA(0, 0, At, B0); PG8_MMA(0, 1, At, B1); PG8_BAR; PG8_SCHED; \
            PG8_LDA(At, 0, 1); PG8_STAGE(PG8_SB(0, 0), b2, voffB); PG8_STAGE(PG8_SB(0, 1), b2 + hstep, voffB); PG8_STAGE(PG8_SA(0, 0), a2, voffA); \
            PG8_WAIT_VI(WV); PG8_WAIT_L(0); PG8_BAR; PG8_MMA(1, 0, At, B0); PG8_MMA(1, 1, At, B1); PG8_BAR; PG8_SCHED; \
            PG8_LDB(B0, 1, 0); PG8_LDB(B1, 1, 1); PG8_SCHED; PG8_LDA(At, 1, 0); PG8_STAGE(PG8_SA(0, 1), a2 + hstep, voffA); \
            PG8_WAIT_VI(WV); PG8_WAIT_L(0); PG8_BAR; PG8_MMA(0, 0, At, B0); PG8_MMA(0, 1, At, B1); PG8_BAR; PG8_SCHED; \
            PG8_LDA(At, 1, 1); PG8_STAGE(PG8_SB(1, 0), b3, voffB); PG8_STAGE(PG8_SB(1, 1), b3 + hstep, voffB); PG8_STAGE(PG8_SA(1, 0), a3, voffA); \
            PG8_WAIT_V(8); PG8_WAIT_L(0); PG8_BAR; PG8_MMA(1, 0, At, B0); PG8_MMA(1, 1, At, B1); PG8_BAR; PG8_SCHED; } while (0)
    {
        const char* a1 = cA + kstep; const char* a2 = cA + 2 * kstep; const char* b2 = cB + 2 * kstep; const char* a3 = a2 + kstep; const char* b3 = b2 + kstep;
        PG8_TRIP(true, 8);
    }
    for (;;) {
        const bool has_next = S.next(ui + 1, nxt);
        const char* nA = has_next ? (const char*)g.A + (size_t)nxt.pm * tstep : cA; const char* nB = has_next ? (const char*)g.Bt + (size_t)nxt.pn * tstep : cB;
        for (int t = 2; t < nt; t += 2) {
            const bool last = (t == nt - 2);
            const char* a1 = cA + (size_t)(t + 1) * kstep;
            const char* a2 = last ? nA : cA + (size_t)(t + 2) * kstep; const char* b2 = last ? nB : cB + (size_t)(t + 2) * kstep;
            const char* a3 = a2 + kstep; const char* b3 = b2 + kstep;
            if (last && has_next) S.a_ready(nxt);
            PG8_TRIP(true, 8);
            if (last) { PG8_STAGE(PG8_SA(1, 1), a3 + hstep, voffA); }
        }
        if (wr == 0) PG8_BAR;
        PG8_SCHED; { const int l_ = lane_id(); E(acc, cur, wr, wc, l_ & 15, l_ >> 4); } PG8_SCHED;
        S.done(cur);
        if (!has_next) break;
#pragma unroll
        for (int a = 0; a < 2; ++a)
#pragma unroll
            for (int b = 0; b < 2; ++b)
#pragma unroll
                for (int m = 0; m < 4; ++m)
#pragma unroll
                    for (int n = 0; n < 2; ++n) acc[a][b][m][n] = (f32x4){0.f, 0.f, 0.f, 0.f};
        cur = nxt; cA = nA; cB = nB; ++ui;
        if (wr == 1) PG8_BAR;
        PG8_SCHED;
        {
            const char* a1 = cA + kstep; const char* a2 = cA + 2 * kstep; const char* b2 = cB + 2 * kstep; const char* a3 = a2 + kstep; const char* b3 = b2 + kstep; (void)a1;
            PG8_TRIP(false, 8 + Epi::NST);
        }
    }
#undef PG8_TRIP
#undef PG8_WAIT_VI
    PG8_WAIT_V(0);
    PG8_BAR;
#undef PG8_SA
#undef PG8_SB
#undef PG8_STAGE
#undef PG8_LDA
#undef PG8_LDB
#undef PG8_MMA
#undef PG8_WAIT_V
#undef PG8_WAIT_L
#undef PG8_BAR
#undef PG8_SCHED
}
}
#define GAS __attribute__((address_space(1)))
#define LAS __attribute__((address_space(3)))
typedef unsigned short bf16;
typedef unsigned v4u __attribute__((ext_vector_type(4)));
typedef float f32x4 __attribute__((ext_vector_type(4)));
typedef short bf16x8 __attribute__((ext_vector_type(8)));
typedef GAS unsigned gu32;
typedef GAS unsigned long long gu64;
#define RLX_AGENT __ATOMIC_RELAXED, __HIP_MEMORY_SCOPE_AGENT
#define LDS_WAIT() asm volatile("s_waitcnt lgkmcnt(0)" ::: "memory")
#define VM_WAIT() asm volatile("s_waitcnt vmcnt(0)" ::: "memory")
__device__ __forceinline__ unsigned long long rt() { return __builtin_amdgcn_s_memrealtime(); }
__device__ __forceinline__ unsigned pk2(float lo, float hi) { return (unsigned)f2bf(lo) | ((unsigned)f2bf(hi) << 16); }

#define XB_TMO      128
#define XB_XCNT(j)  (256  + 64 * (j))
#define XB_XSUB(j)  (1280 + 64 * (j))
#define XB_XGEN(j)  (2304 + 64 * (j))
#define XB_TOP      3328
#define XB_TOPGEN   3392
#define XCD_BAR_WORDS 3456
#define XB_SPIN_CAP (1u << 18)

__device__ __forceinline__ unsigned xb_ld(unsigned* p)              { return __hip_atomic_load(p, __ATOMIC_RELAXED, __HIP_MEMORY_SCOPE_AGENT); }
__device__ __forceinline__ unsigned xb_add(unsigned* p, unsigned v) { return __hip_atomic_fetch_add(p, v, __ATOMIC_RELAXED, __HIP_MEMORY_SCOPE_AGENT); }
__device__ __forceinline__ unsigned xb_xcc_id() { return (unsigned)__builtin_amdgcn_s_getreg((3 << 11) | 20) & 0xFu; }
#define XB_SPIN(cond, bar) do { unsigned _sp = 0; while (cond) { __builtin_amdgcn_s_sleep(1); \
    if ((++_sp & 255u) == 0u) { if (xb_ld(&(bar)[XB_TMO])) break; if (_sp > XB_SPIN_CAP) { atomicAdd(&(bar)[XB_TMO], 1u); break; } } } } while (0)

struct XcdBarrier {
    unsigned* bar; unsigned x; int wave;
    volatile LAS unsigned* st;
};

__device__ __forceinline__ XcdBarrier xcd_barrier_post(unsigned* bar, volatile LAS unsigned* st, int wave) {
    XcdBarrier b; b.bar = bar; b.x = xb_xcc_id(); b.st = st; b.wave = wave;
    if (wave == 0 && pg8::lane_id() == 0) st[2] = xb_add(&bar[XB_XCNT(b.x)], 1u) + 1u;
    return b;
}
__device__ __forceinline__ void xcd_barrier_complete(unsigned* bar, unsigned x, unsigned& nloc, unsigned& nx) {
    const unsigned G = gridDim.x * gridDim.y * gridDim.z;
    unsigned sum, cnt, mine, sp = 0u;
    for (;;) {
        sum = 0u; cnt = 0u; mine = 0u;
#pragma unroll
        for (unsigned j = 0; j < 16; ++j) { const unsigned c = xb_ld(&bar[XB_XCNT(j)]); sum += c; cnt += (c > 0u) ? 1u : 0u; mine = (j == x) ? c : mine; }
        if (sum == G) break;
        __builtin_amdgcn_s_sleep(1);
        if ((++sp & 255u) == 0u) { if (xb_ld(&bar[XB_TMO])) break; if (sp > XB_SPIN_CAP) { atomicAdd(&bar[XB_TMO], 1u); break; } }
    }
    nloc = mine > 0u ? mine : 1u; nx = cnt > 0u ? cnt : 1u;
}

__device__ __forceinline__ void xcd_barrier(const XcdBarrier& b) {
    asm volatile("s_waitcnt vmcnt(0)" ::: "memory");
    __syncthreads();
    if (b.wave == 0 && pg8::lane_id() == 0) {
        unsigned* bar = b.bar;
        __builtin_amdgcn_s_waitcnt(0);
        unsigned nloc = b.st[0], nx = b.st[1];
        if (nloc == 0u) { xcd_barrier_complete(bar, b.x, nloc, nx); b.st[0] = nloc; b.st[1] = nx; }
        const unsigned old = xb_add(&bar[XB_XSUB(b.x)], 1u);
        const unsigned gen = old / nloc;
        if (old + 1u == (gen + 1u) * nloc) {
            __builtin_amdgcn_fence(__ATOMIC_RELEASE, "agent");
            asm volatile("s_waitcnt vmcnt(0)" ::: "memory");
            const unsigned og = xb_add(&bar[XB_TOP], 1u);
            const unsigned tg = og / nx;
            __builtin_amdgcn_fence(__ATOMIC_ACQUIRE, "agent");
            if (og + 1u == (tg + 1u) * nx) xb_add(&bar[XB_TOPGEN], 1u);
            else XB_SPIN(xb_ld(&bar[XB_TOPGEN]) == tg, bar);
            xb_add(&bar[XB_XGEN(b.x)], 1u);
            asm volatile("s_waitcnt vmcnt(0)" ::: "memory");
        } else {
            __builtin_amdgcn_fence(__ATOMIC_ACQUIRE, "agent");
            XB_SPIN(xb_ld(&bar[XB_XGEN(b.x)]) == gen, bar);
            asm volatile("s_waitcnt vmcnt(0)" ::: "memory");
        }
    }
    __syncthreads();
}

#define XB_LSUB(j)  (3520 + 64 * (j))
#define XB_LGEN(j)  (4544 + 64 * (j))
#define XB_WORDS_END 5568
__device__ __forceinline__ void xcc_local_barrier(const XcdBarrier& b) {
    asm volatile("s_waitcnt vmcnt(0)" ::: "memory");
    __syncthreads();
    if (b.wave == 0 && pg8::lane_id() == 0) {
        unsigned* bar = b.bar;
        __builtin_amdgcn_s_waitcnt(0);
        const unsigned nloc = b.st[0];
        const unsigned old = xb_add(&bar[XB_LSUB(b.x)], 1u), gen = old / nloc;
        __builtin_amdgcn_fence(__ATOMIC_ACQUIRE, "agent");
        if (old + 1u == (gen + 1u) * nloc) xb_add(&bar[XB_LGEN(b.x)], 1u);
        else XB_SPIN(xb_ld(&bar[XB_LGEN(b.x)]) == gen, bar);
        asm volatile("s_waitcnt vmcnt(0)" ::: "memory");
    }
    __syncthreads();
}
__device__ __forceinline__ unsigned xcc_regular(unsigned* bar) {
    unsigned ok = (gridDim.x == 256u) ? 1u : 0u;
#pragma unroll
    for (unsigned j = 0; j < 16; ++j) { const unsigned c = xb_ld(&bar[XB_XCNT(j)]); ok &= (c == (j < 8u ? 32u : 0u)) ? 1u : 0u; }
    return ok;
}

constexpr int NWAVES = 8;
constexpr int NPHASE = 14;
constexpr size_t WS_WGU1 = 2 * MiB, WS_WD1 = 13 * MiB, WS_WIN = 18 * MiB + 512 * 1024, WS_WAO = 29 * MiB, WS_WCO = 31 * MiB, WS_WOUT = 33 * MiB, WS_WGU2 = 35 * MiB, WS_WD2 = 46 * MiB;
static_assert(WS_WD2 + (size_t)DM * FF * 2 <= WS_H && WS_H + 8 * 50 * MiB <= WS_END && WS_AO == WS_H && WS_YA == WS_Q && WS_MG == WS_U, "workspace map");
constexpr size_t CTL_ZERO_BYTES = 64 * 1024;
constexpr int CW_BAR = 4096;
constexpr int RING_OFF = 0, RING_BYTES = 131072, EPI_OFF = RING_BYTES, LDS_BYTES = 163840, LDSCTL_OFF = LDS_BYTES - 512, MISC_OFF = LDSCTL_OFF + 320;
static_assert(EPI_OFF + NWAVES * pg8::EPI_WAVE_BYTES <= LDSCTL_OFF && (CW_BAR + XB_WORDS_END) * 4 <= (int)CTL_ZERO_BYTES, "LDS / control-word map");

typedef pg8::u32x4 u32x4;
typedef float f32x16 __attribute__((ext_vector_type(16)));
typedef short s16x4 __attribute__((ext_vector_type(4)));
typedef unsigned u32x2 __attribute__((ext_vector_type(2)));
typedef float f32x2v __attribute__((ext_vector_type(2)));

template <int CTRL> __device__ __forceinline__ float dpp_mov(float v) { return __builtin_bit_cast(float, __builtin_amdgcn_update_dpp(0, __builtin_bit_cast(int, v), CTRL, 0xf, 0xf, true)); }
__device__ __forceinline__ float wave_allsum(float v) {
    v += dpp_mov<0xB1>(v); v += dpp_mov<0x4E>(v); v += dpp_mov<0x124>(v); v += dpp_mov<0x128>(v);
    { auto r = __builtin_amdgcn_permlane16_swap(__float_as_uint(v), __float_as_uint(v), false, false); v = __uint_as_float(r[0]) + __uint_as_float(r[1]); }
    { auto r = __builtin_amdgcn_permlane32_swap(__float_as_uint(v), __float_as_uint(v), false, false); v = __uint_as_float(r[0]) + __uint_as_float(r[1]); }
    return v;
}
__device__ __forceinline__ float xhalf_max(float v) { auto r = __builtin_amdgcn_permlane32_swap(__float_as_uint(v), __float_as_uint(v), false, false); return fmaxf(__uint_as_float(r[0]), __uint_as_float(r[1])); }
__device__ __forceinline__ float xhalf_sum(float v) { auto r = __builtin_amdgcn_permlane32_swap(__float_as_uint(v), __float_as_uint(v), false, false); return __uint_as_float(r[0]) + __uint_as_float(r[1]); }

struct Frame {
    LAS unsigned char* lds;
    volatile LAS unsigned* MISC;
    gu32* ctl;
    int wave, vcu, G;
    __device__ __forceinline__ int lane_() const { return pg8::lane_id(); }
    __device__ __forceinline__ int tid_() const { return (wave << 6) | pg8::lane_id(); }
};
struct Args { const float* in[23]; float* out; unsigned char* ws; int ph_lo, ph_hi, use_bar, pad; };

__device__ __forceinline__ void p0_transpose_item(const float* W, int K, int N, bf16* WT, int kind, LAS float* scr, int item, int lane) {
    const int nblk = N / 32, kb = item / nblk, nb = item % nblk, k0 = 64 * kb, n0 = 32 * nb;
    int drow = n0;
    if (kind == 1 || kind == 2) drow = 256 * (n0 >> 7) + 128 * (kind - 1) + (n0 & 127);
    else if (kind == 3) { if (n0 >= 1280 && n0 < 2304) { const int r = n0 - 1280; drow = 1280 + 256 * (r >> 7) + (r & 127); } else if (n0 >= 2304 && n0 < 3328) { const int r = n0 - 2304; drow = 1280 + 256 * (r >> 7) + 128 + (r & 127); } }
    float v[32];
#pragma unroll
    for (int i = 0; i < 32; ++i) v[i] = W[(size_t)(k0 + 2 * i + (lane >> 5)) * N + n0 + (lane & 31)];
#pragma unroll
    for (int i = 0; i < 32; ++i) scr[(2 * i + (lane >> 5)) * 33 + (lane & 31)] = v[i];
    LDS_WAIT(); asm volatile("" ::: "memory");
    const int c = lane & 7;
#pragma unroll
    for (int j = 0; j < 4; ++j) { const int n = (lane >> 3) + 8 * j; const LAS float* s = scr + (8 * c) * 33 + n;
        v4u o; o.x = pk2(s[0 * 33], s[1 * 33]); o.y = pk2(s[2 * 33], s[3 * 33]); o.z = pk2(s[4 * 33], s[5 * 33]); o.w = pk2(s[6 * 33], s[7 * 33]);
        *(GAS v4u*)(WT + (size_t)(drow + n) * K + k0 + 8 * c) = o; }
    LDS_WAIT(); asm volatile("" ::: "memory");
}
__device__ __forceinline__ void p0_prologue(Frame& F, const Args& a) {
    unsigned char* ws = a.ws;
    if (F.vcu < NMODW / 64) {
        LAS float* cact = (LAS float*)(F.lds);
        LAS float* red = (LAS float*)(F.lds + 65536);
        const float* c = a.in[1];
        for (int e = F.tid_(); e < BATCH * DM; e += NWAVES * 64) { const int b = e >> 10, k = e & 1023; const float v = c[e]; cact[k * 16 + b] = v / (1.f + __expf(-v)); }
        __syncthreads();
        const int col = F.vcu * 64 + F.lane_(); const float* w = a.in[2] + col;
        float acc[16];
#pragma unroll
        for (int b = 0; b < 16; ++b) acc[b] = 0.f;
        const int kbeg = F.wave * 128;
#pragma unroll 1
        for (int k = kbeg; k < kbeg + 128; k += 32) {
            float wv[32];
#pragma unroll
            for (int j = 0; j < 32; ++j) wv[j] = w[(size_t)(k + j) * NMODW];
#pragma unroll
            for (int j = 0; j < 32; ++j) { const LAS f32x4* cp = (const LAS f32x4*)(cact + (k + j) * 16);
#pragma unroll
                for (int q = 0; q < 4; ++q) { const f32x4 cv = cp[q]; acc[4 * q] += cv[0] * wv[j]; acc[4 * q + 1] += cv[1] * wv[j]; acc[4 * q + 2] += cv[2] * wv[j]; acc[4 * q + 3] += cv[3] * wv[j]; } } }
#pragma unroll
        for (int b = 0; b < 16; ++b) red[(F.wave * 16 + b) * 64 + F.lane_()] = acc[b];
        __syncthreads();
        float* mod = (float*)(ws + WS_MOD);
        for (int e = F.tid_(); e < 16 * 64; e += NWAVES * 64) { const int b = e >> 6, cl = e & 63; float s = a.in[3][F.vcu * 64 + cl];
#pragma unroll
            for (int wv = 0; wv < 8; ++wv) s += red[(wv * 16 + b) * 64 + cl];
            mod[(size_t)b * NMODW + F.vcu * 64 + cl] = s; }
        __syncthreads();
    }
    LAS float* scr = (LAS float*)(F.lds + RING_OFF + F.wave * 16384);
    const int gw = F.vcu * NWAVES + F.wave, NGW = F.G * NWAVES;
    constexpr int I_GU = (DM / 64) * (FF / 32), I_D = (FF / 64) * (DM / 32), I_IN = (DM / 64) * (NIN / 32), I_SQ = (DM / 64) * (DM / 32);
    constexpr int NITEMS = 4 * I_GU + 2 * I_D + I_IN + 3 * I_SQ;
    static_assert(NITEMS == (256 - NMODW / 64) * NWAVES * 9 + (NMODW / 64) * NWAVES * 4, "item split");
    const bool split = (F.G == 256), late = F.vcu < NMODW / 64;
    const int n_early = (256 - NMODW / 64) * NWAVES, n_late = (NMODW / 64) * NWAVES;
    const int it0 = !split ? gw : (late ? n_early * 9 + gw : gw - n_late), its = !split ? NGW : (late ? n_late : n_early), itend = !split ? NITEMS : (late ? NITEMS : n_early * 9);
    for (int it = it0; it < itend; it += its) {
        int r = it;
        if (r < I_GU) { p0_transpose_item(a.in[5], DM, FF, (bf16*)(ws + WS_WGU1), 1, scr, r, F.lane_()); continue; } r -= I_GU;
        if (r < I_GU) { p0_transpose_item(a.in[6], DM, FF, (bf16*)(ws + WS_WGU1), 2, scr, r, F.lane_()); continue; } r -= I_GU;
        if (r < I_D) { p0_transpose_item(a.in[7], FF, DM, (bf16*)(ws + WS_WD1), 0, scr, r, F.lane_()); continue; } r -= I_D;
        if (r < I_IN) { p0_transpose_item(a.in[9], DM, NIN, (bf16*)(ws + WS_WIN), 3, scr, r, F.lane_()); continue; } r -= I_IN;
        if (r < I_SQ) { p0_transpose_item(a.in[11], DM, DM, (bf16*)(ws + WS_WAO), 0, scr, r, F.lane_()); continue; } r -= I_SQ;
        if (r < I_SQ) { p0_transpose_item(a.in[16], DM, DM, (bf16*)(ws + WS_WCO), 0, scr, r, F.lane_()); continue; } r -= I_SQ;
        if (r < I_SQ) { p0_transpose_item(a.in[17], DM, DM, (bf16*)(ws + WS_WOUT), 0, scr, r, F.lane_()); continue; } r -= I_SQ;
        if (r < I_GU) { p0_transpose_item(a.in[19], DM, FF, (bf16*)(ws + WS_WGU2), 1, scr, r, F.lane_()); continue; } r -= I_GU;
        if (r < I_GU) { p0_transpose_item(a.in[20], DM, FF, (bf16*)(ws + WS_WGU2), 2, scr, r, F.lane_()); continue; } r -= I_GU;
        p0_transpose_item(a.in[21], FF, DM, (bf16*)(ws + WS_WD2), 0, scr, r, F.lane_());
    }
}

__device__ __forceinline__ void add_bf16x4(f32x4& v, u32x2 w) { v[0] += __uint_as_float(w.x << 16); v[1] += __uint_as_float(w.x & 0xffff0000u); v[2] += __uint_as_float(w.y << 16); v[3] += __uint_as_float(w.y & 0xffff0000u); }
template <int MODE, int NY, bool XBF, bool SNAP>
__device__ __forceinline__ void norm_phase(Frame& F, const float* xin, const bf16* xb, const bf16* y1, const bf16* y2, const bf16* y3, bf16* snap, const float* g, const float* mod, int shift_idx, bf16* H, float* out) {
    const int gw = F.vcu * NWAVES + F.wave, NGW = F.G * NWAVES, lane = F.lane_();
    for (int ch = gw; ch < M / 16; ch += NGW) {
        const int b = (ch * 16) / SEQ;
        f32x4 A[4], Bv[4];
#pragma unroll
        for (int j = 0; j < 4; ++j) { const int c = 4 * lane + 256 * j; A[j] = *(const f32x4*)(g + c);
            if (MODE == 0) { const float* sh = mod + (size_t)b * NMODW + shift_idx * DM + c; A[j] = A[j] * (*(const f32x4*)(sh + DM) + 1.0f); Bv[j] = *(const f32x4*)sh; } }
#pragma unroll 2
        for (int r = 0; r < 16; ++r) {
            const size_t row = (size_t)ch * 16 + r;
            f32x4 v[4]; u32x2 d0[4], d1[4], d2[4], d3[4];
#pragma unroll
            for (int j = 0; j < 4; ++j) {
                if (XBF) d0[j] = ((const GAS u32x2*)(xb + row * DM) + lane)[64 * j]; else v[j] = ((const GAS f32x4*)(xin + row * DM) + lane)[64 * j];
                if (NY >= 1) d1[j] = ((const GAS u32x2*)(y1 + row * DM) + lane)[64 * j];
                if (NY >= 2) d2[j] = ((const GAS u32x2*)(y2 + row * DM) + lane)[64 * j];
                if (NY >= 3) d3[j] = ((const GAS u32x2*)(y3 + row * DM) + lane)[64 * j]; }
            float s = 0.f;
#pragma unroll
            for (int j = 0; j < 4; ++j) { if (XBF) { v[j] = (f32x4){0.f, 0.f, 0.f, 0.f}; add_bf16x4(v[j], d0[j]); }
                if (NY >= 1) add_bf16x4(v[j], d1[j]); if (NY >= 2) add_bf16x4(v[j], d2[j]); if (NY >= 3) add_bf16x4(v[j], d3[j]);
                s += (v[j][0] * v[j][0] + v[j][1] * v[j][1]) + (v[j][2] * v[j][2] + v[j][3] * v[j][3]); }
            const float rs = rsqrtf(wave_allsum(s) * (1.f / DM) + EPS);
            if (SNAP) { GAS u32x2* o8 = (GAS u32x2*)(snap + row * DM) + lane;
#pragma unroll
                for (int j = 0; j < 4; ++j) { u32x2 w; w.x = pg8::cvt_pk_bf16(v[j][0], v[j][1]); w.y = pg8::cvt_pk_bf16(v[j][2], v[j][3]); o8[64 * j] = w; } }
            if (MODE == 0) {
                GAS u32x2* o8 = (GAS u32x2*)(H + row * DM) + lane;
#pragma unroll
                for (int j = 0; j < 4; ++j) { const f32x4 hv = v[j] * rs * A[j] + Bv[j]; u32x2 w; w.x = pg8::cvt_pk_bf16(hv[0], hv[1]); w.y = pg8::cvt_pk_bf16(hv[2], hv[3]); o8[64 * j] = w; }
            } else {
                GAS f32x4* o = (GAS f32x4*)(out + row * DM) + lane;
#pragma unroll
                for (int j = 0; j < 4; ++j) o[64 * j] = v[j] * rs * A[j];
            }
        }
    }
}

constexpr int AT_KROW = 144, AT_V_OFF = 256 * AT_KROW;
__device__ __forceinline__ int crow(int r, int h) { return (r & 3) + 8 * (r >> 2) + 4 * h; }
typedef short v4i16_t __attribute__((ext_vector_type(4)));
__device__ __forceinline__ s16x4 ld_tr16(const LAS unsigned char* p) { return __builtin_bit_cast(s16x4, __builtin_amdgcn_ds_read_tr16_b64_v4i16((LAS v4i16_t*)p)); }
template <class UnitMap>
__device__ __forceinline__ void attn_phase(Frame& F, int first, int stride, int nunits, const UnitMap& umap, const bf16* Q, const bf16* Kb, const bf16* Vb, const float* sinks, bf16* AO) {
    LAS unsigned char* lds = F.lds;
    const int tid = F.tid_(), lane = F.lane_(), r32 = lane & 31, h = lane >> 5;
    if (first >= nunits) return;
    const int sj0 = tid >> 3, c8 = tid & 7;
    u32x4 kr[4], vr[4];
#define AT_LOAD(b_, n_, kvh_) do { const long band0_ = (long)(b_) * SEQ + (long)((n_) - 1) * 128; \
        _Pragma("unroll") for (int i = 0; i < 4; ++i) { const int sj = sj0 + 64 * i; kr[i] = (u32x4){0u, 0u, 0u, 0u}; vr[i] = kr[i]; \
            if ((n_) > 0 || sj >= 128) { const size_t off = (size_t)(band0_ + sj) * 128 + (kvh_) * 64 + c8 * 8; kr[i] = *(const GAS u32x4*)(Kb + off); vr[i] = *(const GAS u32x4*)(Vb + off); } } } while (0)
    int b, n, kvh; umap(first, b, n, kvh);
    AT_LOAD(b, n, kvh);
    const float NEG = -1.0e30f;
    const int tr_off = ((lane & 15) >> 2) * AT_KROW + (16 * ((lane >> 4) & 1) + 4 * (lane & 3)) * 2 + 4 * h * AT_KROW;
    for (int u = first; u < nunits; u += stride) {
        const int hq = kvh * 8 + F.wave;
        const bf16* qbase = Q + ((size_t)b * SEQ + n * 128 + r32) * 1024 + hq * 64 + 8 * h;
        bf16x8 qr[4];
#pragma unroll
        for (int ks = 0; ks < 4; ++ks) qr[ks] = *(const GAS bf16x8*)(qbase + 16 * ks);
#pragma unroll
        for (int i = 0; i < 4; ++i) { const int sj = sj0 + 64 * i; *(LAS u32x4*)(lds + sj * AT_KROW + c8 * 16) = kr[i]; *(LAS u32x4*)(lds + AT_V_OFF + sj * AT_KROW + c8 * 16) = vr[i]; }
        __syncthreads();
        const float sink = sinks[hq] * 1.4426950408889634f;
        const bool first_blk = (n == 0);
        const size_t tok0 = (size_t)b * SEQ + n * 128 + r32;
        int nb = b, nn = n, nk = kvh;
        if (u + stride < nunits) { umap(u + stride, nb, nn, nk); AT_LOAD(nb, nn, nk); }
#pragma unroll 1
        for (int j = 0; j < 4; ++j) {
            bf16x8 qn[4];
            { const bf16* qp = qbase + (size_t)(j < 3 ? j + 1 : j) * 32 * 1024;
#pragma unroll
              for (int ks = 0; ks < 4; ++ks) qn[ks] = *(const GAS bf16x8*)(qp + 16 * ks); }
            f32x16 S[5];
#pragma unroll
            for (int kbi = 0; kbi < 5; ++kbi) {
                f32x16 acc = {0.f, 0.f, 0.f, 0.f, 0.f, 0.f, 0.f, 0.f, 0.f, 0.f, 0.f, 0.f, 0.f, 0.f, 0.f, 0.f};
                const LAS unsigned char* kp = lds + (32 * (j + kbi) + r32) * AT_KROW + 16 * h;
#pragma unroll
                for (int ks = 0; ks < 4; ++ks) { const bf16x8 kf = *(const LAS bf16x8*)(kp + 32 * ks); acc = __builtin_amdgcn_mfma_f32_32x32x16_bf16(kf, qr[ks], acc, 0, 0, 0); }
                S[kbi] = acc;
            }
#pragma unroll
            for (int r = 0; r < 16; ++r) { const int cr = crow(r, h); S[0][r] = (cr > r32) ? S[0][r] : NEG; S[4][r] = (cr <= r32) ? S[4][r] : NEG; }
            if (first_blk) {
#pragma unroll
                for (int kbi = 0; kbi < 4; ++kbi) if (j + kbi < 4) {
#pragma unroll
                    for (int r = 0; r < 16; ++r) S[kbi][r] = NEG; }
            }
            float mx = sink;
#pragma unroll
            for (int kbi = 0; kbi < 5; ++kbi)
#pragma unroll
                for (int r = 0; r < 16; r += 2) mx = fmaxf(fmaxf(mx, S[kbi][r]), S[kbi][r + 1]);
            mx = xhalf_max(mx);
            float l0 = 0.f, l1 = 0.f;
#pragma unroll
            for (int kbi = 0; kbi < 5; ++kbi)
#pragma unroll
                for (int r = 0; r < 16; r += 2) { const float p0 = __builtin_amdgcn_exp2f(S[kbi][r] - mx), p1 = __builtin_amdgcn_exp2f(S[kbi][r + 1] - mx); S[kbi][r] = p0; S[kbi][r + 1] = p1; l0 += p0; l1 += p1; }
            const float l = xhalf_sum(l0 + l1) + __builtin_amdgcn_exp2f(sink - mx);
            const float inv = 1.0f / l;
            f32x16 o0 = {0.f, 0.f, 0.f, 0.f, 0.f, 0.f, 0.f, 0.f, 0.f, 0.f, 0.f, 0.f, 0.f, 0.f, 0.f, 0.f}, o1 = o0;
#pragma unroll
            for (int kbi = 0; kbi < 5; ++kbi)
#pragma unroll
                for (int s2 = 0; s2 < 2; ++s2) {
                    u32x4 pw; pw.x = pg8::cvt_pk_bf16(S[kbi][8 * s2 + 0], S[kbi][8 * s2 + 1]); pw.y = pg8::cvt_pk_bf16(S[kbi][8 * s2 + 2], S[kbi][8 * s2 + 3]);
                    pw.z = pg8::cvt_pk_bf16(S[kbi][8 * s2 + 4], S[kbi][8 * s2 + 5]); pw.w = pg8::cvt_pk_bf16(S[kbi][8 * s2 + 6], S[kbi][8 * s2 + 7]);
                    const bf16x8 pf = __builtin_bit_cast(bf16x8, pw);
                    const LAS unsigned char* vp = lds + AT_V_OFF + (32 * (j + kbi) + 16 * s2) * AT_KROW + tr_off;
                    const s16x4 a0 = ld_tr16(vp), a1 = ld_tr16(vp + 8 * AT_KROW), c0 = ld_tr16(vp + 64), c1 = ld_tr16(vp + 8 * AT_KROW + 64);
                    const bf16x8 vf0 = __builtin_shufflevector(a0, a1, 0, 1, 2, 3, 4, 5, 6, 7), vf1 = __builtin_shufflevector(c0, c1, 0, 1, 2, 3, 4, 5, 6, 7);
                    o0 = __builtin_amdgcn_mfma_f32_32x32x16_bf16(vf0, pf, o0, 0, 0, 0);
                    o1 = __builtin_amdgcn_mfma_f32_32x32x16_bf16(vf1, pf, o1, 0, 0, 0);
                }
            bf16* orow = AO + (tok0 + 32 * j) * 1024 + hq * 64 + 4 * h;
#pragma unroll
            for (int g4 = 0; g4 < 4; ++g4) {
                u32x2 w0, w1;
                w0.x = pg8::cvt_pk_bf16(o0[4 * g4] * inv, o0[4 * g4 + 1] * inv); w0.y = pg8::cvt_pk_bf16(o0[4 * g4 + 2] * inv, o0[4 * g4 + 3] * inv);
                w1.x = pg8::cvt_pk_bf16(o1[4 * g4] * inv, o1[4 * g4 + 1] * inv); w1.y = pg8::cvt_pk_bf16(o1[4 * g4 + 2] * inv, o1[4 * g4 + 3] * inv);
                *(GAS u32x2*)(orow + 8 * g4) = w0; *(GAS u32x2*)(orow + 32 + 8 * g4) = w1;
            }
#pragma unroll
            for (int ks = 0; ks < 4; ++ks) qr[ks] = qn[ks];
        }
        __syncthreads();
        b = nb; n = nn; kvh = nk;
    }
#undef AT_LOAD
}
struct AttnMapFlat { __device__ __forceinline__ void operator()(int u, int& b, int& n, int& kvh) const { kvh = u & 1; n = (u >> 1) & 15; b = u >> 5; } };
struct AttnMapGroup { int g; __device__ __forceinline__ void operator()(int li, int& b, int& n, int& kvh) const { kvh = li & 1; n = (li >> 1) & 15; b = 2 * g + (li >> 5); } };

#ifndef CVG_TOK
#define CVG_TOK 8
#endif
constexpr int CV_T = 32, CV_ROWS = CV_T + 30, CVG = 8;
constexpr int CV_YOFF = CV_ROWS * 2048;
static_assert(CV_YOFF + CVG * 4096 <= LDSCTL_OFF && CVG == NWAVES, "conv LDS map");
__device__ __forceinline__ void conv_phase(Frame& F, int first, int stride, int nunits, const bf16* U, const float* wdw, const float* bdw, const float* lng, const float* lnb, bf16* CA) {
    LAS unsigned char* lds = F.lds;
    const int tid = F.tid_(), lane = F.lane_();
    if (first >= nunits) return;
    float w0[31], w1[31];
#pragma unroll
    for (int k = 0; k < 31; ++k) { const f32x2v wv = *(const GAS f32x2v*)(wdw + k * 1024 + 2 * tid); w0[k] = wv[0]; w1[k] = wv[1]; }
    const f32x2v bv = *(const GAS f32x2v*)(bdw + 2 * tid);
    f32x4 lg[4], lb[4];
#pragma unroll
    for (int q = 0; q < 4; ++q) { const int c = (q >> 1) * 512 + 8 * lane + 4 * (q & 1); lg[q] = *(const GAS f32x4*)(lng + c); lb[q] = *(const GAS f32x4*)(lnb + c); }
    u32x4 R[16];
    const int r0 = tid >> 7;
    int tbase = r0 * 2048 + (tid & 127) * 16;
#define CV_LOAD(cu_) do { const long m0_ = (long)(cu_) * CV_T; const int t0_ = (int)(m0_ % SEQ); asm volatile("" : "+v"(tbase)); \
        const unsigned char* gb_ = (const unsigned char*)U + (m0_ - 30) * 2048 + tbase; \
        _Pragma("unroll") for (int i = 0; i < 16; ++i) { R[i] = (u32x4){0u, 0u, 0u, 0u}; \
            if ((i < 15 || r0 < 2) && t0_ - 30 + r0 + 4 * i >= 0) R[i] = *(const GAS u32x4*)(gb_ + i * 8192); } } while (0)
#define CV_WRITE() do { asm volatile("" : "+v"(tbase)); _Pragma("unroll") for (int i = 0; i < 16; ++i) { if (i < 15 || r0 < 2) *(LAS u32x4*)(lds + tbase + i * 8192) = R[i]; } } while (0)
    CV_LOAD(first); CV_WRITE();
    __syncthreads();
    for (int cu = first; cu < nunits; cu += stride) {
        const long m0 = (long)cu * CV_T;
        const bool more = cu + stride < nunits;
        if (more) CV_LOAD(cu + stride);
#pragma unroll 1
        for (int gq = 0; gq < CV_T / CVG; ++gq) {
            float y0[CVG], y1[CVG];
            const LAS unsigned char* wp = lds + gq * CVG * 2048 + tid * 4;
#pragma unroll
            for (int t = 0; t < CVG; ++t) { y0[t] = bv[0]; y1[t] = bv[1]; }
#pragma unroll
            for (int i = 0; i < CVG + 30; ++i) {
                const unsigned uu = *(const LAS unsigned*)(wp + i * 2048);
                const float u0 = __uint_as_float(uu << 16), u1 = __uint_as_float(uu & 0xffff0000u);
#pragma unroll
                for (int t = 0; t < CVG; ++t) { const int k = i - t; if (k >= 0 && k < 31) { y0[t] += w0[k] * u0; y1[t] += w1[k] * u1; } }
            }
#pragma unroll
            for (int t = 0; t < CVG; ++t) *(LAS f32x2v*)(lds + CV_YOFF + t * 4096 + tid * 8) = (f32x2v){y0[t], y1[t]};
            __syncthreads();
            {
                const LAS f32x4* yp = (const LAS f32x4*)(lds + CV_YOFF + F.wave * 4096 + lane * 32);
                f32x4 v[4]; v[0] = yp[0]; v[1] = yp[1]; v[2] = yp[128]; v[3] = yp[129];
                float sm = 0.f, sq = 0.f;
#pragma unroll
                for (int q = 0; q < 4; ++q) { sm += (v[q][0] + v[q][1]) + (v[q][2] + v[q][3]); sq += (v[q][0] * v[q][0] + v[q][1] * v[q][1]) + (v[q][2] * v[q][2] + v[q][3] * v[q][3]); }
                sm = wave_allsum(sm); sq = wave_allsum(sq);
                const float mean = sm * (1.f / DM), rs = rsqrtf(fmaxf(sq * (1.f / DM) - mean * mean, 0.f) + EPS);
#pragma unroll
                for (int q = 0; q < 4; ++q) { const f32x4 a = (v[q] - mean) * rs * lg[q] + lb[q]; v[q] = a * pg8::sigm4(a); }
                bf16* orow = CA + (size_t)(m0 + gq * CVG + F.wave) * 1024 + 8 * lane;
                *(GAS u32x4*)orow = pg8::pack8(v[0], v[1]); *(GAS u32x4*)(orow + 512) = pg8::pack8(v[2], v[3]);
            }
            __syncthreads();
        }
        if (more) { CV_WRITE(); __syncthreads(); }
    }
#undef CV_LOAD
#undef CV_WRITE
}

__global__ void __launch_bounds__(NWAVES * 64, 2) mk_fwd(Args args) {
    extern __shared__ __attribute__((aligned(16))) unsigned char lds[];
    Frame F;
    F.lds = (LAS unsigned char*)lds;
    F.MISC = (volatile LAS unsigned*)(F.lds + MISC_OFF);
    F.wave = __builtin_amdgcn_readfirstlane((int)threadIdx.x >> 6);
    F.G = gridDim.x; { const int bx = blockIdx.x; F.vcu = (F.G % 8 == 0) ? (bx % 8) * (F.G / 8) + bx / 8 : bx; }
    unsigned char* ws = args.ws;
    F.ctl = (gu32*)(ws + WS_CTL);
    for (int u = F.tid_(); u < 512 / 4; u += NWAVES * 64) ((LAS unsigned*)(F.lds + LDSCTL_OFF))[u] = 0u;
    __syncthreads();
    XcdBarrier bar; bar.bar = (unsigned*)(F.ctl + CW_BAR); bar.x = 0; bar.st = nullptr; bar.wave = F.wave;
    if (args.use_bar) bar = xcd_barrier_post((unsigned*)(F.ctl + CW_BAR), F.MISC + 8, F.wave);
    const int lo = args.ph_lo, hi = args.ph_hi;
#ifndef PHM
#define PHM 0x3FFF
#endif
#define IN(k) (((PHM >> (k)) & 1) && lo <= (k) && (k) < hi)
#define SEAM(k) do { if (IN(k) && IN((k) + 1)) { if (local_mode) xcc_local_barrier(bar); else xcd_barrier(bar); } } while (0)
    int local_mode = 0, vbx = (int)blockIdx.x;

    const float* x = args.in[0]; float* out = args.out;
    LAS unsigned char* escr = F.lds + EPI_OFF + F.wave * pg8::EPI_WAVE_BYTES;
    float* mod = (float*)(ws + WS_MOD);
    int grp = -1;
#define BUF(name, flat_off, slab_off, pitch) bf16* name = (gq < 0) ? (bf16*)(ws + (flat_off)) : (bf16*)(ws + WS_H + (size_t)gq * (50 * MiB) + (slab_off)) - (size_t)gq * 4096 * (pitch)
#define GATES() bf16* GA = (gq < 0) ? (bf16*)out : (bf16*)((unsigned char*)out + (size_t)gq * (16 * MiB)) - (size_t)gq * 4096 * 1024; bf16* GC = (gq < 0) ? GA + (size_t)M * DM : GA + 4096 * 1024
#define GRP() int gq = grp; asm volatile("" : "+s"(gq))
#define B_H()   BUF(H,   WS_H,   0 * MiB,  1024)
#define B_Y1()  BUF(Y1,  WS_Y1,  8 * MiB,  1024)
#define B_Y2()  BUF(Y2,  WS_Y2,  16 * MiB, 1024)
#define B_ACT() BUF(ACT, WS_ACT, 24 * MiB, FF)
#define B_Q()   BUF(Qb,  WS_Q,   24 * MiB, 1024)
#define B_K()   BUF(Kb,  WS_K,   32 * MiB, 128)
#define B_V()   BUF(Vb,  WS_V,   33 * MiB, 128)
#define B_U()   BUF(Ub,  WS_U,   34 * MiB, 1024)
#define B_CA()  BUF(CA,  WS_CA,  42 * MiB, 1024)

    if (IN(0)) { p0_prologue(F, args); } SEAM(0);
    if (args.use_bar && IN(0) && IN(1)) {
#ifdef FORCE_GLOBAL_SEAMS
        if (F.wave == 0 && pg8::lane_id() == 0) F.MISC[11] = 0u;
#else
        if (F.wave == 0 && pg8::lane_id() == 0) F.MISC[11] = xcc_regular(bar.bar);
#endif
        __syncthreads();
        local_mode = __builtin_amdgcn_readfirstlane((int)F.MISC[11]);
        if (local_mode) { const int rank = __builtin_amdgcn_readfirstlane((int)F.MISC[10]) - 1; vbx = 8 * rank + (int)bar.x; F.vcu = 32 * (int)bar.x + rank; grp = (int)bar.x; }
    }
    if (IN(1)) { GRP(); B_H(); norm_phase<0, 0, false, false>(F, x, nullptr, nullptr, nullptr, nullptr, nullptr, args.in[4], mod, 0, H, nullptr); } SEAM(1);
    if (IN(2)) { GRP(); B_H(); B_ACT(); pg8::Gemm g{H, (const bf16*)(ws + WS_WGU1), M, 2 * FF, DM, F.wave}; pg8::StaticOrder S; S.init(M, 2 * FF, F.G, vbx);
        pg8::EpiSwiGLU E{ACT, FF};
        pg8::gemm_phase<pg8::EpiSwiGLU, pg8::StaticOrder, true, true>(F.lds + RING_OFF, g, S, E); } SEAM(2);
    if (IN(3)) { GRP(); B_ACT(); B_Y1(); pg8::Gemm g{ACT, (const bf16*)(ws + WS_WD1), M, DM, FF, F.wave}; pg8::StaticOrder S; S.init(M, DM, F.G, vbx);
        typedef pg8::EpiDelta<NMODW, SEQ / 256, 1> EpiD; EpiD E{Y1, mod + 2 * DM, escr};
        pg8::gemm_phase<EpiD, pg8::StaticOrder, true, true>(F.lds + RING_OFF, g, S, E); } SEAM(3);
    if (IN(4)) { GRP(); B_H(); B_Y1(); norm_phase<0, 1, false, true>(F, x, nullptr, Y1, nullptr, nullptr,   Y1, args.in[8], mod, 3, H, nullptr); } SEAM(4);
    if (IN(5)) { GRP(); B_H(); B_Q(); B_K(); B_V(); B_U(); GATES(); pg8::Gemm g{H, (const bf16*)(ws + WS_WIN), M, NIN, DM, F.wave}; pg8::StaticOrder S; S.init(M, NIN, F.G, vbx);
        pg8::EpiIn E{Qb, Kb, Vb, Ub, GA, GC, escr};
        pg8::gemm_phase<pg8::EpiIn, pg8::StaticOrder, true, true>(F.lds + RING_OFF, g, S, E); } SEAM(5);
    if (IN(6)) { GRP(); B_Q(); B_K(); B_V(); B_U(); B_CA(); BUF(AO, WS_AO, 0 * MiB, 1024);
        if (local_mode) attn_phase(F, F.vcu & 31, 32, 64, AttnMapGroup{F.vcu >> 5}, Qb, Kb, Vb, args.in[10], AO);
        else attn_phase(F, F.vcu, F.G, BATCH * 16 * 2, AttnMapFlat{}, Qb, Kb, Vb, args.in[10], AO);
        if (local_mode) conv_phase(F, 128 * (F.vcu >> 5) + (F.vcu & 31), 32, 128 * (F.vcu >> 5) + 128, Ub, args.in[12], args.in[13], args.in[14], args.in[15], CA);
        else conv_phase(F, F.vcu, F.G, M / CV_T, Ub, args.in[12], args.in[13], args.in[14], args.in[15], CA);
    } SEAM(6);
    if (IN(7)) { GRP(); BUF(AO, WS_AO, 0 * MiB, 1024); BUF(YA, WS_YA, 24 * MiB, 1024); GATES(); (void)GC; pg8::Gemm g{AO, (const bf16*)(ws + WS_WAO), M, DM, DM, F.wave}; pg8::StaticOrder S; S.init(M, DM, F.G, vbx);
        pg8::EpiGate<0> E{GA, nullptr, YA, escr};
        pg8::gemm_phase<pg8::EpiGate<0>, pg8::StaticOrder, true, true>(F.lds + RING_OFF, g, S, E); }
    if (IN(8)) { GRP(); B_CA(); BUF(YA, WS_YA, 24 * MiB, 1024); BUF(MG, WS_MG, 34 * MiB, 1024); GATES(); (void)GA; pg8::Gemm g{CA, (const bf16*)(ws + WS_WCO), M, DM, DM, F.wave}; pg8::StaticOrder S; S.init(M, DM, F.G, vbx);
        pg8::EpiGate<1> E{GC, YA, MG, escr};
        pg8::gemm_phase<pg8::EpiGate<1>, pg8::StaticOrder, true, true>(F.lds + RING_OFF, g, S, E); } SEAM(8);
    if (IN(9)) { GRP(); BUF(MG, WS_MG, 34 * MiB, 1024); B_Y2(); pg8::Gemm g{MG, (const bf16*)(ws + WS_WOUT), M, DM, DM, F.wave}; pg8::StaticOrder S; S.init(M, DM, F.G, vbx);
        typedef pg8::EpiDelta<NMODW, SEQ / 256, 0> EpiD; EpiD E{Y2, mod + 5 * DM, escr};
        pg8::gemm_phase<EpiD, pg8::StaticOrder, true, true>(F.lds + RING_OFF, g, S, E); } SEAM(9);
    if (IN(10)) { GRP(); B_H(); B_Y1(); B_Y2(); norm_phase<0, 1, true, true>(F, nullptr,   Y1, Y2, nullptr, nullptr,   Y2, args.in[18], mod, 6, H, nullptr); } SEAM(10);
    if (IN(11)) { GRP(); B_H(); B_ACT(); pg8::Gemm g{H, (const bf16*)(ws + WS_WGU2), M, 2 * FF, DM, F.wave}; pg8::StaticOrder S; S.init(M, 2 * FF, F.G, vbx);
        pg8::EpiSwiGLU E{ACT, FF};
        pg8::gemm_phase<pg8::EpiSwiGLU, pg8::StaticOrder, true, true>(F.lds + RING_OFF, g, S, E); } SEAM(11);
    if (IN(12)) { GRP(); B_ACT(); BUF(Y3, WS_H, 0 * MiB, 1024); pg8::Gemm g{ACT, (const bf16*)(ws + WS_WD2), M, DM, FF, F.wave}; pg8::StaticOrder S; S.init(M, DM, F.G, vbx);
        typedef pg8::EpiDelta<NMODW, SEQ / 256, 1> EpiD; EpiD E{Y3, mod + 8 * DM, escr};
        pg8::gemm_phase<EpiD, pg8::StaticOrder, true, true>(F.lds + RING_OFF, g, S, E); } SEAM(12);
    if (IN(13)) { GRP(); B_Y2(); BUF(Y3, WS_H, 0 * MiB, 1024); norm_phase<1, 1, true, false>(F, nullptr,   Y2, Y3, nullptr, nullptr, nullptr, args.in[22], nullptr, 0, nullptr, out); }
#undef IN
#undef SEAM
}

#ifndef SPLIT_LAUNCH
#define SPLIT_LAUNCH 0
#endif
extern "C" void kernel_launch(void* const* d_in, const int* in_sizes, int n_in, void* d_out, int out_size, void* d_ws, size_t ws_size, hipStream_t stream) {
    static int grid = 0;
    if (grid == 0) {
        if (n_in != 23 || in_sizes[0] != M * DM || out_size != M * DM || ws_size < WS_END) {
            fprintf(stderr, "kernel_launch: unexpected shapes n_in %d in0 %d out %d ws %zu\n", n_in, n_in > 0 ? in_sizes[0] : -1, out_size, ws_size); grid = -1; return; }
        int dev = 0, cus = 0, per_cu = 0;
        if (hipGetDevice(&dev) != hipSuccess || hipDeviceGetAttribute(&cus, hipDeviceAttributeMultiprocessorCount, dev) != hipSuccess) { fprintf(stderr, "kernel_launch: device query failed\n"); grid = -1; return; }
        if (hipFuncSetAttribute((const void*)mk_fwd, hipFuncAttributeMaxDynamicSharedMemorySize, LDS_BYTES) != hipSuccess) { fprintf(stderr, "kernel_launch: hipFuncSetAttribute failed\n"); grid = -1; return; }
        if (hipOccupancyMaxActiveBlocksPerMultiprocessor(&per_cu, (const void*)mk_fwd, NWAVES * 64, LDS_BYTES) != hipSuccess || per_cu < 1) { fprintf(stderr, "kernel_launch: the occupancy query admits %d workgroups per CU for this kernel and LDS size; nothing launched\n", per_cu); (void)hipGetLastError(); grid = -1; return; }
        (void)hipGetLastError();
        grid = cus;
    }
    if (grid < 0) return;
    (void)hipMemsetAsync((unsigned char*)d_ws + WS_CTL, 0, CTL_ZERO_BYTES, stream);
    Args a{};
    for (int i = 0; i < 23; ++i) a.in[i] = (const float*)d_in[i];
    a.out = (float*)d_out; a.ws = (unsigned char*)d_ws;
    if (!SPLIT_LAUNCH) {
        a.ph_lo = 0; a.ph_hi = NPHASE; a.use_bar = 1;
        hipLaunchKernelGGL(mk_fwd, dim3(grid), dim3(NWAVES * 64), LDS_BYTES, stream, a);
        return;
    }
    for (int k = 0; k < NPHASE; ++k) { a.ph_lo = k; a.ph_hi = k + 1; a.use_bar = 0; hipLaunchKernelGGL(mk_fwd, dim3(grid), dim3(NWAVES * 64), LDS_BYTES, stream, a); }
}
```

```cpp
#define PADW 3
#include <hip/hip_runtime.h>
#include <cstdio>
#include <cstdint>

typedef unsigned short bf16_t;
constexpr int BATCH = 16, SEQ = 2048, DM = 1024, M = BATCH * SEQ, FF = 2816, NIN = 5376, NMODW = 9 * DM;
constexpr float EPS = 1e-6f;

__device__ __forceinline__ float bf2f(bf16_t v) { return __uint_as_float(((unsigned)v) << 16); }
__device__ __forceinline__ bf16_t f2bf(float f) { unsigned u = __float_as_uint(f); return (bf16_t)((u + 0x7fffu + ((u >> 16) & 1u)) >> 16); }
__device__ __forceinline__ float sigm(float x) { return 1.f / (1.f + __expf(-x)); }
__device__ __forceinline__ float silu(float x) { return x / (1.f + __expf(-x)); }

constexpr size_t MiB = 1u << 20;
constexpr size_t WS_CTL = 0, WS_MOD = 1 * MiB;
constexpr size_t WS_H = 52 * MiB;
constexpr size_t WS_Y1 = 116 * MiB, WS_Y2 = 180 * MiB;
constexpr size_t WS_ACT = 244 * MiB;
constexpr size_t WS_Q = 244 * MiB;
constexpr size_t WS_K = 308 * MiB;
constexpr size_t WS_V = 316 * MiB;
constexpr size_t WS_U = 324 * MiB;
constexpr size_t WS_CA = 388 * MiB;
constexpr size_t WS_END = 452 * MiB;
constexpr size_t WS_AO = WS_H, WS_YA = WS_Q, WS_MG = WS_U;

namespace pg8 {
#define PG8_LAS __attribute__((address_space(3)))
typedef unsigned short bf16_t;
typedef short bf16x8 __attribute__((ext_vector_type(8)));
typedef float f32x4 __attribute__((ext_vector_type(4)));
typedef unsigned u32x4 __attribute__((ext_vector_type(4)));
constexpr int BM = 256, BK = 64, HALF = 128, HTB = HALF * BK * 2  , STAGE_BYTES = 8 * HTB, NXCD = 8, WGM = 8;

__host__ __device__ __forceinline__ int lds_byte(int r, int c) { const int st = (r >> 4) * 2 + (c >> 5), rr = r & 15, cc = c & 31, ob = rr * 64 + cc * 2; return st * 1024 + (ob ^ (((ob >> 9) & 1) << 5)); }
__host__ __device__ __forceinline__ void stage_rc(int b, int& R, int& C) { const int st = b / 1024, sb = b % 1024, swz = sb ^ (((sb >> 9) & 1) << 5); R = (st >> 1) * 16 + swz / 64; C = (st & 1) * 32 + (swz % 64) / 2; }
__host__ __device__ __forceinline__ int perm32(int rho) { const int n = rho >> 4, i = rho & 15; return 8 * (i >> 2) + 4 * n + (i & 3); }

__device__ __forceinline__ int lane_id() { unsigned z; asm volatile("s_mov_b32 %0, 0" : "=s"(z)); return (int)__builtin_amdgcn_mbcnt_hi(~0u, __builtin_amdgcn_mbcnt_lo(~0u, z)); }
struct Unit { int pm, pn; };
struct Gemm { const bf16_t* A; const bf16_t* Bt; int M, N, K, wave; };

struct StaticOrder {
    int nM, nN, nwg, G, c;
    __host__ __device__ void init(int M, int N, int G_, int c_) { nM = M / BM; nN = N / BM; nwg = nM * nN; G = G_; c = c_; }
    __host__ __device__ bool next(int i, Unit& u) const {
        const long L = (long)i * G + c; if (L >= nwg) return false;
        int wgid = (int)L; { const int q = nwg / NXCD, r = nwg % NXCD, xcd = wgid % NXCD, off = wgid / NXCD; wgid = (xcd < r ? xcd * (q + 1) : r * (q + 1) + (xcd - r) * q) + off; }
        const int nig = WGM * nN, gid = wgid / nig, fm = gid * WGM, gsz = (nM - fm) < WGM ? (nM - fm) : WGM;
        u.pm = fm + ((wgid % nig) % gsz); u.pn = (wgid % nig) / gsz; return true;
    }
    __device__ __forceinline__ void a_ready(const Unit&) const {}
    __device__ __forceinline__ void done(const Unit&) const {}
};

typedef float f32x2 __attribute__((ext_vector_type(2)));
typedef __bf16 bf16x2_t __attribute__((ext_vector_type(2)));
constexpr int EPI_ROWB = 144, EPI_WAVE_BYTES = 16 * EPI_ROWB;
__device__ __forceinline__ unsigned cvt_pk_bf16(float lo, float hi) { f32x2 v = {lo, hi}; bf16x2_t b = __builtin_convertvector(v, bf16x2_t); return __builtin_bit_cast(unsigned, b); }
__device__ __forceinline__ u32x4 pack8(f32x4 a, f32x4 b) { u32x4 w; w.x = cvt_pk_bf16(a[0], a[1]); w.y = cvt_pk_bf16(a[2], a[3]); w.z = cvt_pk_bf16(b[0], b[1]); w.w = cvt_pk_bf16(b[2], b[3]); return w; }
typedef _Float16 f16x2_t __attribute__((ext_vector_type(2)));
__device__ __forceinline__ unsigned cvt_pk_f16(float lo, float hi) { f32x2 v = {lo, hi}; f16x2_t h = __builtin_convertvector(v, f16x2_t); return __builtin_bit_cast(unsigned, h); }
__device__ __forceinline__ u32x4 pack8h(f32x4 a, f32x4 b) { u32x4 w; w.x = cvt_pk_f16(a[0], a[1]); w.y = cvt_pk_f16(a[2], a[3]); w.z = cvt_pk_f16(b[0], b[1]); w.w = cvt_pk_f16(b[2], b[3]); return w; }
__device__ __forceinline__ void unpack8(u32x4 w, f32x4& a, f32x4& b) {
    a[0] = __uint_as_float(w.x << 16); a[1] = __uint_as_float(w.x & 0xffff0000u); a[2] = __uint_as_float(w.y << 16); a[3] = __uint_as_float(w.y & 0xffff0000u);
    b[0] = __uint_as_float(w.z << 16); b[1] = __uint_as_float(w.z & 0xffff0000u); b[2] = __uint_as_float(w.w << 16); b[3] = __uint_as_float(w.w & 0xffff0000u); }
__device__ __forceinline__ float sigm1(float x) { return __builtin_amdgcn_rcpf(1.0f + __builtin_amdgcn_exp2f(x * -1.4426950408889634f)); }
__device__ __forceinline__ f32x4 sigm4(f32x4 x) { f32x4 r; r[0] = sigm1(x[0]); r[1] = sigm1(x[1]); r[2] = sigm1(x[2]); r[3] = sigm1(x[3]); return r; }
template <bool PERM> __device__ __forceinline__ void epi_put(PG8_LAS unsigned char* scr, int fr, int fq, f32x4 v0, f32x4 v1) {
    const int c0 = PERM ? 8 * fq : 4 * fq, c1 = PERM ? 8 * fq + 4 : 16 + 4 * fq;
    *(PG8_LAS f32x4*)(scr + fr * EPI_ROWB + c0 * 4) = v0; *(PG8_LAS f32x4*)(scr + fr * EPI_ROWB + c1 * 4) = v1; }
__device__ __forceinline__ void epi_get8(PG8_LAS unsigned char* scr, int lane, f32x4& a, f32x4& b) {
    PG8_LAS unsigned char* p = scr + (lane >> 2) * EPI_ROWB + (lane & 3) * 32; a = *(PG8_LAS f32x4*)p; b = *(PG8_LAS f32x4*)(p + 16); }
__device__ __forceinline__ f32x4 epi_get4(PG8_LAS unsigned char* scr, int lane, int pass) {
    return *(PG8_LAS f32x4*)(scr + ((lane >> 3) + 8 * pass) * EPI_ROWB + (lane & 7) * 16); }

struct EpiSwiGLU {
    static constexpr bool PERM = true, AFTER_DRAIN = false; static constexpr int NST = 8;
    bf16_t* O; int ldc;
    __device__ __forceinline__ void operator()(const f32x4 (&acc)[2][2][4][2], const Unit& u, int wr, int wc, int fr, int fq) const {
        asm volatile("" : "+v"(fr), "+v"(fq));
        bf16_t* base = O + (size_t)(u.pm * BM + wr * 64 + fr) * ldc + u.pn * HALF + wc * 32 + 8 * fq;
#pragma unroll
        for (int ai = 0; ai < 2; ++ai)
#pragma unroll
            for (int m = 0; m < 4; ++m) {
                const f32x4 g0 = acc[ai][0][m][0], g1 = acc[ai][0][m][1];
                *(u32x4*)(base + (size_t)(ai * HALF + m * 16) * ldc) = pack8(g0 * sigm4(g0) * acc[ai][1][m][0], g1 * sigm4(g1) * acc[ai][1][m][1]); }
    }
};
template <int GLD, int TPB, int HALFCOEF> struct EpiDelta {
    static constexpr bool PERM = true, AFTER_DRAIN = false; static constexpr int NST = 16;
    bf16_t* Y; const float* gate; PG8_LAS unsigned char* scr;
    __device__ __forceinline__ void operator()(const f32x4 (&acc)[2][2][4][2], const Unit& u, int wr, int wc, int fr, int fq) const {
        asm volatile("" : "+v"(fr), "+v"(fq));
        const int lane = fr + 16 * fq, b = u.pm / TPB, col0 = u.pn * BM + wc * 32 + 8 * (lane & 3); const float coef = HALFCOEF ? 0.5f : 1.0f;
        bf16_t* base = Y + (size_t)(u.pm * BM + wr * 64 + (lane >> 2)) * 1024 + col0;
        const float* gp = gate + (size_t)b * GLD + col0;
        const f32x4 g00 = *(const f32x4*)(gp) * coef, g01 = *(const f32x4*)(gp + 4) * coef, g10 = *(const f32x4*)(gp + HALF) * coef, g11 = *(const f32x4*)(gp + HALF + 4) * coef;
#pragma unroll
        for (int ai = 0; ai < 2; ++ai)
#pragma unroll
            for (int m = 0; m < 4; ++m) {
                { epi_put<true>(scr, fr, fq, acc[ai][0][m][0], acc[ai][0][m][1]); f32x4 a, c; epi_get8(scr, lane, a, c);
                  *(u32x4*)(base + (size_t)(ai * HALF + m * 16) * 1024) = pack8(a * g00, c * g01); }
                { epi_put<true>(scr, fr, fq, acc[ai][1][m][0], acc[ai][1][m][1]); f32x4 a, c; epi_get8(scr, lane, a, c);
                  *(u32x4*)(base + (size_t)(ai * HALF + m * 16) * 1024 + HALF) = pack8(a * g10, c * g11); } }
    }
};
struct EpiIn {
    static constexpr bool PERM = true, AFTER_DRAIN = false; static constexpr int NST = 8;
    bf16_t *Q, *K, *V, *U, *GA, *GC; PG8_LAS unsigned char* scr;
    __device__ __forceinline__ void operator()(const f32x4 (&acc)[2][2][4][2], const Unit& u, int wr, int wc, int fr, int fq) const {
        asm volatile("" : "+v"(fr), "+v"(fq));
        const int lane = fr + 16 * fq, pn = u.pn, cw = wc * 32 + 8 * (lane & 3);
        const size_t row0 = (size_t)(u.pm * BM + wr * 64 + (lane >> 2));
        if (pn >= 5 && pn < 13) {
            bf16_t* base = U + row0 * 1024 + (pn - 5) * HALF + cw;
#pragma unroll
            for (int ai = 0; ai < 2; ++ai)
#pragma unroll
                for (int m = 0; m < 4; ++m) {
                    epi_put<true>(scr, fr, fq, acc[ai][0][m][0] * sigm4(acc[ai][1][m][0]), acc[ai][0][m][1] * sigm4(acc[ai][1][m][1]));
                    f32x4 a, b; epi_get8(scr, lane, a, b);
                    *(u32x4*)(base + (size_t)(ai * HALF + m * 16) * 1024) = pack8h(a, b); }
        } else if (pn >= 13) {
            bf16_t* base = (pn < 17 ? GA + (pn - 13) * BM : GC + (pn - 17) * BM) + row0 * 1024 + cw;
#pragma unroll
            for (int ai = 0; ai < 2; ++ai)
#pragma unroll
                for (int m = 0; m < 4; ++m)
#pragma unroll
                    for (int bj = 0; bj < 2; ++bj) {
                        epi_put<true>(scr, fr, fq, sigm4(acc[ai][bj][m][0]), sigm4(acc[ai][bj][m][1]));
                        f32x4 a, b; epi_get8(scr, lane, a, b);
                        *(u32x4*)(base + (size_t)(ai * HALF + m * 16) * 1024 + bj * HALF) = pack8(a, b); }
        } else {
            bf16_t* b0; bf16_t* b1; int ld; float sc;
            if (pn < 4) { b0 = Q + row0 * 1024 + pn * BM + cw; b1 = b0 + HALF; ld = 1024; sc = 0.125f * 1.4426950408889634f;     } else { b0 = K + row0 * 128 + cw; b1 = V + row0 * 128 + cw; ld = 128; sc = 1.0f; }
#pragma unroll
            for (int ai = 0; ai < 2; ++ai)
#pragma unroll
                for (int m = 0; m < 4; ++m)
#pragma unroll
                    for (int bj = 0; bj < 2; ++bj) {
                        epi_put<true>(scr, fr, fq, acc[ai][bj][m][0] * sc, acc[ai][bj][m][1] * sc);
                        f32x4 a, b; epi_get8(scr, lane, a, b);
                        *(u32x4*)((bj ? b1 : b0) + (size_t)(ai * HALF + m * 16) * ld) = pack8(a, b); }
        }
    }
};
template <int MODE> struct EpiGate {
    static constexpr bool PERM = true, AFTER_DRAIN = false; static constexpr int NST = 16;
    const bf16_t* G; const bf16_t* Y; bf16_t* O; PG8_LAS unsigned char* scr;
    __device__ __forceinline__ void operator()(const f32x4 (&acc)[2][2][4][2], const Unit& u, int wr, int wc, int fr, int fq) const {
        asm volatile("" : "+v"(fr), "+v"(fq));
        const int lane = fr + 16 * fq;
        const size_t off0 = (size_t)(u.pm * BM + wr * 64 + (lane >> 2)) * 1024 + u.pn * BM + wc * 32 + 8 * (lane & 3);
#pragma unroll
        for (int ai = 0; ai < 2; ++ai) {
            u32x4 gw[4][2], yw[4][2];
#pragma unroll
            for (int m = 0; m < 4; ++m)
#pragma unroll
                for (int bj = 0; bj < 2; ++bj) { const size_t off = off0 + (size_t)(ai * HALF + m * 16) * 1024 + bj * HALF; gw[m][bj] = *(const u32x4*)(G + off); if (MODE == 1) yw[m][bj] = *(const u32x4*)(Y + off); }
            asm volatile("" ::: "memory");
#pragma unroll
            for (int m = 0; m < 4; ++m)
#pragma unroll
                for (int bj = 0; bj < 2; ++bj) { const size_t off = off0 + (size_t)(ai * HALF + m * 16) * 1024 + bj * HALF;
                    epi_put<true>(scr, fr, fq, acc[ai][bj][m][0], acc[ai][bj][m][1]);
                    f32x4 a, b; epi_get8(scr, lane, a, b);
                    f32x4 g0, g1; unpack8(gw[m][bj], g0, g1);
                    f32x4 v0 = g0 * a, v1 = g1 * b;
                    if (MODE == 1) { f32x4 y0, y1; unpack8(yw[m][bj], y0, y1); v0 += y0; v1 += y1; }
                    *(u32x4*)(O + off) = pack8(v0, v1); }
            asm volatile("" ::: "memory");
        }
    }
};
template <class Epi, class Sched, bool ALIGN_EPI = false, bool SP2 = false>
__device__ __forceinline__ void gemm_phase(PG8_LAS unsigned char* lds, const Gemm g, const Sched& S, const Epi& E) {
    int tid = (g.wave << 6) | lane_id(); asm volatile("" : "+v"(tid));
    const int wid = g.wave, wr = wid >> 2, wc = wid & 3;
    int aoff, boff;
    { const int lane = tid & 63, fr = lane & 15, fq = lane >> 4; aoff = lds_byte(wr * 64 + fr, fq * 8); boff = lds_byte(wc * 32 + fr, fq * 8); }
    const int K = g.K, nt = K / BK;
    unsigned voffA[2], voffB[2];
#pragma unroll
    for (int i = 0; i < 2; ++i) { int R, C; stage_rc(tid * 16 + i * 8192, R, C); const int Rb = Epi::PERM ? ((R & ~31) + perm32(R & 31)) : R;
        voffA[i] = (unsigned)(R * K + C) * 2u; voffB[i] = (unsigned)(Rb * K + C) * 2u; }
    const size_t kstep = (size_t)(BK * 2);
    const size_t hstep = (size_t)HALF * K * 2;
    const size_t tstep = 2 * hstep;
    const unsigned ldsw = (unsigned)wid * 1024u;
#define PG8_SA(b, h) (((b) * 2 + (h)) * HTB)
#define PG8_SB(b, h) ((4 + (b) * 2 + (h)) * HTB)
#define PG8_STAGE(bufoff, gbase, voff) do { _Pragma("unroll") for (int _i = 0; _i < 2; ++_i) \
        __builtin_amdgcn_global_load_lds((const unsigned*)((const char*)(gbase) + (voff)[_i]), (PG8_LAS unsigned*)(lds + (bufoff) + ldsw + _i * 8192), 16, 0, 0); } while (0)
#define PG8_LDA(dst, b, h) do { _Pragma("unroll") for (int m = 0; m < 4; ++m) _Pragma("unroll") for (int k = 0; k < 2; ++k) dst[m][k] = *(const PG8_LAS bf16x8*)(lds + PG8_SA(b, h) + aoff + m * 2048 + k * 1024); } while (0)
#define PG8_LDB(dst, b, h) do { _Pragma("unroll") for (int n = 0; n < 2; ++n) _Pragma("unroll") for (int k = 0; k < 2; ++k) dst[n][k] = *(const PG8_LAS bf16x8*)(lds + PG8_SB(b, h) + boff + n * 2048 + k * 1024); } while (0)
#define PG8_MMA(ai, bj, At, Bt) do { __builtin_amdgcn_s_setprio(1); _Pragma("unroll") for (int m = 0; m < 4; ++m) _Pragma("unroll") for (int n = 0; n < 2; ++n) _Pragma("unroll") for (int k = 0; k < 2; ++k) \
        acc[ai][bj][m][n] = __builtin_amdgcn_mfma_f32_16x16x32_bf16(Bt[n][k], At[m][k], acc[ai][bj][m][n], 0, 0, 0); __builtin_amdgcn_s_setprio(0); } while (0)
#define PG8_WAIT_V(n) asm volatile("s_waitcnt vmcnt(" #n ")" ::: "memory")
#define PG8_WAIT_L(n) asm volatile("s_waitcnt lgkmcnt(" #n ")" ::: "memory")
#define PG8_BAR __builtin_amdgcn_s_barrier()
#define PG8_SCHED __builtin_amdgcn_sched_barrier(0)
    Unit cur, nxt; int ui = 0;
    if (!S.next(0, cur)) return;
    f32x4 acc[2][2][4][2];
#pragma unroll
    for (int a = 0; a < 2; ++a)
#pragma unroll
        for (int b = 0; b < 2; ++b)
#pragma unroll
            for (int m = 0; m < 4; ++m)
#pragma unroll
                for (int n = 0; n < 2; ++n) acc[a][b][m][n] = (f32x4){0.f, 0.f, 0.f, 0.f};
    bf16x8 At[4][2], B0[2][2], B1[2][2];
    const char* cA = (const char*)g.A + (size_t)cur.pm * tstep; const char* cB = (const char*)g.Bt + (size_t)cur.pn * tstep;
    S.a_ready(cur);
    {
        PG8_STAGE(PG8_SB(0, 0), cB, voffB); PG8_STAGE(PG8_SB(0, 1), cB + hstep, voffB); PG8_STAGE(PG8_SA(0, 0), cA, voffA); PG8_STAGE(PG8_SA(0, 1), cA + hstep, voffA);
        if (wr == 1) PG8_BAR;
        PG8_WAIT_V(2); PG8_BAR;
        PG8_STAGE(PG8_SB(1, 0), cB + kstep, voffB); PG8_STAGE(PG8_SA(1, 0), cA + kstep, voffA); PG8_STAGE(PG8_SB(1, 1), cB + hstep + kstep, voffB);
        PG8_WAIT_V(6); PG8_BAR;
    }
    static_assert(SP2 && ALIGN_EPI && !Epi::AFTER_DRAIN && Epi::NST > 0, "this copy of the body keeps only the SP2 + ALIGN_EPI + store-overlap form");
#define PG8_WAIT_VI(n) asm volatile("s_waitcnt vmcnt(%0)" :: "i"(n) : "memory")
#define PG8_TRIP(STG, WV) do { asm volatile("" : "+v"(voffA[0]), "+v"(voffA[1]), "+v"(voffB[0]), "+v"(voffB[1]));     \
            PG8_LDB(B0, 0, 0); PG8_LDB(B1, 0, 1); PG8_SCHED; PG8_LDA(At, 0, 0); if (STG) { PG8_STAGE(PG8_SA(1, 1), a1 + hstep, voffA); } \
            PG8_WAIT_VI(WV); PG8_WAIT_L(0); PG8_BAR; PG8_MMA(0, 0, At, B0); PG8_MMA(0, 1, At, B1); PG8_BAR; PG8_SCHED; \
            PG8_LDA(At, 0, 1); PG8_STAGE(PG8_SB(0, 0), b2, voffB); PG8_STAGE(PG8_SB(0, 1), b2 + hstep, voffB); PG8_STAGE(PG8_SA(0, 0), a2, voffA); \
            PG8_WAIT_VI(WV); PG8_WAIT_L(0); PG8_BAR; PG8_MMA(1, 0, At, B0); PG8_MMA(1, 1, At, B1); PG8_BAR; PG8_SCHED; \
            PG8_LDB(B0, 1, 0); PG8_LDB(B1, 1, 1); PG8_SCHED; PG8_LDA(At, 1, 0); PG8_STAGE(PG8_SA(0, 1), a2 + hstep, voffA); \
            PG8_WAIT_VI(WV); PG8_WAIT_L(0); PG8_BAR; PG8_MMA(0, 0, At, B0); PG8_MMA(0, 1, At, B1); PG8_BAR; PG8_SCHED; \
            PG8_LDA(At, 1, 1); PG8_STAGE(PG8_SB(1, 0), b3, voffB); PG8_STAGE(PG8_SB(1, 1), b3 + hstep, voffB); PG8_STAGE(PG8_SA(1, 0), a3, voffA); \
            PG8_WAIT_V(8); PG8_WAIT_L(0); PG8_BAR; PG8_MMA(1, 0, At, B0); PG8_MMA(1, 1, At, B1); PG8_BAR; PG8_SCHED; } while (0)
    {
        const char* a1 = cA + kstep; const char* a2 = cA + 2 * kstep; const char* b2 = cB + 2 * kstep; const char* a3 = a2 + kstep; const char* b3 = b2 + kstep;
        PG8_TRIP(true, 8);
    }
    for (;;) {
        const bool has_next = S.next(ui + 1, nxt);
        const char* nA = has_next ? (const char*)g.A + (size_t)nxt.pm * tstep : cA; const char* nB = has_next ? (const char*)g.Bt + (size_t)nxt.pn * tstep : cB;
        for (int t = 2; t < nt; t += 2) {
            const bool last = (t == nt - 2);
            const char* a1 = cA + (size_t)(t + 1) * kstep;
            const char* a2 = last ? nA : cA + (size_t)(t + 2) * kstep; const char* b2 = last ? nB : cB + (size_t)(t + 2) * kstep;
            const char* a3 = a2 + kstep; const char* b3 = b2 + kstep;
            if (last && has_next) S.a_ready(nxt);
            PG8_TRIP(true, 8);
            if (last) { PG8_STAGE(PG8_SA(1, 1), a3 + hstep, voffA); }
        }
        if (wr == 0) PG8_BAR;
        PG8_SCHED; { const int l_ = lane_id(); E(acc, cur, wr, wc, l_ & 15, l_ >> 4); } PG8_SCHED;
        S.done(cur);
        if (!has_next) break;
#pragma unroll
        for (int a = 0; a < 2; ++a)
#pragma unroll
            for (int b = 0; b < 2; ++b)
#pragma unroll
                for (int m = 0; m < 4; ++m)
#pragma unroll
                    for (int n = 0; n < 2; ++n) acc[a][b][m][n] = (f32x4){0.f, 0.f, 0.f, 0.f};
        cur = nxt; cA = nA; cB = nB; ++ui;
        if (wr == 1) PG8_BAR;
        PG8_SCHED;
        {
            const char* a1 = cA + kstep; const char* a2 = cA + 2 * kstep; const char* b2 = cB + 2 * kstep; const char* a3 = a2 + kstep; const char* b3 = b2 + kstep; (void)a1;
            PG8_TRIP(false, 8 + Epi::NST);
        }
    }
#undef PG8_TRIP
#undef PG8_WAIT_VI
    PG8_WAIT_V(0);
    PG8_BAR;
#undef PG8_SA
#undef PG8_SB
#undef PG8_STAGE
#undef PG8_LDA
#undef PG8_LDB
#undef PG8_MMA
#undef PG8_WAIT_V
#undef PG8_WAIT_L
#undef PG8_BAR
#undef PG8_SCHED
}
}
#define GAS __attribute__((address_space(1)))
#define LAS __attribute__((address_space(3)))
typedef unsigned short bf16;
typedef unsigned v4u __attribute__((ext_vector_type(4)));
typedef float f32x4 __attribute__((ext_vector_type(4)));
typedef short bf16x8 __attribute__((ext_vector_type(8)));
typedef GAS unsigned gu32;
typedef GAS unsigned long long gu64;
#define RLX_AGENT __ATOMIC_RELAXED, __HIP_MEMORY_SCOPE_AGENT
#define LDS_WAIT() asm volatile("s_waitcnt lgkmcnt(0)" ::: "memory")
#define VM_WAIT() asm volatile("s_waitcnt vmcnt(0)" ::: "memory")
__device__ __forceinline__ unsigned long long rt() { return __builtin_amdgcn_s_memrealtime(); }
__device__ __forceinline__ unsigned pk2(float lo, float hi) { return (unsigned)f2bf(lo) | ((unsigned)f2bf(hi) << 16); }

#define XB_TMO      128
#define XB_XCNT(j)  (256  + 64 * (j))
#define XB_XSUB(j)  (1280 + 64 * (j))
#define XB_XGEN(j)  (2304 + 64 * (j))
#define XB_TOP      3328
#define XB_TOPGEN   3392
#define XCD_BAR_WORDS 3456
#define XB_SPIN_CAP (1u << 18)

__device__ __forceinline__ unsigned xb_ld(unsigned* p)              { return __hip_atomic_load(p, __ATOMIC_RELAXED, __HIP_MEMORY_SCOPE_AGENT); }
__device__ __forceinline__ unsigned xb_add(unsigned* p, unsigned v) { return __hip_atomic_fetch_add(p, v, __ATOMIC_RELAXED, __HIP_MEMORY_SCOPE_AGENT); }
__device__ __forceinline__ unsigned xb_xcc_id() { return (unsigned)__builtin_amdgcn_s_getreg((3 << 11) | 20) & 0xFu; }
#define XB_SPIN(cond, bar) do { unsigned _sp = 0; while (cond) { __builtin_amdgcn_s_sleep(1); \
    if ((++_sp & 255u) == 0u) { if (xb_ld(&(bar)[XB_TMO])) break; if (_sp > XB_SPIN_CAP) { atomicAdd(&(bar)[XB_TMO], 1u); break; } } } } while (0)

struct XcdBarrier {
    unsigned* bar; unsigned x; int wave;
    volatile LAS unsigned* st;
};

__device__ __forceinline__ XcdBarrier xcd_barrier_post(unsigned* bar, volatile LAS unsigned* st, int wave) {
    XcdBarrier b; b.bar = bar; b.x = xb_xcc_id(); b.st = st; b.wave = wave;
    if (wave == 0 && pg8::lane_id() == 0) st[2] = xb_add(&bar[XB_XCNT(b.x)], 1u) + 1u;
    return b;
}
__device__ __forceinline__ void xcd_barrier_complete(unsigned* bar, unsigned x, unsigned& nloc, unsigned& nx) {
    const unsigned G = gridDim.x * gridDim.y * gridDim.z;
    unsigned sum, cnt, mine, sp = 0u;
    for (;;) {
        sum = 0u; cnt = 0u; mine = 0u;
#pragma unroll
        for (unsigned j = 0; j < 16; ++j) { const unsigned c = xb_ld(&bar[XB_XCNT(j)]); sum += c; cnt += (c > 0u) ? 1u : 0u; mine = (j == x) ? c : mine; }
        if (sum == G) break;
        __builtin_amdgcn_s_sleep(1);
        if ((++sp & 255u) == 0u) { if (xb_ld(&bar[XB_TMO])) break; if (sp > XB_SPIN_CAP) { atomicAdd(&bar[XB_TMO], 1u); break; } }
    }
    nloc = mine > 0u ? mine : 1u; nx = cnt > 0u ? cnt : 1u;
}

__device__ __forceinline__ void xcd_barrier(const XcdBarrier& b) {
    asm volatile("s_waitcnt vmcnt(0)" ::: "memory");
    __syncthreads();
    if (b.wave == 0 && pg8::lane_id() == 0) {
        unsigned* bar = b.bar;
        __builtin_amdgcn_s_waitcnt(0);
        unsigned nloc = b.st[0], nx = b.st[1];
        if (nloc == 0u) { xcd_barrier_complete(bar, b.x, nloc, nx); b.st[0] = nloc; b.st[1] = nx; }
        const unsigned old = xb_add(&bar[XB_XSUB(b.x)], 1u);
        const unsigned gen = old / nloc;
        if (old + 1u == (gen + 1u) * nloc) {
            __builtin_amdgcn_fence(__ATOMIC_RELEASE, "agent");
            asm volatile("s_waitcnt vmcnt(0)" ::: "memory");
            const unsigned og = xb_add(&bar[XB_TOP], 1u);
            const unsigned tg = og / nx;
            __builtin_amdgcn_fence(__ATOMIC_ACQUIRE, "agent");
            if (og + 1u == (tg + 1u) * nx) xb_add(&bar[XB_TOPGEN], 1u);
            else XB_SPIN(xb_ld(&bar[XB_TOPGEN]) == tg, bar);
            xb_add(&bar[XB_XGEN(b.x)], 1u);
            asm volatile("s_waitcnt vmcnt(0)" ::: "memory");
        } else {
            __builtin_amdgcn_fence(__ATOMIC_ACQUIRE, "agent");
            XB_SPIN(xb_ld(&bar[XB_XGEN(b.x)]) == gen, bar);
            asm volatile("s_waitcnt vmcnt(0)" ::: "memory");
        }
    }
    __syncthreads();
}

#define XB_LSUB(j)  (3520 + 64 * (j))
#define XB_LGEN(j)  (4544 + 64 * (j))
#define XB_WORDS_END 5568
__device__ __forceinline__ void xcc_local_barrier(const XcdBarrier& b) {
    asm volatile("s_waitcnt vmcnt(0)" ::: "memory");
    __syncthreads();
    if (b.wave == 0 && pg8::lane_id() == 0) {
        unsigned* bar = b.bar;
        __builtin_amdgcn_s_waitcnt(0);
        const unsigned nloc = b.st[0];
        const unsigned old = xb_add(&bar[XB_LSUB(b.x)], 1u), gen = old / nloc;
        __builtin_amdgcn_fence(__ATOMIC_ACQUIRE, "agent");
        if (old + 1u == (gen + 1u) * nloc) xb_add(&bar[XB_LGEN(b.x)], 1u);
        else XB_SPIN(xb_ld(&bar[XB_LGEN(b.x)]) == gen, bar);
        asm volatile("s_waitcnt vmcnt(0)" ::: "memory");
    }
    __syncthreads();
}
__device__ __forceinline__ unsigned xcc_regular(unsigned* bar) {
    unsigned ok = (gridDim.x == 256u) ? 1u : 0u;
#pragma unroll
    for (unsigned j = 0; j < 16; ++j) { const unsigned c = xb_ld(&bar[XB_XCNT(j)]); ok &= (c == (j < 8u ? 32u : 0u)) ? 1u : 0u; }
    return ok;
}

constexpr int NWAVES = 8;
constexpr int NPHASE = 14;
constexpr size_t WS_WGU1 = 2 * MiB, WS_WD1 = 13 * MiB, WS_WIN = 18 * MiB + 512 * 1024, WS_WAO = 29 * MiB, WS_WCO = 31 * MiB, WS_WOUT = 33 * MiB, WS_WGU2 = 35 * MiB, WS_WD2 = 46 * MiB;
static_assert(WS_WD2 + (size_t)DM * FF * 2 <= WS_H && WS_H + 8 * 50 * MiB <= WS_END && WS_AO == WS_H && WS_YA == WS_Q && WS_MG == WS_U, "workspace map");
constexpr size_t CTL_ZERO_BYTES = 64 * 1024;
constexpr int CW_BAR = 4096;
constexpr int RING_OFF = 0, RING_BYTES = 131072, EPI_OFF = RING_BYTES, LDS_BYTES = 163840, LDSCTL_OFF = LDS_BYTES - 512, MISC_OFF = LDSCTL_OFF + 320;
static_assert(EPI_OFF + NWAVES * pg8::EPI_WAVE_BYTES <= LDSCTL_OFF && (CW_BAR + XB_WORDS_END) * 4 <= (int)CTL_ZERO_BYTES, "LDS / control-word map");

typedef pg8::u32x4 u32x4;
typedef float f32x16 __attribute__((ext_vector_type(16)));
typedef short s16x4 __attribute__((ext_vector_type(4)));
typedef unsigned u32x2 __attribute__((ext_vector_type(2)));
typedef float f32x2v __attribute__((ext_vector_type(2)));

template <int CTRL> __device__ __forceinline__ float dpp_mov(float v) { return __builtin_bit_cast(float, __builtin_amdgcn_update_dpp(0, __builtin_bit_cast(int, v), CTRL, 0xf, 0xf, true)); }
__device__ __forceinline__ float wave_allsum(float v) {
    v += dpp_mov<0xB1>(v); v += dpp_mov<0x4E>(v); v += dpp_mov<0x124>(v); v += dpp_mov<0x128>(v);
    { auto r = __builtin_amdgcn_permlane16_swap(__float_as_uint(v), __float_as_uint(v), false, false); v = __uint_as_float(r[0]) + __uint_as_float(r[1]); }
    { auto r = __builtin_amdgcn_permlane32_swap(__float_as_uint(v), __float_as_uint(v), false, false); v = __uint_as_float(r[0]) + __uint_as_float(r[1]); }
    return v;
}
__device__ __forceinline__ float xhalf_max(float v) { auto r = __builtin_amdgcn_permlane32_swap(__float_as_uint(v), __float_as_uint(v), false, false); return fmaxf(__uint_as_float(r[0]), __uint_as_float(r[1])); }
__device__ __forceinline__ float xhalf_sum(float v) { auto r = __builtin_amdgcn_permlane32_swap(__float_as_uint(v), __float_as_uint(v), false, false); return __uint_as_float(r[0]) + __uint_as_float(r[1]); }

struct Frame {
    LAS unsigned char* lds;
    volatile LAS unsigned* MISC;
    gu32* ctl;
    int wave, vcu, G;
    __device__ __forceinline__ int lane_() const { return pg8::lane_id(); }
    __device__ __forceinline__ int tid_() const { return (wave << 6) | pg8::lane_id(); }
};
struct Args { const float* in[23]; float* out; unsigned char* ws; int ph_lo, ph_hi, use_bar, pad; };

__device__ __forceinline__ void p0_transpose_item(const float* W, int K, int N, bf16* WT, int kind, LAS float* scr, int item, int lane) {
    const int nblk = N / 32, kb = item / nblk, nb = item % nblk, k0 = 64 * kb, n0 = 32 * nb;
    int drow = n0;
    if (kind == 1 || kind == 2) drow = 256 * (n0 >> 7) + 128 * (kind - 1) + (n0 & 127);
    else if (kind == 3) { if (n0 >= 1280 && n0 < 2304) { const int r = n0 - 1280; drow = 1280 + 256 * (r >> 7) + (r & 127); } else if (n0 >= 2304 && n0 < 3328) { const int r = n0 - 2304; drow = 1280 + 256 * (r >> 7) + 128 + (r & 127); } }
    float v[32];
#pragma unroll
    for (int i = 0; i < 32; ++i) v[i] = W[(size_t)(k0 + 2 * i + (lane >> 5)) * N + n0 + (lane & 31)];
#pragma unroll
    for (int i = 0; i < 32; ++i) scr[(2 * i + (lane >> 5)) * 33 + (lane & 31)] = v[i];
    LDS_WAIT(); asm volatile("" ::: "memory");
    const int c = lane & 7;
#pragma unroll
    for (int j = 0; j < 4; ++j) { const int n = (lane >> 3) + 8 * j; const LAS float* s = scr + (8 * c) * 33 + n;
        v4u o; o.x = pk2(s[0 * 33], s[1 * 33]); o.y = pk2(s[2 * 33], s[3 * 33]); o.z = pk2(s[4 * 33], s[5 * 33]); o.w = pk2(s[6 * 33], s[7 * 33]);
        *(GAS v4u*)(WT + (size_t)(drow + n) * K + k0 + 8 * c) = o; }
    LDS_WAIT(); asm volatile("" ::: "memory");
}
__device__ __forceinline__ void p0_prologue(Frame& F, const Args& a) {
    unsigned char* ws = a.ws;
    if (F.vcu < NMODW / 64) {
        LAS float* cact = (LAS float*)(F.lds);
        LAS float* red = (LAS float*)(F.lds + 65536);
        const float* c = a.in[1];
        for (int e = F.tid_(); e < BATCH * DM; e += NWAVES * 64) { const int b = e >> 10, k = e & 1023; const float v = c[e]; cact[k * 16 + b] = v / (1.f + __expf(-v)); }
        __syncthreads();
        const int col = F.vcu * 64 + F.lane_(); const float* w = a.in[2] + col;
        float acc[16];
#pragma unroll
        for (int b = 0; b < 16; ++b) acc[b] = 0.f;
        const int kbeg = F.wave * 128;
#pragma unroll 1
        for (int k = kbeg; k < kbeg + 128; k += 32) {
            float wv[32];
#pragma unroll
            for (int j = 0; j < 32; ++j) wv[j] = w[(size_t)(k + j) * NMODW];
#pragma unroll
            for (int j = 0; j < 32; ++j) { const LAS f32x4* cp = (const LAS f32x4*)(cact + (k + j) * 16);
#pragma unroll
                for (int q = 0; q < 4; ++q) { const f32x4 cv = cp[q]; acc[4 * q] += cv[0] * wv[j]; acc[4 * q + 1] += cv[1] * wv[j]; acc[4 * q + 2] += cv[2] * wv[j]; acc[4 * q + 3] += cv[3] * wv[j]; } } }
#pragma unroll
        for (int b = 0; b < 16; ++b) red[(F.wave * 16 + b) * 64 + F.lane_()] = acc[b];
        __syncthreads();
        float* mod = (float*)(ws + WS_MOD);
        for (int e = F.tid_(); e < 16 * 64; e += NWAVES * 64) { const int b = e >> 6, cl = e & 63; float s = a.in[3][F.vcu * 64 + cl];
#pragma unroll
            for (int wv = 0; wv < 8; ++wv) s += red[(wv * 16 + b) * 64 + cl];
            mod[(size_t)b * NMODW + F.vcu * 64 + cl] = s; }
        __syncthreads();
    }
    LAS float* scr = (LAS float*)(F.lds + RING_OFF + F.wave * 16384);
    const int gw = F.vcu * NWAVES + F.wave, NGW = F.G * NWAVES;
    constexpr int I_GU = (DM / 64) * (FF / 32), I_D = (FF / 64) * (DM / 32), I_IN = (DM / 64) * (NIN / 32), I_SQ = (DM / 64) * (DM / 32);
    constexpr int NITEMS = 4 * I_GU + 2 * I_D + I_IN + 3 * I_SQ;
    static_assert(NITEMS == (256 - NMODW / 64) * NWAVES * 9 + (NMODW / 64) * NWAVES * 4, "item split");
    const bool split = (F.G == 256), late = F.vcu < NMODW / 64;
    const int n_early = (256 - NMODW / 64) * NWAVES, n_late = (NMODW / 64) * NWAVES;
    const int it0 = !split ? gw : (late ? n_early * 9 + gw : gw - n_late), its = !split ? NGW : (late ? n_late : n_early), itend = !split ? NITEMS : (late ? NITEMS : n_early * 9);
    for (int it = it0; it < itend; it += its) {
        int r = it;
        if (r < I_GU) { p0_transpose_item(a.in[5], DM, FF, (bf16*)(ws + WS_WGU1), 1, scr, r, F.lane_()); continue; } r -= I_GU;
        if (r < I_GU) { p0_transpose_item(a.in[6], DM, FF, (bf16*)(ws + WS_WGU1), 2, scr, r, F.lane_()); continue; } r -= I_GU;
        if (r < I_D) { p0_transpose_item(a.in[7], FF, DM, (bf16*)(ws + WS_WD1), 0, scr, r, F.lane_()); continue; } r -= I_D;
        if (r < I_IN) { p0_transpose_item(a.in[9], DM, NIN, (bf16*)(ws + WS_WIN), 3, scr, r, F.lane_()); continue; } r -= I_IN;
        if (r < I_SQ) { p0_transpose_item(a.in[11], DM, DM, (bf16*)(ws + WS_WAO), 0, scr, r, F.lane_()); continue; } r -= I_SQ;
        if (r < I_SQ) { p0_transpose_item(a.in[16], DM, DM, (bf16*)(ws + WS_WCO), 0, scr, r, F.lane_()); continue; } r -= I_SQ;
        if (r < I_SQ) { p0_transpose_item(a.in[17], DM, DM, (bf16*)(ws + WS_WOUT), 0, scr, r, F.lane_()); continue; } r -= I_SQ;
        if (r < I_GU) { p0_transpose_item(a.in[19], DM, FF, (bf16*)(ws + WS_WGU2), 1, scr, r, F.lane_()); continue; } r -= I_GU;
        if (r < I_GU) { p0_transpose_item(a.in[20], DM, FF, (bf16*)(ws + WS_WGU2), 2, scr, r, F.lane_()); continue; } r -= I_GU;
        p0_transpose_item(a.in[21], FF, DM, (bf16*)(ws + WS_WD2), 0, scr, r, F.lane_());
    }
}

__device__ __forceinline__ void add_bf16x4(f32x4& v, u32x2 w) { v[0] += __uint_as_float(w.x << 16); v[1] += __uint_as_float(w.x & 0xffff0000u); v[2] += __uint_as_float(w.y << 16); v[3] += __uint_as_float(w.y & 0xffff0000u); }
template <int MODE, int NY, bool XBF, bool SNAP>
__device__ __forceinline__ void norm_phase(Frame& F, const float* xin, const bf16* xb, const bf16* y1, const bf16* y2, const bf16* y3, bf16* snap, const float* g, const float* mod, int shift_idx, bf16* H, float* out) {
    const int gw = F.vcu * NWAVES + F.wave, NGW = F.G * NWAVES, lane = F.lane_();
    for (int ch = gw; ch < M / 16; ch += NGW) {
        const int b = (ch * 16) / SEQ;
        f32x4 A[4], Bv[4];
#pragma unroll
        for (int j = 0; j < 4; ++j) { const int c = 4 * lane + 256 * j; A[j] = *(const f32x4*)(g + c);
            if (MODE == 0) { const float* sh = mod + (size_t)b * NMODW + shift_idx * DM + c; A[j] = A[j] * (*(const f32x4*)(sh + DM) + 1.0f); Bv[j] = *(const f32x4*)sh; } }
#pragma unroll 2
        for (int r = 0; r < 16; ++r) {
            const size_t row = (size_t)ch * 16 + r;
            f32x4 v[4]; u32x2 d0[4], d1[4], d2[4], d3[4];
#pragma unroll
            for (int j = 0; j < 4; ++j) {
                if (XBF) d0[j] = ((const GAS u32x2*)(xb + row * DM) + lane)[64 * j]; else v[j] = ((const GAS f32x4*)(xin + row * DM) + lane)[64 * j];
                if (NY >= 1) d1[j] = ((const GAS u32x2*)(y1 + row * DM) + lane)[64 * j];
                if (NY >= 2) d2[j] = ((const GAS u32x2*)(y2 + row * DM) + lane)[64 * j];
                if (NY >= 3) d3[j] = ((const GAS u32x2*)(y3 + row * DM) + lane)[64 * j]; }
            float s = 0.f;
#pragma unroll
            for (int j = 0; j < 4; ++j) { if (XBF) { v[j] = (f32x4){0.f, 0.f, 0.f, 0.f}; add_bf16x4(v[j], d0[j]); }
                if (NY >= 1) add_bf16x4(v[j], d1[j]); if (NY >= 2) add_bf16x4(v[j], d2[j]); if (NY >= 3) add_bf16x4(v[j], d3[j]);
                s += (v[j][0] * v[j][0] + v[j][1] * v[j][1]) + (v[j][2] * v[j][2] + v[j][3] * v[j][3]); }
            const float rs = rsqrtf(wave_allsum(s) * (1.f / DM) + EPS);
            if (SNAP) { GAS u32x2* o8 = (GAS u32x2*)(snap + row * DM) + lane;
#pragma unroll
                for (int j = 0; j < 4; ++j) { u32x2 w; w.x = pg8::cvt_pk_bf16(v[j][0], v[j][1]); w.y = pg8::cvt_pk_bf16(v[j][2], v[j][3]); o8[64 * j] = w; } }
            if (MODE == 0) {
                GAS u32x2* o8 = (GAS u32x2*)(H + row * DM) + lane;
#pragma unroll
                for (int j = 0; j < 4; ++j) { const f32x4 hv = v[j] * rs * A[j] + Bv[j]; u32x2 w; w.x = pg8::cvt_pk_bf16(hv[0], hv[1]); w.y = pg8::cvt_pk_bf16(hv[2], hv[3]); o8[64 * j] = w; }
            } else {
                GAS f32x4* o = (GAS f32x4*)(out + row * DM) + lane;
#pragma unroll
                for (int j = 0; j < 4; ++j) o[64 * j] = v[j] * rs * A[j];
            }
        }
    }
}

constexpr int AT_KROW = 144, AT_V_OFF = 256 * AT_KROW;
__device__ __forceinline__ int crow(int r, int h) { return (r & 3) + 8 * (r >> 2) + 4 * h; }
typedef short v4i16_t __attribute__((ext_vector_type(4)));
__device__ __forceinline__ s16x4 ld_tr16(const LAS unsigned char* p) { return __builtin_bit_cast(s16x4, __builtin_amdgcn_ds_read_tr16_b64_v4i16((LAS v4i16_t*)p)); }
template <class UnitMap>
__device__ __forceinline__ void attn_phase(Frame& F, int first, int stride, int nunits, const UnitMap& umap, const bf16* Q, const bf16* Kb, const bf16* Vb, const float* sinks, bf16* AO) {
    LAS unsigned char* lds = F.lds;
    const int tid = F.tid_(), lane = F.lane_(), r32 = lane & 31, h = lane >> 5;
    if (first >= nunits) return;
    const int sj0 = tid >> 3, c8 = tid & 7;
    u32x4 kr[4], vr[4];
#define AT_LOAD(b_, n_, kvh_) do { const long band0_ = (long)(b_) * SEQ + (long)((n_) - 1) * 128; \
        _Pragma("unroll") for (int i = 0; i < 4; ++i) { const int sj = sj0 + 64 * i; kr[i] = (u32x4){0u, 0u, 0u, 0u}; vr[i] = kr[i]; \
            if ((n_) > 0 || sj >= 128) { const size_t off = (size_t)(band0_ + sj) * 128 + (kvh_) * 64 + c8 * 8; kr[i] = *(const GAS u32x4*)(Kb + off); vr[i] = *(const GAS u32x4*)(Vb + off); } } } while (0)
    int b, n, kvh; umap(first, b, n, kvh);
    AT_LOAD(b, n, kvh);
    const float NEG = -1.0e30f;
    const int tr_off = ((lane & 15) >> 2) * AT_KROW + (16 * ((lane >> 4) & 1) + 4 * (lane & 3)) * 2 + 4 * h * AT_KROW;
    for (int u = first; u < nunits; u += stride) {
        const int hq = kvh * 8 + F.wave;
        const bf16* qbase = Q + ((size_t)b * SEQ + n * 128 + r32) * 1024 + hq * 64 + 8 * h;
        bf16x8 qr[4];
#pragma unroll
        for (int ks = 0; ks < 4; ++ks) qr[ks] = *(const GAS bf16x8*)(qbase + 16 * ks);
#pragma unroll
        for (int i = 0; i < 4; ++i) { const int sj = sj0 + 64 * i; *(LAS u32x4*)(lds + sj * AT_KROW + c8 * 16) = kr[i]; *(LAS u32x4*)(lds + AT_V_OFF + sj * AT_KROW + c8 * 16) = vr[i]; }
        __syncthreads();
        const float sink = sinks[hq] * 1.4426950408889634f;
        const bool first_blk = (n == 0);
        const size_t tok0 = (size_t)b * SEQ + n * 128 + r32;
        int nb = b, nn = n, nk = kvh;
        if (u + stride < nunits) { umap(u + stride, nb, nn, nk); AT_LOAD(nb, nn, nk); }
#pragma unroll 1
        for (int j = 0; j < 4; ++j) {
            bf16x8 qn[4];
            { const bf16* qp = qbase + (size_t)(j < 3 ? j + 1 : j) * 32 * 1024;
#pragma unroll
              for (int ks = 0; ks < 4; ++ks) qn[ks] = *(const GAS bf16x8*)(qp + 16 * ks); }
            f32x16 S[5];
#pragma unroll
            for (int kbi = 0; kbi < 5; ++kbi) {
                f32x16 acc = {0.f, 0.f, 0.f, 0.f, 0.f, 0.f, 0.f, 0.f, 0.f, 0.f, 0.f, 0.f, 0.f, 0.f, 0.f, 0.f};
                const LAS unsigned char* kp = lds + (32 * (j + kbi) + r32) * AT_KROW + 16 * h;
#pragma unroll
                for (int ks = 0; ks < 4; ++ks) { const bf16x8 kf = *(const LAS bf16x8*)(kp + 32 * ks); acc = __builtin_amdgcn_mfma_f32_32x32x16_bf16(kf, qr[ks], acc, 0, 0, 0); }
                S[kbi] = acc;
            }
#pragma unroll
            for (int r = 0; r < 16; ++r) { const int cr = crow(r, h); S[0][r] = (cr > r32) ? S[0][r] : NEG; S[4][r] = (cr <= r32) ? S[4][r] : NEG; }
            if (first_blk) {
#pragma unroll
                for (int kbi = 0; kbi < 4; ++kbi) if (j + kbi < 4) {
#pragma unroll
                    for (int r = 0; r < 16; ++r) S[kbi][r] = NEG; }
            }
            float mx = sink;
#pragma unroll
            for (int kbi = 0; kbi < 5; ++kbi)
#pragma unroll
                for (int r = 0; r < 16; r += 2) mx = fmaxf(fmaxf(mx, S[kbi][r]), S[kbi][r + 1]);
            mx = xhalf_max(mx);
            float l0 = 0.f, l1 = 0.f;
#pragma unroll
            for (int kbi = 0; kbi < 5; ++kbi)
#pragma unroll
                for (int r = 0; r < 16; r += 2) { const float p0 = __builtin_amdgcn_exp2f(S[kbi][r] - mx), p1 = __builtin_amdgcn_exp2f(S[kbi][r + 1] - mx); S[kbi][r] = p0; S[kbi][r + 1] = p1; l0 += p0; l1 += p1; }
            const float l = xhalf_sum(l0 + l1) + __builtin_amdgcn_exp2f(sink - mx);
            const float inv = 1.0f / l;
            f32x16 o0 = {0.f, 0.f, 0.f, 0.f, 0.f, 0.f, 0.f, 0.f, 0.f, 0.f, 0.f, 0.f, 0.f, 0.f, 0.f, 0.f}, o1 = o0;
#pragma unroll
            for (int kbi = 0; kbi < 5; ++kbi)
#pragma unroll
                for (int s2 = 0; s2 < 2; ++s2) {
                    u32x4 pw; pw.x = pg8::cvt_pk_bf16(S[kbi][8 * s2 + 0], S[kbi][8 * s2 + 1]); pw.y = pg8::cvt_pk_bf16(S[kbi][8 * s2 + 2], S[kbi][8 * s2 + 3]);
                    pw.z = pg8::cvt_pk_bf16(S[kbi][8 * s2 + 4], S[kbi][8 * s2 + 5]); pw.w = pg8::cvt_pk_bf16(S[kbi][8 * s2 + 6], S[kbi][8 * s2 + 7]);
                    const bf16x8 pf = __builtin_bit_cast(bf16x8, pw);
                    const LAS unsigned char* vp = lds + AT_V_OFF + (32 * (j + kbi) + 16 * s2) * AT_KROW + tr_off;
                    const s16x4 a0 = ld_tr16(vp), a1 = ld_tr16(vp + 8 * AT_KROW), c0 = ld_tr16(vp + 64), c1 = ld_tr16(vp + 8 * AT_KROW + 64);
                    const bf16x8 vf0 = __builtin_shufflevector(a0, a1, 0, 1, 2, 3, 4, 5, 6, 7), vf1 = __builtin_shufflevector(c0, c1, 0, 1, 2, 3, 4, 5, 6, 7);
                    o0 = __builtin_amdgcn_mfma_f32_32x32x16_bf16(vf0, pf, o0, 0, 0, 0);
                    o1 = __builtin_amdgcn_mfma_f32_32x32x16_bf16(vf1, pf, o1, 0, 0, 0);
                }
            bf16* orow = AO + (tok0 + 32 * j) * 1024 + hq * 64 + 4 * h;
#pragma unroll
            for (int g4 = 0; g4 < 4; ++g4) {
                u32x2 w0, w1;
                w0.x = pg8::cvt_pk_bf16(o0[4 * g4] * inv, o0[4 * g4 + 1] * inv); w0.y = pg8::cvt_pk_bf16(o0[4 * g4 + 2] * inv, o0[4 * g4 + 3] * inv);
                w1.x = pg8::cvt_pk_bf16(o1[4 * g4] * inv, o1[4 * g4 + 1] * inv); w1.y = pg8::cvt_pk_bf16(o1[4 * g4 + 2] * inv, o1[4 * g4 + 3] * inv);
                *(GAS u32x2*)(orow + 8 * g4) = w0; *(GAS u32x2*)(orow + 32 + 8 * g4) = w1;
            }
#pragma unroll
            for (int ks = 0; ks < 4; ++ks) qr[ks] = qn[ks];
        }
        __syncthreads();
        b = nb; n = nn; kvh = nk;
    }
#undef AT_LOAD
}
struct AttnMapFlat { __device__ __forceinline__ void operator()(int u, int& b, int& n, int& kvh) const { kvh = u & 1; n = (u >> 1) & 15; b = u >> 5; } };
struct AttnMapGroup { int g; __device__ __forceinline__ void operator()(int li, int& b, int& n, int& kvh) const { kvh = li & 1; n = (li >> 1) & 15; b = 2 * g + (li >> 5); } };

#ifndef CVG_TOK
#define CVG_TOK 8
#endif
constexpr int CV_T = 32, CV_ROWS = CV_T + 30, CVG = 8;
constexpr int CV_YOFF = CV_ROWS * 2048;
static_assert(CV_YOFF + CVG * 4096 <= LDSCTL_OFF && CVG == NWAVES, "conv LDS map");
__device__ __forceinline__ void conv_phase(Frame& F, int first, int stride, int nunits, const bf16* U, const float* wdw, const float* bdw, const float* lng, const float* lnb, bf16* CA) {
    LAS unsigned char* lds = F.lds;
    const int tid = F.tid_(), lane = F.lane_();
    if (first >= nunits) return;
    pg8::f16x2_t wk[31];
#pragma unroll
    for (int k = 0; k < 31; ++k) { const f32x2v wv = *(const GAS f32x2v*)(wdw + k * 1024 + 2 * tid); wk[k] = __builtin_convertvector(wv, pg8::f16x2_t); }
    const f32x2v bv = *(const GAS f32x2v*)(bdw + 2 * tid);
    f32x4 lg[4], lb[4];
#pragma unroll
    for (int q = 0; q < 4; ++q) { const int c = (q >> 1) * 512 + 8 * lane + 4 * (q & 1); lg[q] = *(const GAS f32x4*)(lng + c); lb[q] = *(const GAS f32x4*)(lnb + c); }
    u32x4 R[16];
    const int r0 = tid >> 7;
    int tbase = r0 * 2048 + (tid & 127) * 16;
#define CV_LOAD(cu_) do { const long m0_ = (long)(cu_) * CV_T; const int t0_ = (int)(m0_ % SEQ); asm volatile("" : "+v"(tbase)); \
        const unsigned char* gb_ = (const unsigned char*)U + (m0_ - 30) * 2048 + tbase; \
        _Pragma("unroll") for (int i = 0; i < 16; ++i) { R[i] = (u32x4){0u, 0u, 0u, 0u}; \
            if ((i < 15 || r0 < 2) && t0_ - 30 + r0 + 4 * i >= 0) R[i] = *(const GAS u32x4*)(gb_ + i * 8192); } } while (0)
#define CV_WRITE() do { asm volatile("" : "+v"(tbase)); _Pragma("unroll") for (int i = 0; i < 16; ++i) { if (i < 15 || r0 < 2) *(LAS u32x4*)(lds + tbase + i * 8192) = R[i]; } } while (0)
#define CV_LOAD_NEW(cu_) do { asm volatile("" : "+v"(tbase)); const unsigned char* gb_ = (const unsigned char*)U + (long)(cu_) * CV_T * 2048 + tbase; \
        _Pragma("unroll") for (int i = 0; i < 8; ++i) R[i] = *(const GAS u32x4*)(gb_ + i * 8192); } while (0)
    CV_LOAD(first); CV_WRITE();
    __syncthreads();
    for (int cu = first; cu < nunits; cu += stride) {
        const long m0 = (long)cu * CV_T;
        const bool more = cu + stride < nunits;
        const bool reuse = more && stride == 1 && ((cu + 1) % (SEQ / CV_T)) != 0;
        if (more) { if (reuse) CV_LOAD_NEW(cu + 1); else CV_LOAD(cu + stride); }
#pragma unroll 1
        for (int gq = 0; gq < CV_T / CVG; ++gq) {
            float y0[CVG], y1[CVG];
            const LAS unsigned char* wp = lds + gq * CVG * 2048 + tid * 4;
            pg8::f16x2_t ya[CVG], yb[CVG];
#pragma unroll
            for (int t = 0; t < CVG; ++t) { ya[t] = (pg8::f16x2_t){(_Float16)0.f, (_Float16)0.f}; yb[t] = ya[t]; }
#pragma unroll
            for (int i = 0; i < CVG + 30; ++i) {
                const pg8::f16x2_t uu = *(const LAS pg8::f16x2_t*)(wp + i * 2048);
#pragma unroll
                for (int t = 0; t < CVG; ++t) { const int k = i - t; if (k >= 0 && k < 16) ya[t] = __builtin_elementwise_fma(wk[k], uu, ya[t]); else if (k >= 16 && k < 31) yb[t] = __builtin_elementwise_fma(wk[k], uu, yb[t]); }
            }
#pragma unroll
            for (int t = 0; t < CVG; ++t) { y0[t] = bv[0] + ((float)ya[t][0] + (float)yb[t][0]); y1[t] = bv[1] + ((float)ya[t][1] + (float)yb[t][1]); }
#pragma unroll
            for (int t = 0; t < CVG; ++t) *(LAS f32x2v*)(lds + CV_YOFF + t * 4096 + tid * 8) = (f32x2v){y0[t], y1[t]};
            __syncthreads();
            {
                const LAS f32x4* yp = (const LAS f32x4*)(lds + CV_YOFF + F.wave * 4096 + lane * 32);
                f32x4 v[4]; v[0] = yp[0]; v[1] = yp[1]; v[2] = yp[128]; v[3] = yp[129];
                float sm = 0.f, sq = 0.f;
#pragma unroll
                for (int q = 0; q < 4; ++q) { sm += (v[q][0] + v[q][1]) + (v[q][2] + v[q][3]); sq += (v[q][0] * v[q][0] + v[q][1] * v[q][1]) + (v[q][2] * v[q][2] + v[q][3] * v[q][3]); }
                sm = wave_allsum(sm); sq = wave_allsum(sq);
                const float mean = sm * (1.f / DM), rs = rsqrtf(fmaxf(sq * (1.f / DM) - mean * mean, 0.f) + EPS);
#pragma unroll
                for (int q = 0; q < 4; ++q) { const f32x4 a = (v[q] - mean) * rs * lg[q] + lb[q]; v[q] = a * pg8::sigm4(a); }
                bf16* orow = CA + (size_t)(m0 + gq * CVG + F.wave) * 1024 + 8 * lane;
                *(GAS u32x4*)orow = pg8::pack8(v[0], v[1]); *(GAS u32x4*)(orow + 512) = pg8::pack8(v[2], v[3]);
            }
            __syncthreads();
        }
        if (more) {
            if (reuse) {
                asm volatile("" : "+v"(tbase));
#pragma unroll
                for (int i = 0; i < 8; ++i) if (i < 7 || r0 < 2) R[8 + i] = *(const LAS u32x4*)(lds + tbase + (32 * 2048) + i * 8192);
                __syncthreads();
                asm volatile("" : "+v"(tbase));
#pragma unroll
                for (int i = 0; i < 8; ++i) { if (i < 7 || r0 < 2) *(LAS u32x4*)(lds + tbase + i * 8192) = R[8 + i];
                    *(LAS u32x4*)(lds + tbase + (30 * 2048) + i * 8192) = R[i]; }
            } else CV_WRITE();
            __syncthreads();
        }
    }
#undef CV_LOAD
#undef CV_LOAD_NEW
#undef CV_WRITE
}

__global__ void __launch_bounds__(NWAVES * 64, 2) mk_fwd(Args args) {
    extern __shared__ __attribute__((aligned(16))) unsigned char lds[];
#ifndef PADW
#define PADW 0
#endif
#define PAD_STR2(x) #x
#define PAD_STR(x) PAD_STR2(x)
    if (PADW > 0) asm volatile("s_branch 1f\n\t.fill " PAD_STR(PADW) ", 4, 0xbf800000\n1:" ::: "memory");
    Frame F;
    F.lds = (LAS unsigned char*)lds;
    F.MISC = (volatile LAS unsigned*)(F.lds + MISC_OFF);
    F.wave = __builtin_amdgcn_readfirstlane((int)threadIdx.x >> 6);
    F.G = gridDim.x; { const int bx = blockIdx.x; F.vcu = (F.G % 8 == 0) ? (bx % 8) * (F.G / 8) + bx / 8 : bx; }
    unsigned char* ws = args.ws;
    F.ctl = (gu32*)(ws + WS_CTL);
    for (int u = F.tid_(); u < 512 / 4; u += NWAVES * 64) ((LAS unsigned*)(F.lds + LDSCTL_OFF))[u] = 0u;
    __syncthreads();
    XcdBarrier bar; bar.bar = (unsigned*)(F.ctl + CW_BAR); bar.x = 0; bar.st = nullptr; bar.wave = F.wave;
    if (args.use_bar) bar = xcd_barrier_post((unsigned*)(F.ctl + CW_BAR), F.MISC + 8, F.wave);
    const int lo = args.ph_lo, hi = args.ph_hi;
#ifndef PHM
#define PHM 0x3FFF
#endif
#define IN(k) (((PHM >> (k)) & 1) && lo <= (k) && (k) < hi)
#define SEAM(k) do { if (IN(k) && IN((k) + 1)) { if (local_mode) xcc_local_barrier(bar); else xcd_barrier(bar); } } while (0)
    int local_mode = 0, vbx = (int)blockIdx.x;

    const float* x = args.in[0]; float* out = args.out;
    LAS unsigned char* escr = F.lds + EPI_OFF + F.wave * pg8::EPI_WAVE_BYTES;
    float* mod = (float*)(ws + WS_MOD);
    int grp = -1;
#define BUF(name, flat_off, slab_off, pitch) bf16* name = (gq < 0) ? (bf16*)(ws + (flat_off)) : (bf16*)(ws + WS_H + (size_t)gq * (50 * MiB) + (slab_off)) - (size_t)gq * 4096 * (pitch)
#define GATES() bf16* GA = (gq < 0) ? (bf16*)out : (bf16*)((unsigned char*)out + (size_t)gq * (16 * MiB)) - (size_t)gq * 4096 * 1024; bf16* GC = (gq < 0) ? GA + (size_t)M * DM : GA + 4096 * 1024
#define GRP() int gq = grp; asm volatile("" : "+s"(gq))
#define B_H()   BUF(H,   WS_H,   0 * MiB,  1024)
#define B_Y1()  BUF(Y1,  WS_Y1,  8 * MiB,  1024)
#define B_Y2()  BUF(Y2,  WS_Y2,  16 * MiB, 1024)
#define B_ACT() BUF(ACT, WS_ACT, 24 * MiB, FF)
#define B_Q()   BUF(Qb,  WS_Q,   24 * MiB, 1024)
#define B_K()   BUF(Kb,  WS_K,   32 * MiB, 128)
#define B_V()   BUF(Vb,  WS_V,   33 * MiB, 128)
#define B_U()   BUF(Ub,  WS_U,   34 * MiB, 1024)
#define B_CA()  BUF(CA,  WS_CA,  42 * MiB, 1024)

    if (IN(0)) { p0_prologue(F, args); } SEAM(0);
    if (args.use_bar && IN(0) && IN(1)) {
#ifdef FORCE_GLOBAL_SEAMS
        if (F.wave == 0 && pg8::lane_id() == 0) F.MISC[11] = 0u;
#else
        if (F.wave == 0 && pg8::lane_id() == 0) F.MISC[11] = xcc_regular(bar.bar);
#endif
        __syncthreads();
        local_mode = __builtin_amdgcn_readfirstlane((int)F.MISC[11]);
        if (local_mode) { const int rank = __builtin_amdgcn_readfirstlane((int)F.MISC[10]) - 1; vbx = 8 * rank + (int)bar.x; F.vcu = 32 * (int)bar.x + rank; grp = (int)bar.x; }
    }
    if (IN(1)) { GRP(); B_H(); norm_phase<0, 0, false, false>(F, x, nullptr, nullptr, nullptr, nullptr, nullptr, args.in[4], mod, 0, H, nullptr); } SEAM(1);
    if (IN(2)) { GRP(); B_H(); B_ACT(); pg8::Gemm g{H, (const bf16*)(ws + WS_WGU1), M, 2 * FF, DM, F.wave}; pg8::StaticOrder S; S.init(M, 2 * FF, F.G, vbx);
        pg8::EpiSwiGLU E{ACT, FF};
        pg8::gemm_phase<pg8::EpiSwiGLU, pg8::StaticOrder, true, true>(F.lds + RING_OFF, g, S, E); } SEAM(2);
    if (IN(3)) { GRP(); B_ACT(); B_Y1(); pg8::Gemm g{ACT, (const bf16*)(ws + WS_WD1), M, DM, FF, F.wave}; pg8::StaticOrder S; S.init(M, DM, F.G, vbx);
        typedef pg8::EpiDelta<NMODW, SEQ / 256, 1> EpiD; EpiD E{Y1, mod + 2 * DM, escr};
        pg8::gemm_phase<EpiD, pg8::StaticOrder, true, true>(F.lds + RING_OFF, g, S, E); } SEAM(3);
    if (IN(4)) { GRP(); B_H(); B_Y1(); norm_phase<0, 1, false, true>(F, x, nullptr, Y1, nullptr, nullptr,   Y1, args.in[8], mod, 3, H, nullptr); } SEAM(4);
    if (IN(5)) { GRP(); B_H(); B_Q(); B_K(); B_V(); B_U(); GATES(); pg8::Gemm g{H, (const bf16*)(ws + WS_WIN), M, NIN, DM, F.wave}; pg8::StaticOrder S; S.init(M, NIN, F.G, vbx);
        pg8::EpiIn E{Qb, Kb, Vb, Ub, GA, GC, escr};
        pg8::gemm_phase<pg8::EpiIn, pg8::StaticOrder, true, true>(F.lds + RING_OFF, g, S, E); } SEAM(5);
    if (IN(6)) { GRP(); B_Q(); B_K(); B_V(); B_U(); B_CA(); BUF(AO, WS_AO, 0 * MiB, 1024);
        if (local_mode) attn_phase(F, F.vcu & 31, 32, 64, AttnMapGroup{F.vcu >> 5}, Qb, Kb, Vb, args.in[10], AO);
        else attn_phase(F, F.vcu, F.G, BATCH * 16 * 2, AttnMapFlat{}, Qb, Kb, Vb, args.in[10], AO);
        if (local_mode) { const int u0 = 128 * (F.vcu >> 5) + 4 * (F.vcu & 31); conv_phase(F, u0, 1, u0 + 4, Ub, args.in[12], args.in[13], args.in[14], args.in[15], CA); }
        else { const int per = (M / CV_T + F.G - 1) / F.G, u0 = F.vcu * per, u1 = (u0 + per < M / CV_T) ? u0 + per : M / CV_T; conv_phase(F, u0, 1, u1, Ub, args.in[12], args.in[13], args.in[14], args.in[15], CA); }
    } SEAM(6);
    if (IN(7)) { GRP(); BUF(AO, WS_AO, 0 * MiB, 1024); BUF(YA, WS_YA, 24 * MiB, 1024); GATES(); (void)GC; pg8::Gemm g{AO, (const bf16*)(ws + WS_WAO), M, DM, DM, F.wave}; pg8::StaticOrder S; S.init(M, DM, F.G, vbx);
        pg8::EpiGate<0> E{GA, nullptr, YA, escr};
        pg8::gemm_phase<pg8::EpiGate<0>, pg8::StaticOrder, true, true>(F.lds + RING_OFF, g, S, E); }
    if (IN(8)) { GRP(); B_CA(); BUF(YA, WS_YA, 24 * MiB, 1024); BUF(MG, WS_MG, 34 * MiB, 1024); GATES(); (void)GA; pg8::Gemm g{CA, (const bf16*)(ws + WS_WCO), M, DM, DM, F.wave}; pg8::StaticOrder S; S.init(M, DM, F.G, vbx);
        pg8::EpiGate<1> E{GC, YA, MG, escr};
        pg8::gemm_phase<pg8::EpiGate<1>, pg8::StaticOrder, true, true>(F.lds + RING_OFF, g, S, E); } SEAM(8);
    if (IN(9)) { GRP(); BUF(MG, WS_MG, 34 * MiB, 1024); B_Y2(); pg8::Gemm g{MG, (const bf16*)(ws + WS_WOUT), M, DM, DM, F.wave}; pg8::StaticOrder S; S.init(M, DM, F.G, vbx);
        typedef pg8::EpiDelta<NMODW, SEQ / 256, 0> EpiD; EpiD E{Y2, mod + 5 * DM, escr};
        pg8::gemm_phase<EpiD, pg8::StaticOrder, true, true>(F.lds + RING_OFF, g, S, E); } SEAM(9);
    if (IN(10)) { GRP(); B_H(); B_Y1(); B_Y2(); norm_phase<0, 1, true, true>(F, nullptr,   Y1, Y2, nullptr, nullptr,   Y2, args.in[18], mod, 6, H, nullptr); } SEAM(10);
    if (IN(11)) { GRP(); B_H(); B_ACT(); pg8::Gemm g{H, (const bf16*)(ws + WS_WGU2), M, 2 * FF, DM, F.wave}; pg8::StaticOrder S; S.init(M, 2 * FF, F.G, vbx);
        pg8::EpiSwiGLU E{ACT, FF};
        pg8::gemm_phase<pg8::EpiSwiGLU, pg8::StaticOrder, true, true>(F.lds + RING_OFF, g, S, E); } SEAM(11);
    if (IN(12)) { GRP(); B_ACT(); BUF(Y3, WS_H, 0 * MiB, 1024); pg8::Gemm g{ACT, (const bf16*)(ws + WS_WD2), M, DM, FF, F.wave}; pg8::StaticOrder S; S.init(M, DM, F.G, vbx);
        typedef pg8::EpiDelta<NMODW, SEQ / 256, 1> EpiD; EpiD E{Y3, mod + 8 * DM, escr};
        pg8::gemm_phase<EpiD, pg8::StaticOrder, true, true>(F.lds + RING_OFF, g, S, E); } SEAM(12);
    if (IN(13)) { GRP(); B_Y2(); BUF(Y3, WS_H, 0 * MiB, 1024); norm_phase<1, 1, true, false>(F, nullptr,   Y2, Y3, nullptr, nullptr, nullptr, args.in[22], nullptr, 0, nullptr, out); }
#undef IN
#undef SEAM
}

#ifndef SPLIT_LAUNCH
#define SPLIT_LAUNCH 0
#endif
extern "C" void kernel_launch(void* const* d_in, const int* in_sizes, int n_in, void* d_out, int out_size, void* d_ws, size_t ws_size, hipStream_t stream) {
    static int grid = 0;
    if (grid == 0) {
        if (n_in != 23 || in_sizes[0] != M * DM || out_size != M * DM || ws_size < WS_END) {
            fprintf(stderr, "kernel_launch: unexpected shapes n_in %d in0 %d out %d ws %zu\n", n_in, n_in > 0 ? in_sizes[0] : -1, out_size, ws_size); grid = -1; return; }
        int dev = 0, cus = 0, per_cu = 0;
        if (hipGetDevice(&dev) != hipSuccess || hipDeviceGetAttribute(&cus, hipDeviceAttributeMultiprocessorCount, dev) != hipSuccess) { fprintf(stderr, "kernel_launch: device query failed\n"); grid = -1; return; }
        if (hipFuncSetAttribute((const void*)mk_fwd, hipFuncAttributeMaxDynamicSharedMemorySize, LDS_BYTES) != hipSuccess) { fprintf(stderr, "kernel_launch: hipFuncSetAttribute failed\n"); grid = -1; return; }
        if (hipOccupancyMaxActiveBlocksPerMultiprocessor(&per_cu, (const void*)mk_fwd, NWAVES * 64, LDS_BYTES) != hipSuccess || per_cu < 1) { fprintf(stderr, "kernel_launch: the occupancy query admits %d workgroups per CU for this kernel and LDS size; nothing launched\n", per_cu); (void)hipGetLastError(); grid = -1; return; }
        (void)hipGetLastError();
        grid = cus;
    }
    if (grid < 0) return;
    (void)hipMemsetAsync((unsigned char*)d_ws + WS_CTL, 0, CTL_ZERO_BYTES, stream);
    Args a{};
    for (int i = 0; i < 23; ++i) a.in[i] = (const float*)d_in[i];
    a.out = (float*)d_out; a.ws = (unsigned char*)d_ws;
    if (!SPLIT_LAUNCH) {
        a.ph_lo = 0; a.ph_hi = NPHASE; a.use_bar = 1;
        hipLaunchKernelGGL(mk_fwd, dim3(grid), dim3(NWAVES * 64), LDS_BYTES, stream, a);
        return;
    }
    for (int k = 0; k < NPHASE; ++k) { a.ph_lo = k; a.ph_hi = k + 1; a.use_bar = 0; hipLaunchKernelGGL(mk_fwd, dim3(grid), dim3(NWAVES * 64), LDS_BYTES, stream, a); }
}
```
